# Optimizing an MI355X kernel written in HIP

```python
import jax, jax.numpy as jnp
from jax import lax
import numpy as np

D_MODEL = 1024
BATCH = 2
SEQ = 8192
DEPTH = 1
DEC_BATCH = 128
DEC_SEQ = 4
PAST_LEN = 2048
PAGE_SIZE = 128

D_MIX = D_MODEL
D_ATT = D_MIX // 2
H_ATT = 8
HD_ATT = D_ATT // H_ATT
D_SSM = D_MIX - D_ATT
P_SSM = 64
H_SSM = D_SSM // P_SSM
N_STATE = 128
N_BC_GROUPS = 2
HEADS_PER_BC_GROUP = H_SSM // N_BC_GROUPS
CONV_WIDTH = 4
CONV_CH = D_SSM + 2 * N_BC_GROUPS * N_STATE
SSD_CHUNK = 128
Q_BLOCK = 128
N_MEM = 256
H_X = 4
HD_X = D_MODEL // H_X
D_FF = -(-(8 * D_MODEL) // (3 * 256)) * 256
IN_COLS = 3 * D_ATT + H_ATT + D_SSM + CONV_CH + H_SSM
EPS = 1e-6
ATT_SCALE = HD_ATT ** -0.5
X_SCALE = HD_X ** -0.5

kernel_name = 'hymba_fox_ssd_decode_step'


def rms_norm(x, g):
    xf = x.astype(jnp.float32)
    xf = xf * lax.rsqrt(jnp.mean(xf * xf, axis=-1, keepdims=True) + EPS)
    return (xf * g.astype(jnp.float32)).astype(x.dtype)


def in_projection(h, w_in, b_forget):
    b, l, _ = h.shape
    proj = jnp.einsum('bld,dc->blc', h, w_in)
    cuts = [D_ATT, 2 * D_ATT, 3 * D_ATT, 3 * D_ATT + H_ATT,
            3 * D_ATT + H_ATT + D_SSM, 3 * D_ATT + H_ATT + D_SSM + CONV_CH]
    q, k, v, f_raw, z, xbc, dt_raw = jnp.split(proj, cuts, axis=-1)
    q = q.reshape(b, l, H_ATT, HD_ATT)
    k = k.reshape(b, l, H_ATT, HD_ATT)
    v = v.reshape(b, l, H_ATT, HD_ATT)
    logf = jax.nn.log_sigmoid((f_raw + b_forget).astype(jnp.float32))
    return q, k, v, logf, z, xbc, dt_raw


def fox_attend(q, c_q, k, v, c_k, mask):
    s = jnp.einsum('bqhd,bkhd->bhqk', q, k).astype(jnp.float32) * ATT_SCALE
    bias = jnp.swapaxes(c_q, 1, 2)[:, :, :, None] - jnp.swapaxes(c_k, 1, 2)[:, :, None, :]
    s = jnp.where(mask, s + bias, -jnp.inf)
    p = jax.nn.softmax(s, axis=-1)
    return jnp.einsum('bhqk,bkhd->bqhd', p.astype(v.dtype), v)


def fox_prompt(q, k, v, logf):
    b, l, h, d = q.shape
    c = jnp.cumsum(logf, axis=1)
    kpos = jnp.arange(l)

    def block(i):
        start = i * Q_BLOCK
        q_blk = lax.dynamic_slice_in_dim(q, start, Q_BLOCK, axis=1)
        c_blk = lax.dynamic_slice_in_dim(c, start, Q_BLOCK, axis=1)
        qpos = start + jnp.arange(Q_BLOCK)
        mask = qpos[:, None] >= kpos[None, :]
        return fox_attend(q_blk, c_blk, k, v, c, mask)

    out = lax.map(block, jnp.arange(l // Q_BLOCK))
    return jnp.moveaxis(out, 0, 1).reshape(b, l, h * d)


def fox_sample(q, k_new, v_new, logf_new, cache_k, cache_v, cache_logf, page_table):
    db, l = q.shape[:2]
    past = page_table.shape[1] * PAGE_SIZE
    k_past = cache_k[page_table].reshape(db, past, H_ATT, HD_ATT)
    v_past = cache_v[page_table].reshape(db, past, H_ATT, HD_ATT)
    logf_past = cache_logf[page_table].reshape(db, past, H_ATT).astype(jnp.float32)
    c_past = jnp.cumsum(logf_past, axis=1)
    c_new = c_past[:, -1:] + jnp.cumsum(logf_new, axis=1)
    k_all = jnp.concatenate([k_past.astype(k_new.dtype), k_new], axis=1)
    v_all = jnp.concatenate([v_past.astype(v_new.dtype), v_new], axis=1)
    c_all = jnp.concatenate([c_past, c_new], axis=1)
    qpos = past + jnp.arange(l)
    kpos = jnp.arange(past + l)
    mask = qpos[:, None] >= kpos[None, :]
    return fox_attend(q, c_new, k_all, v_all, c_all, mask).reshape(db, l, D_ATT)


def ssd_scan(xdt, a, bmat, cmat, h0):
    b, l, h, p = xdt.shape
    n = bmat.shape[-1]
    q = min(SSD_CHUNK, l)
    pad = (-l) % q
    if pad:
        xdt = jnp.pad(xdt, ((0, 0), (0, pad), (0, 0), (0, 0)))
        bmat = jnp.pad(bmat, ((0, 0), (0, pad), (0, 0), (0, 0)))
        cmat = jnp.pad(cmat, ((0, 0), (0, pad), (0, 0), (0, 0)))
        a = jnp.pad(a, ((0, 0), (0, pad), (0, 0)))
    nc = (l + pad) // q
    xdt = xdt.reshape(b, nc, q, h, p)
    bmat = bmat.reshape(b, nc, q, h, n)
    cmat = cmat.reshape(b, nc, q, h, n)
    a_cs = jnp.cumsum(a.reshape(b, nc, q, h), axis=2)
    causal = jnp.tril(jnp.ones((q, q), dtype=bool))
    seg = a_cs[:, :, :, None, :] - a_cs[:, :, None, :, :]
    decay_ts = jnp.exp(jnp.where(causal[None, None, :, :, None], seg, -jnp.inf))
    g = jnp.einsum('bcthn,bcshn->bctsh', cmat, bmat) * decay_ts
    y_diag = jnp.einsum('bctsh,bcshp->bcthp', g, xdt)
    decay_to_end = jnp.exp(a_cs[:, :, -1:, :] - a_cs)
    s_chunk = jnp.einsum('bcshn,bcsh,bcshp->bchpn', bmat, decay_to_end, xdt).astype(jnp.float32)
    chunk_decay = jnp.exp(a_cs[:, :, -1, :])

    def step(state, inp):
        s_c, d_c = inp
        return d_c[:, :, None, None] * state + s_c, state

    h_final, h_start = lax.scan(step, h0.astype(jnp.float32),
                                (jnp.moveaxis(s_chunk, 1, 0), jnp.moveaxis(chunk_decay, 1, 0)))
    h_start = jnp.moveaxis(h_start, 0, 1)
    y_off = jnp.einsum('bcthn,bchpn,bcth->bcthp', cmat, h_start, jnp.exp(a_cs))
    y = (y_diag + y_off).reshape(b, nc * q, h, p)[:, :l]
    return y, h_final


def ssd_branch(z, xbc, dt_raw, conv_buf, h0, conv_w, conv_b, dt_bias, a_log, d_skip, norm_g):
    b, l, _ = xbc.shape
    xpad = jnp.concatenate([conv_buf.astype(xbc.dtype), xbc], axis=1)
    acc = conv_b
    for tap in range(CONV_WIDTH):
        acc = acc + xpad[:, tap:tap + l] * conv_w[tap]
    new_buf = xpad[:, l:]
    act = jax.nn.silu(acc)
    xs = act[..., :D_SSM].reshape(b, l, H_SSM, P_SSM)
    bm = act[..., D_SSM:D_SSM + N_BC_GROUPS * N_STATE].reshape(b, l, N_BC_GROUPS, N_STATE)
    cm = act[..., D_SSM + N_BC_GROUPS * N_STATE:].reshape(b, l, N_BC_GROUPS, N_STATE)
    bm = jnp.repeat(bm, HEADS_PER_BC_GROUP, axis=2)
    cm = jnp.repeat(cm, HEADS_PER_BC_GROUP, axis=2)
    dt = jax.nn.softplus((dt_raw + dt_bias).astype(jnp.float32))
    a = -jnp.exp(a_log.astype(jnp.float32)) * dt
    y, h_new = ssd_scan(xs * dt[..., None], a, bm, cm, h0)
    y = y + d_skip[:, None] * xs
    y = y.reshape(b, l, D_SSM) * jax.nn.silu(z)
    return rms_norm(y, norm_g), new_buf, h_new


def mixer_sublayer(x, attend, conv_buf, h0, norm_g, w_in, b_forget, conv_w, conv_b,
                   dt_bias, a_log, d_skip, ssm_norm_g, w_out):
    h = rms_norm(x, norm_g)
    q, k, v, logf, z, xbc, dt_raw = in_projection(h, w_in, b_forget)
    att = attend(q, k, v, logf)
    ssm, conv_new, h_new = ssd_branch(z, xbc, dt_raw, conv_buf, h0, conv_w, conv_b,
                                      dt_bias, a_log, d_skip, ssm_norm_g)
    mixed = jnp.concatenate([att, ssm], axis=-1)
    x = x + jnp.einsum('blc,cd->bld', mixed, w_out).astype(x.dtype)
    return x, k, v, logf, conv_new, h_new


def memory_kv(mem, g, w_ck, w_cv):
    b, m, _ = mem.shape
    mn = rms_norm(mem, g)
    k = jnp.einsum('bmd,de->bme', mn, w_ck).reshape(b, m, H_X, HD_X)
    v = jnp.einsum('bmd,de->bme', mn, w_cv).reshape(b, m, H_X, HD_X)
    return k, v


def cross_sublayer(x, mem_k, mem_v, norm_g, w_cq, w_co):
    b, l, _ = x.shape
    h = rms_norm(x, norm_g)
    q = jnp.einsum('bld,de->ble', h, w_cq).reshape(b, l, H_X, HD_X)
    s = jnp.einsum('bqhd,bmhd->bhqm', q, mem_k.astype(q.dtype)).astype(jnp.float32) * X_SCALE
    p = jax.nn.softmax(s, axis=-1)
    o = jnp.einsum('bhqm,bmhd->bqhd', p.astype(q.dtype), mem_v.astype(q.dtype)).reshape(b, l, D_MODEL)
    return x + jnp.einsum('ble,ed->bld', o, w_co).astype(x.dtype)


def ffn_sublayer(x, norm_g, w_gate, w_up, w_down):
    h = rms_norm(x, norm_g)
    u = jax.nn.silu(jnp.einsum('bld,df->blf', h, w_gate)) * jnp.einsum('bld,df->blf', h, w_up)
    return x + jnp.einsum('blf,fd->bld', u, w_down).astype(x.dtype)


def setup_inputs(seed: int = 0) -> dict:
    key = jax.random.key(seed)
    keys = list(jax.random.split(key, 48))

    def nxt():
        return keys.pop()

    f32 = jnp.float32

    def normal(shape, scale=1.0):
        return jax.random.normal(nxt(), shape, f32) * scale

    def gain(shape):
        return 1.0 + 0.02 * normal(shape)

    n_pages = PAST_LEN // PAGE_SIZE
    n_used = DEC_BATCH * n_pages
    n_phys = n_used + max(n_used // 4, 1)

    x_prompt = normal((BATCH, SEQ, D_MODEL))
    x_sample = normal((DEC_BATCH, DEC_SEQ, D_MODEL))
    mem_prompt = normal((BATCH, N_MEM, D_MODEL))
    cache_k = normal((DEPTH, n_phys, PAGE_SIZE, H_ATT, HD_ATT))
    cache_v = normal((DEPTH, n_phys, PAGE_SIZE, H_ATT, HD_ATT))
    cache_logf = jax.nn.log_sigmoid(normal((DEPTH, n_phys, PAGE_SIZE, H_ATT)) + 2.0)
    page_table = jax.random.permutation(nxt(), n_phys)[:n_used].reshape(DEC_BATCH, n_pages).astype(jnp.int32)
    cache_mem_k = normal((DEPTH, DEC_BATCH, N_MEM, H_X, HD_X))
    cache_mem_v = normal((DEPTH, DEC_BATCH, N_MEM, H_X, HD_X))
    state_conv = normal((DEPTH, DEC_BATCH, CONV_WIDTH - 1, CONV_CH))
    state_ssm = normal((DEPTH, DEC_BATCH, H_SSM, P_SSM, N_STATE), 0.1)

    norm_mix_g = gain((DEPTH, D_MODEL))
    w_in = normal((DEPTH, D_MODEL, IN_COLS), D_MODEL ** -0.5)
    b_forget = jax.random.uniform(nxt(), (DEPTH, H_ATT), f32, 0.5, 3.0)
    conv_w = normal((DEPTH, CONV_WIDTH, CONV_CH), CONV_WIDTH ** -0.5)
    conv_b = normal((DEPTH, CONV_CH), 0.02)
    dt0 = jnp.exp(jax.random.uniform(nxt(), (DEPTH, H_SSM), f32, float(np.log(1e-3)), float(np.log(1e-1))))
    dt_bias = dt0 + jnp.log(-jnp.expm1(-dt0))
    a_log = jnp.log(jax.random.uniform(nxt(), (DEPTH, H_SSM), f32, 1.0, 16.0))
    d_skip = gain((DEPTH, H_SSM))
    ssm_norm_g = gain((DEPTH, D_SSM))
    w_out = normal((DEPTH, D_MIX, D_MODEL), D_MIX ** -0.5)
    norm_cross_g = gain((DEPTH, D_MODEL))
    norm_mem_g = gain((DEPTH, D_MODEL))
    w_cq = normal((DEPTH, D_MODEL, D_MODEL), D_MODEL ** -0.5)
    w_ck = normal((DEPTH, D_MODEL, D_MODEL), D_MODEL ** -0.5)
    w_cv = normal((DEPTH, D_MODEL, D_MODEL), D_MODEL ** -0.5)
    w_co = normal((DEPTH, D_MODEL, D_MODEL), D_MODEL ** -0.5)
    norm_ffn_g = gain((DEPTH, D_MODEL))
    w_gate = normal((DEPTH, D_MODEL, D_FF), D_MODEL ** -0.5)
    w_up = normal((DEPTH, D_MODEL, D_FF), D_MODEL ** -0.5)
    w_down = normal((DEPTH, D_FF, D_MODEL), D_FF ** -0.5)
    final_norm_g = gain((D_MODEL,))
    return {'x_prompt': x_prompt, 'x_sample': x_sample, 'mem_prompt': mem_prompt,
            'cache_k': cache_k, 'cache_v': cache_v, 'cache_logf': cache_logf,
            'page_table': page_table, 'cache_mem_k': cache_mem_k, 'cache_mem_v': cache_mem_v,
            'state_conv': state_conv, 'state_ssm': state_ssm,
            'norm_mix_g': norm_mix_g, 'w_in': w_in, 'b_forget': b_forget,
            'conv_w': conv_w, 'conv_b': conv_b, 'dt_bias': dt_bias, 'a_log': a_log,
            'd_skip': d_skip, 'ssm_norm_g': ssm_norm_g, 'w_out': w_out,
            'norm_cross_g': norm_cross_g, 'norm_mem_g': norm_mem_g,
            'w_cq': w_cq, 'w_ck': w_ck, 'w_cv': w_cv, 'w_co': w_co,
            'norm_ffn_g': norm_ffn_g, 'w_gate': w_gate, 'w_up': w_up, 'w_down': w_down,
            'final_norm_g': final_norm_g}


def reference(x_prompt, x_sample, mem_prompt, cache_k, cache_v, cache_logf, page_table,
              cache_mem_k, cache_mem_v, state_conv, state_ssm,
              norm_mix_g, w_in, b_forget, conv_w, conv_b, dt_bias, a_log, d_skip,
              ssm_norm_g, w_out, norm_cross_g, norm_mem_g, w_cq, w_ck, w_cv, w_co,
              norm_ffn_g, w_gate, w_up, w_down, final_norm_g):
    xp, xs = x_prompt, x_sample
    bp = xp.shape[0]
    kp_l, vp_l, fp_l, mkp_l, mvp_l, cp_l, sp_l = [], [], [], [], [], [], []
    ks_l, vs_l, fs_l, cs_l, ss_l = [], [], [], [], []
    for layer in range(DEPTH):
        mix_w = (norm_mix_g[layer], w_in[layer], b_forget[layer], conv_w[layer], conv_b[layer],
                 dt_bias[layer], a_log[layer], d_skip[layer], ssm_norm_g[layer], w_out[layer])
        conv0 = jnp.zeros((bp, CONV_WIDTH - 1, CONV_CH), xp.dtype)
        h0 = jnp.zeros((bp, H_SSM, P_SSM, N_STATE), jnp.float32)
        xp, kp, vp, fp, cp, sp = mixer_sublayer(xp, fox_prompt, conv0, h0, *mix_w)
        ck, cv, cf = cache_k[layer], cache_v[layer], cache_logf[layer]

        def attend_sample(q, k, v, logf, ck=ck, cv=cv, cf=cf):
            return fox_sample(q, k, v, logf, ck, cv, cf, page_table)

        xs, ks, vs, fs, cs, ss = mixer_sublayer(xs, attend_sample, state_conv[layer],
                                                state_ssm[layer], *mix_w)
        mkp, mvp = memory_kv(mem_prompt, norm_mem_g[layer], w_ck[layer], w_cv[layer])
        xp = cross_sublayer(xp, mkp, mvp, norm_cross_g[layer], w_cq[layer], w_co[layer])
        xs = cross_sublayer(xs, cache_mem_k[layer], cache_mem_v[layer], norm_cross_g[layer],
                            w_cq[layer], w_co[layer])
        xp = ffn_sublayer(xp, norm_ffn_g[layer], w_gate[layer], w_up[layer], w_down[layer])
        xs = ffn_sublayer(xs, norm_ffn_g[layer], w_gate[layer], w_up[layer], w_down[layer])
        kp_l.append(kp); vp_l.append(vp); fp_l.append(fp); mkp_l.append(mkp); mvp_l.append(mvp)
        cp_l.append(cp); sp_l.append(sp)
        ks_l.append(ks); vs_l.append(vs); fs_l.append(fs); cs_l.append(cs); ss_l.append(ss)
    y_prompt = rms_norm(xp, final_norm_g)
    y_sample = rms_norm(xs, final_norm_g)
    return (y_prompt, y_sample,
            jnp.stack(kp_l), jnp.stack(vp_l), jnp.stack(fp_l), jnp.stack(mkp_l), jnp.stack(mvp_l),
            jnp.stack(cp_l), jnp.stack(sp_l),
            jnp.stack(ks_l), jnp.stack(vs_l), jnp.stack(fs_l), jnp.stack(cs_l), jnp.stack(ss_l))
```

```cpp
#include <hip/hip_runtime.h>
#include <cstdio>
#include <cstdint>
#include <cmath>
#define GAS __attribute__((address_space(1)))
#define LAS __attribute__((address_space(3)))
typedef unsigned short bf16;
typedef unsigned v4u __attribute__((ext_vector_type(4)));
typedef float f32x4 __attribute__((ext_vector_type(4)));
typedef short bf16x8 __attribute__((ext_vector_type(8)));
typedef GAS unsigned gu32;
typedef GAS unsigned long long gu64;
#define RLX_AGENT __ATOMIC_RELAXED, __HIP_MEMORY_SCOPE_AGENT
#define LDS_WAIT() asm volatile("s_waitcnt lgkmcnt(0)" ::: "memory")
#define VM_WAIT() asm volatile("s_waitcnt vmcnt(0)" ::: "memory")
__device__ __forceinline__ unsigned long long rt() { return __builtin_amdgcn_s_memrealtime(); }
__device__ __forceinline__ unsigned f2bf(float f) { unsigned u = __builtin_bit_cast(unsigned, f); return (u + 0x7fffu + ((u >> 16) & 1u)) >> 16; }
__device__ __forceinline__ unsigned pk2(float lo, float hi) { return f2bf(lo) | (f2bf(hi) << 16); }
typedef float f32x2 __attribute__((ext_vector_type(2)));
namespace pg8 {
#define PG8_LAS __attribute__((address_space(3)))
typedef unsigned short bf16_t;
typedef short bf16x8 __attribute__((ext_vector_type(8)));
typedef float f32x4 __attribute__((ext_vector_type(4)));
typedef unsigned u32x4 __attribute__((ext_vector_type(4)));
constexpr int BM = 256, BK = 64, HALF = 128, HTB = HALF * BK * 2  , STAGE_BYTES = 8 * HTB, NXCD = 8, WGM = 8;

__host__ __device__ __forceinline__ int lds_byte(int r, int c) { const int st = (r >> 4) * 2 + (c >> 5), rr = r & 15, cc = c & 31, ob = rr * 64 + cc * 2; return st * 1024 + (ob ^ (((ob >> 9) & 1) << 5)); }
__host__ __device__ __forceinline__ void stage_rc(int b, int& R, int& C) { const int st = b / 1024, sb = b % 1024, swz = sb ^ (((sb >> 9) & 1) << 5); R = (st >> 1) * 16 + swz / 64; C = (st & 1) * 32 + (swz % 64) / 2; }
__host__ __device__ __forceinline__ int perm32(int rho) { const int n = rho >> 4, i = rho & 15; return 8 * (i >> 2) + 4 * n + (i & 3); }

struct Unit { int pm, pn; };
struct Gemm { const bf16_t* A; const bf16_t* Bt; int M, N, K; };

struct StaticOrder {
    int nM, nN, nwg, G, c;
    __host__ __device__ void init(int M, int N, int G_, int c_) { nM = M / BM; nN = N / BM; nwg = nM * nN; G = G_; c = c_; }
    __host__ __device__ bool next(int i, Unit& u) const {
        const long L = (long)i * G + c; if (L >= nwg) return false;
        int wgid = (int)L; { const int q = nwg / NXCD, r = nwg % NXCD, xcd = wgid % NXCD, off = wgid / NXCD; wgid = (xcd < r ? xcd * (q + 1) : r * (q + 1) + (xcd - r) * q) + off; }
        const int nig = WGM * nN, gid = wgid / nig, fm = gid * WGM, gsz = (nM - fm) < WGM ? (nM - fm) : WGM;
        u.pm = fm + ((wgid % nig) % gsz); u.pn = (wgid % nig) / gsz; return true;
    }
    __device__ __forceinline__ void a_ready(const Unit&) const {}
    __device__ __forceinline__ void done(const Unit&) const {}
};

__device__ __forceinline__ unsigned cvt_pk_bf16(float lo, float hi) { unsigned r; asm volatile("v_cvt_pk_bf16_f32 %0, %1, %2" : "=v"(r) : "v"(lo), "v"(hi)); return r; }
typedef float f32x2 __attribute__((ext_vector_type(2)));
template <class F> struct Epi8 {
    static constexpr bool PERM = true, AFTER_DRAIN = false;
    F f;
    __device__ __forceinline__ void operator()(const f32x4 (&acc)[2][2][4][2], const Unit& u, int wr, int wc, int fr, int fq) const {
        const int row0 = u.pm * BM + wr * 64 + fr, col0 = u.pn * BM + wc * 32 + 8 * fq;
#pragma unroll
        for (int ai = 0; ai < 2; ++ai)
#pragma unroll
            for (int m = 0; m < 4; ++m) { const int row = row0 + ai * HALF + m * 16;
#pragma unroll
                for (int bj = 0; bj < 2; ++bj) f(row, col0 + bj * HALF, acc[ai][bj][m][0], acc[ai][bj][m][1]); }
    }
};
template <class F> struct EpiGU {
    static constexpr bool PERM = true, AFTER_DRAIN = false;
    F f;
    __device__ __forceinline__ void operator()(const f32x4 (&acc)[2][2][4][2], const Unit& u, int wr, int wc, int fr, int fq) const {
        const int row0 = u.pm * BM + wr * 64 + fr, col0 = u.pn * HALF + wc * 32 + 8 * fq;
#pragma unroll
        for (int ai = 0; ai < 2; ++ai)
#pragma unroll
            for (int m = 0; m < 4; ++m) { const int row = row0 + ai * HALF + m * 16;
                f(row, col0, acc[ai][0][m][0], acc[ai][0][m][1], acc[ai][1][m][0], acc[ai][1][m][1]); }
    }
};
template <class Epi, class Sched, bool ALIGN_EPI = false, bool SP2 = false>
__device__ __forceinline__ void gemm_phase(PG8_LAS unsigned char* lds, const Gemm g, const Sched& S, const Epi& E) {
    const int tid = threadIdx.x, wid = __builtin_amdgcn_readfirstlane(tid >> 6), lane = tid & 63, wr = wid >> 2, wc = wid & 3, fr = lane & 15, fq = lane >> 4;
    const int K = g.K, nt = K / BK;
    unsigned voffA[2], voffB[2];
#pragma unroll
    for (int i = 0; i < 2; ++i) { int R, C; stage_rc(tid * 16 + i * 8192, R, C); const int Rb = Epi::PERM ? ((R & ~31) + perm32(R & 31)) : R;
        voffA[i] = (unsigned)(R * K + C) * 2u; voffB[i] = (unsigned)(Rb * K + C) * 2u; }
    const size_t kstep = (size_t)(BK * 2);
    const size_t hstep = (size_t)HALF * K * 2;
    const size_t tstep = 2 * hstep;
    const unsigned ldsw = (unsigned)wid * 1024u;
    const int aoff = lds_byte(wr * 64 + fr, fq * 8), boff = lds_byte(wc * 32 + fr, fq * 8);
#define PG8_SA(b, h) (((b) * 2 + (h)) * HTB)
#define PG8_SB(b, h) ((4 + (b) * 2 + (h)) * HTB)
#define PG8_STAGE(bufoff, gbase, voff) do { _Pragma("unroll") for (int _i = 0; _i < 2; ++_i) \
        __builtin_amdgcn_global_load_lds((const unsigned*)((const char*)(gbase) + (voff)[_i]), (PG8_LAS unsigned*)(lds + (bufoff) + ldsw + _i * 8192), 16, 0, 0); } while (0)
#define PG8_LDA(dst, b, h) do { _Pragma("unroll") for (int m = 0; m < 4; ++m) _Pragma("unroll") for (int k = 0; k < 2; ++k) dst[m][k] = *(const PG8_LAS bf16x8*)(lds + PG8_SA(b, h) + aoff + m * 2048 + k * 1024); } while (0)
#define PG8_LDB(dst, b, h) do { _Pragma("unroll") for (int n = 0; n < 2; ++n) _Pragma("unroll") for (int k = 0; k < 2; ++k) dst[n][k] = *(const PG8_LAS bf16x8*)(lds + PG8_SB(b, h) + boff + n * 2048 + k * 1024); } while (0)
#define PG8_MMA(ai, bj, At, Bt) do { __builtin_amdgcn_s_setprio(1); _Pragma("unroll") for (int m = 0; m < 4; ++m) _Pragma("unroll") for (int n = 0; n < 2; ++n) _Pragma("unroll") for (int k = 0; k < 2; ++k) \
        acc[ai][bj][m][n] = __builtin_amdgcn_mfma_f32_16x16x32_bf16(Bt[n][k], At[m][k], acc[ai][bj][m][n], 0, 0, 0); __builtin_amdgcn_s_setprio(0); } while (0)
#define PG8_WAIT_V(n) asm volatile("s_waitcnt vmcnt(" #n ")" ::: "memory")
#define PG8_WAIT_L(n) asm volatile("s_waitcnt lgkmcnt(" #n ")" ::: "memory")
#define PG8_BAR __builtin_amdgcn_s_barrier()
#define PG8_SCHED __builtin_amdgcn_sched_barrier(0)
    Unit cur, nxt; int ui = 0;
    if (!S.next(0, cur)) return;
    f32x4 acc[2][2][4][2];
#pragma unroll
    for (int a = 0; a < 2; ++a)
#pragma unroll
        for (int b = 0; b < 2; ++b)
#pragma unroll
            for (int m = 0; m < 4; ++m)
#pragma unroll
                for (int n = 0; n < 2; ++n) acc[a][b][m][n] = (f32x4){0.f, 0.f, 0.f, 0.f};
    bf16x8 At[4][2], B0[2][2], B1[2][2];
    const char* cA = (const char*)g.A + (size_t)cur.pm * tstep; const char* cB = (const char*)g.Bt + (size_t)cur.pn * tstep;
    S.a_ready(cur);
    if constexpr (SP2) {
        PG8_STAGE(PG8_SB(0, 0), cB, voffB); PG8_STAGE(PG8_SB(0, 1), cB + hstep, voffB); PG8_STAGE(PG8_SA(0, 0), cA, voffA); PG8_STAGE(PG8_SA(0, 1), cA + hstep, voffA);
        if (wr == 1) PG8_BAR;
        PG8_WAIT_V(2); PG8_BAR;
        PG8_STAGE(PG8_SB(1, 0), cB + kstep, voffB); PG8_STAGE(PG8_SA(1, 0), cA + kstep, voffA); PG8_STAGE(PG8_SB(1, 1), cB + hstep + kstep, voffB);
        PG8_WAIT_V(6); PG8_BAR;
    } else {
        PG8_STAGE(PG8_SB(0, 0), cB, voffB); PG8_STAGE(PG8_SA(0, 0), cA, voffA); PG8_STAGE(PG8_SB(0, 1), cB + hstep, voffB); PG8_STAGE(PG8_SA(0, 1), cA + hstep, voffA);
        if (wr == 1) PG8_BAR;
        PG8_WAIT_V(4); PG8_BAR;
        PG8_STAGE(PG8_SB(1, 0), cB + kstep, voffB); PG8_STAGE(PG8_SA(1, 0), cA + kstep, voffA); PG8_STAGE(PG8_SB(1, 1), cB + hstep + kstep, voffB);
        PG8_WAIT_V(6); PG8_BAR;
    }
    for (;;) {
        const bool has_next = S.next(ui + 1, nxt);
        const char* nA = has_next ? (const char*)g.A + (size_t)nxt.pm * tstep : cA; const char* nB = has_next ? (const char*)g.Bt + (size_t)nxt.pn * tstep : cB;
        for (int t = 0; t < nt; t += 2) {
            const bool last = (t == nt - 2);
            const char* a1 = cA + (size_t)(t + 1) * kstep;
            const char* a2 = last ? nA : cA + (size_t)(t + 2) * kstep; const char* b2 = last ? nB : cB + (size_t)(t + 2) * kstep;
            const char* a3 = a2 + kstep; const char* b3 = b2 + kstep;
            if (last && has_next) S.a_ready(nxt);
            if constexpr (SP2) {
            PG8_LDB(B0, 0, 0); PG8_LDB(B1, 0, 1); PG8_SCHED; PG8_LDA(At, 0, 0); PG8_STAGE(PG8_SA(1, 1), a1 + hstep, voffA);
            PG8_WAIT_V(8); PG8_WAIT_L(0); PG8_BAR; PG8_MMA(0, 0, At, B0); PG8_MMA(0, 1, At, B1); PG8_BAR; PG8_SCHED;
            PG8_LDA(At, 0, 1); PG8_STAGE(PG8_SB(0, 0), b2, voffB); PG8_STAGE(PG8_SB(0, 1), b2 + hstep, voffB); PG8_STAGE(PG8_SA(0, 0), a2, voffA);
            PG8_WAIT_V(8); PG8_WAIT_L(0); PG8_BAR; PG8_MMA(1, 0, At, B0); PG8_MMA(1, 1, At, B1); PG8_BAR; PG8_SCHED;
            PG8_LDB(B0, 1, 0); PG8_LDB(B1, 1, 1); PG8_SCHED; PG8_LDA(At, 1, 0); PG8_STAGE(PG8_SA(0, 1), a2 + hstep, voffA);
            PG8_WAIT_V(8); PG8_WAIT_L(0); PG8_BAR; PG8_MMA(0, 0, At, B0); PG8_MMA(0, 1, At, B1); PG8_BAR; PG8_SCHED;
            PG8_LDA(At, 1, 1); PG8_STAGE(PG8_SB(1, 0), b3, voffB); PG8_STAGE(PG8_SB(1, 1), b3 + hstep, voffB); PG8_STAGE(PG8_SA(1, 0), a3, voffA);
            PG8_WAIT_V(8); PG8_WAIT_L(0); PG8_BAR; PG8_MMA(1, 0, At, B0); PG8_MMA(1, 1, At, B1); PG8_BAR; PG8_SCHED;
            } else {
            PG8_LDB(B0, 0, 0); PG8_SCHED; PG8_LDA(At, 0, 0); PG8_STAGE(PG8_SA(1, 1), a1 + hstep, voffA);
            PG8_WAIT_L(8); PG8_BAR; PG8_WAIT_L(0); PG8_MMA(0, 0, At, B0); PG8_BAR; PG8_SCHED;
            PG8_LDB(B1, 0, 1); PG8_STAGE(PG8_SB(0, 0), b2, voffB);
            PG8_BAR; PG8_WAIT_L(0); PG8_MMA(0, 1, At, B1); PG8_BAR;
            PG8_LDA(At, 0, 1); PG8_STAGE(PG8_SA(0, 0), a2, voffA);
            PG8_BAR; PG8_WAIT_L(0); PG8_MMA(1, 0, At, B0); PG8_BAR; PG8_SCHED;
            PG8_STAGE(PG8_SB(0, 1), b2 + hstep, voffB);
            PG8_WAIT_V(6); PG8_BAR; PG8_MMA(1, 1, At, B1); PG8_BAR;
            PG8_LDB(B0, 1, 0); PG8_SCHED; PG8_LDA(At, 1, 0); PG8_STAGE(PG8_SA(0, 1), a2 + hstep, voffA);
            PG8_WAIT_L(8); PG8_BAR; PG8_WAIT_L(0); PG8_MMA(0, 0, At, B0); PG8_BAR; PG8_SCHED;
            PG8_LDB(B1, 1, 1); PG8_STAGE(PG8_SB(1, 0), b3, voffB);
            PG8_BAR; PG8_WAIT_L(0); PG8_MMA(0, 1, At, B1); PG8_BAR;
            PG8_LDA(At, 1, 1); PG8_STAGE(PG8_SA(1, 0), a3, voffA);
            PG8_BAR; PG8_WAIT_L(0); PG8_MMA(1, 0, At, B0); PG8_BAR; PG8_SCHED;
            PG8_STAGE(PG8_SB(1, 1), b3 + hstep, voffB);
            PG8_WAIT_V(6); PG8_BAR; PG8_MMA(1, 1, At, B1); PG8_BAR;
            }
        }
        if constexpr (ALIGN_EPI) { if (wr == 0) PG8_BAR; }
        if constexpr (!Epi::AFTER_DRAIN) { E(acc, cur, wr, wc, fr, fq); S.done(cur); }
        if (!has_next) break;
#pragma unroll
        for (int a = 0; a < 2; ++a)
#pragma unroll
            for (int b = 0; b < 2; ++b)
#pragma unroll
                for (int m = 0; m < 4; ++m)
#pragma unroll
                    for (int n = 0; n < 2; ++n) acc[a][b][m][n] = (f32x4){0.f, 0.f, 0.f, 0.f};
        cur = nxt; cA = nA; cB = nB; ++ui;
        if constexpr (ALIGN_EPI) { if (wr == 1) PG8_BAR; }
    }
    PG8_WAIT_V(0);
    if constexpr (!ALIGN_EPI) { if (wr == 0) PG8_BAR; }
    PG8_BAR;
    if constexpr (Epi::AFTER_DRAIN) { E.fused(acc, cur, wr, wc, fr, fq, lds, wid, lane); S.done(cur); }
#undef PG8_SA
#undef PG8_SB
#undef PG8_STAGE
#undef PG8_LDA
#undef PG8_LDB
#undef PG8_MMA
#undef PG8_WAIT_V
#undef PG8_WAIT_L
#undef PG8_BAR
#undef PG8_SCHED
}
}
#define XB_TMO      128
#define XB_XCNT(j)  (256  + 64 * (j))
#define XB_XSUB(j)  (1280 + 64 * (j))
#define XB_XGEN(j)  (2304 + 64 * (j))
#define XB_TOP      3328
#define XB_TOPGEN   3392
#define XCD_BAR_WORDS 3456
#define XB_SPIN_CAP (1u << 18)

__device__ __forceinline__ unsigned xb_ld(unsigned* p)              { return __hip_atomic_load(p, __ATOMIC_RELAXED, __HIP_MEMORY_SCOPE_AGENT); }
__device__ __forceinline__ unsigned xb_add(unsigned* p, unsigned v) { return __hip_atomic_fetch_add(p, v, __ATOMIC_RELAXED, __HIP_MEMORY_SCOPE_AGENT); }
__device__ __forceinline__ unsigned xb_xcc_id() { return (unsigned)__builtin_amdgcn_s_getreg((3 << 11) | 20) & 0xFu; }
#define XB_SPIN(cond, bar) do { unsigned _sp = 0; while (cond) { __builtin_amdgcn_s_sleep(1); \
    if ((++_sp & 255u) == 0u) { if (xb_ld(&(bar)[XB_TMO])) break; if (_sp > XB_SPIN_CAP) { atomicAdd(&(bar)[XB_TMO], 1u); break; } } } } while (0)

struct XcdBarrier {
    unsigned* bar; unsigned x;
    volatile LAS unsigned* st;
};

__device__ __forceinline__ XcdBarrier xcd_barrier_post(unsigned* bar, volatile LAS unsigned* st) {
    XcdBarrier b; b.bar = bar; b.x = xb_xcc_id(); b.st = st;
    if (threadIdx.x == 0) (void)xb_add(&bar[XB_XCNT(b.x)], 1u);
    return b;
}
__device__ __forceinline__ void xcd_barrier_complete(unsigned* bar, unsigned x, unsigned& nloc, unsigned& nx) {
    const unsigned G = gridDim.x * gridDim.y * gridDim.z;
    unsigned sum, cnt, mine, sp = 0u;
    for (;;) {
        sum = 0u; cnt = 0u; mine = 0u;
#pragma unroll
        for (unsigned j = 0; j < 16; ++j) { const unsigned c = xb_ld(&bar[XB_XCNT(j)]); sum += c; cnt += (c > 0u) ? 1u : 0u; mine = (j == x) ? c : mine; }
        if (sum == G) break;
        __builtin_amdgcn_s_sleep(1);
        if ((++sp & 255u) == 0u) { if (xb_ld(&bar[XB_TMO])) break; if (sp > XB_SPIN_CAP) { atomicAdd(&bar[XB_TMO], 1u); break; } }
    }
    nloc = mine > 0u ? mine : 1u; nx = cnt > 0u ? cnt : 1u;
}

__device__ __forceinline__ void xcd_barrier(const XcdBarrier& b) {
    asm volatile("s_waitcnt vmcnt(0)" ::: "memory");
    __syncthreads();
    if (threadIdx.x == 0) {
        unsigned* bar = b.bar;
        __builtin_amdgcn_s_waitcnt(0);
        unsigned nloc = b.st[0], nx = b.st[1];
        if (nloc == 0u) { xcd_barrier_complete(bar, b.x, nloc, nx); b.st[0] = nloc; b.st[1] = nx; }
        const unsigned old = xb_add(&bar[XB_XSUB(b.x)], 1u);
        const unsigned gen = old / nloc;
        if (old + 1u == (gen + 1u) * nloc) {
            __builtin_amdgcn_fence(__ATOMIC_RELEASE, "agent");
            asm volatile("s_waitcnt vmcnt(0)" ::: "memory");
            const unsigned og = xb_add(&bar[XB_TOP], 1u);
            const unsigned tg = og / nx;
            if (og + 1u == (tg + 1u) * nx) xb_add(&bar[XB_TOPGEN], 1u);
            else XB_SPIN(xb_ld(&bar[XB_TOPGEN]) == tg, bar);
            __builtin_amdgcn_fence(__ATOMIC_ACQUIRE, "agent");
            xb_add(&bar[XB_XGEN(b.x)], 1u);
            asm volatile("s_waitcnt vmcnt(0)" ::: "memory");
        } else {
            XB_SPIN(xb_ld(&bar[XB_XGEN(b.x)]) == gen, bar);
            __builtin_amdgcn_fence(__ATOMIC_ACQUIRE, "agent");
            asm volatile("s_waitcnt vmcnt(0)" ::: "memory");
        }
    }
    __syncthreads();
}
constexpr int DM = 1024, SEQ = 8192, NBATCH = 2, MP = NBATCH * SEQ, DB = 128, DSQ = 4, MS = DB * DSQ, MT = MP + MS;
constexpr int NMEM = 256, MMEM = NBATCH * NMEM;
constexpr int HATT = 8, HD = 64, DATT = 512, HSSM = 8, PS = 64, NST = 128, DSSM = 512, CONVCH = 1024, DFF = 2816, INCOLS = 3088, HX = 4, HDX = 256;
constexpr int NPAGES = 16, PAGE = 128, PAST = 2048;
constexpr float EPS = 1e-6f, LOG2E = 1.4426950408889634f;
constexpr float C2 = 0.125f * LOG2E;
constexpr float XC2 = 0.0625f * LOG2E;
constexpr size_t OFF_YP = 0, OFF_YS = OFF_YP + (size_t)MP * DM, OFF_KP = OFF_YS + (size_t)MS * DM, OFF_VP = OFF_KP + (size_t)MP * DATT, OFF_FP = OFF_VP + (size_t)MP * DATT,
                 OFF_MKP = OFF_FP + (size_t)MP * HATT, OFF_MVP = OFF_MKP + (size_t)MMEM * DM, OFF_CP = OFF_MVP + (size_t)MMEM * DM, OFF_SP = OFF_CP + (size_t)NBATCH * 3 * CONVCH,
                 OFF_KS = OFF_SP + (size_t)NBATCH * HSSM * PS * NST, OFF_VS = OFF_KS + (size_t)MS * DATT, OFF_FS = OFF_VS + (size_t)MS * DATT, OFF_CS = OFF_FS + (size_t)MS * HATT,
                 OFF_SS = OFF_CS + (size_t)DB * 3 * CONVCH, OUT_TOTAL = OFF_SS + (size_t)DB * HSSM * PS * NST;
static_assert(OUT_TOTAL == 44705792, "output size");
constexpr size_t MiB = 1u << 20;
constexpr size_t WS_CTL = 0, CTL_ZERO_BYTES = 1 * MiB;
constexpr int CW_BAR = 4096;
constexpr size_t WS_SS1 = 256 * 1024, WS_SS2 = 384 * 1024, WS_SS3 = 512 * 1024;
constexpr size_t WS_WIN = 2 * MiB, WS_WOUT = 8 * MiB, WS_WCQ = 10 * MiB, WS_WCO = 12 * MiB, WS_WCKV = 14 * MiB, WS_WGU = 18 * MiB, WS_WD = 29 * MiB;
constexpr size_t WS_SS0 = 35 * MiB, WS_SSM = 35 * MiB + 128 * 1024, WS_LOGF = 36 * MiB, WS_DT = 37 * MiB, WS_AA = 38 * MiB, WS_CUM = 39 * MiB;
constexpr size_t WS_XB = 40 * MiB, WS_MB = 74 * MiB, WS_Q = 76 * MiB, WS_K = 93 * MiB, WS_V = 110 * MiB, WS_Z = 127 * MiB, WS_XBC = 144 * MiB, WS_ACT = 178 * MiB, WS_Y = 244 * MiB;
constexpr size_t WS_MIX = 278 * MiB, WS_X = 312 * MiB, WS_QC = 378 * MiB, WS_OC = 412 * MiB, WS_U = 446 * MiB, WS_MK = 538 * MiB, WS_MV = 539 * MiB, WS_END = 540 * MiB;
static_assert(WS_SS3 + (size_t)MT * 4 <= CTL_ZERO_BYTES && (CW_BAR + 3456) * 4 <= (int)WS_SS1, "ctl map");
static_assert(WS_XB + (size_t)MT * DM * 2 <= WS_MB && WS_Q + (size_t)MT * DATT * 2 <= WS_K && WS_XBC + (size_t)MT * DM * 2 <= WS_ACT && WS_ACT + (size_t)MT * DM * 4 <= WS_Y && WS_Y + (size_t)MT * DSSM * 4 <= WS_MIX, "ws map 1");
static_assert(WS_MIX + (size_t)MT * DM * 2 <= WS_X && WS_X + (size_t)MT * DM * 4 <= WS_QC && WS_QC + (size_t)MT * DM * 2 <= WS_OC && WS_OC + (size_t)MT * DM * 2 <= WS_U && WS_U + (size_t)MT * DFF * 2 <= WS_MK, "ws map 2");
static_assert(WS_WGU + (size_t)2 * DFF * DM * 2 <= WS_WD && WS_WD + (size_t)DM * DFF * 2 <= WS_SS0 && WS_WIN + (size_t)3072 * DM * 2 <= WS_WOUT && WS_WCKV + (size_t)2048 * DM * 2 <= WS_WGU, "ws map 3");
constexpr int RING_BYTES = 131072, LDSCTL_OFF = RING_BYTES, MISC_OFF = LDSCTL_OFF + 320, LDS_BYTES = 147456;
constexpr int NWAVES = 8, NTHREADS = 512;
#ifndef MK_ONE_LAUNCH
#define MK_ONE_LAUNCH 1
#endif
constexpr int NPH = 12;

struct Args { const void* in[32]; float* out; unsigned char* ws; int ph_lo, ph_hi; };

__device__ __forceinline__ float bf2f(unsigned short h) { return __uint_as_float((unsigned)h << 16); }
__device__ __forceinline__ float wave_sum(float v) {
#pragma unroll
    for (int o = 1; o < 64; o <<= 1) v += __shfl_xor(v, o);
    return v;
}
__device__ __forceinline__ float wave_max(float v) {
#pragma unroll
    for (int o = 1; o < 64; o <<= 1) v = fmaxf(v, __shfl_xor(v, o));
    return v;
}
__device__ __forceinline__ v4u pack8(f32x4 a, f32x4 b) { v4u w; w.x = pk2(a[0], a[1]); w.y = pk2(a[2], a[3]); w.z = pk2(b[0], b[1]); w.w = pk2(b[2], b[3]); return w; }
__device__ __forceinline__ float rstd_of(float ss, int n) { return rsqrtf(ss * (1.0f / (float)n) + EPS); }

struct FInproj {
    const float* ss0; bf16 *Qb, *Kb, *Vb, *Zb, *XBCb; float* out;
    __device__ __forceinline__ void operator()(int row, int col0, f32x4 v0, f32x4 v1) const {
        const float rs = rstd_of(ss0[row], DM); v0 = v0 * rs; v1 = v1 * rs;
        if (col0 < 512) { *(v4u*)(Qb + (size_t)row * DATT + col0) = pack8(v0 * C2, v1 * C2); }
        else if (col0 < 1536) {
            const bool isk = col0 < 1024; const int c = col0 - (isk ? 512 : 1024);
            *(v4u*)((isk ? Kb : Vb) + (size_t)row * DATT + c) = pack8(v0, v1);
            float* o = out + (row < MP ? (isk ? OFF_KP : OFF_VP) + (size_t)row * DATT : (isk ? OFF_KS : OFF_VS) + (size_t)(row - MP) * DATT) + c;
            *(f32x4*)o = v0; *(f32x4*)(o + 4) = v1;
        } else if (col0 < 2048) { *(v4u*)(Zb + (size_t)row * DSSM + (col0 - 1536)) = pack8(v0, v1); }
        else {
            const int c = col0 - 2048; *(v4u*)(XBCb + (size_t)row * CONVCH + c) = pack8(v0, v1);
            float* o = nullptr;
            if (row < MP) { const int t = row & (SEQ - 1); if (t >= SEQ - 3) o = out + OFF_CP + ((size_t)(row >> 13) * 3 + (t - (SEQ - 3))) * CONVCH + c; }
            else { const int s = row - MP, t = s & 3; if (t >= 1) o = out + OFF_CS + ((size_t)(s >> 2) * 3 + (t - 1)) * CONVCH + c; }
            if (o) { *(f32x4*)o = v0; *(f32x4*)(o + 4) = v1; }
        }
    }
};
struct FMemKV {
    const float* ssm; bf16 *MKb, *MVb; float* out;
    __device__ __forceinline__ void operator()(int row, int col0, f32x4 v0, f32x4 v1) const {
        const float rs = rstd_of(ssm[row], DM); v0 = v0 * rs; v1 = v1 * rs;
        const bool isk = col0 < 1024; const int c = isk ? col0 : col0 - 1024;
        *(v4u*)((isk ? MKb : MVb) + (size_t)row * DM + c) = pack8(v0, v1);
        float* o = out + (isk ? OFF_MKP : OFF_MVP) + (size_t)row * DM + c; *(f32x4*)o = v0; *(f32x4*)(o + 4) = v1;
    }
};
struct FRes {
    const float* xin_p; const float* xin_s; float* X; bf16* XB; float* SS;
    __device__ __forceinline__ void operator()(int row, int col0, f32x4 v0, f32x4 v1) const {
        const float* src = (row < MP ? xin_p + (size_t)row * DM : xin_s + (size_t)(row - MP) * DM) + col0;
        const f32x4 x0 = *(const f32x4*)src + v0, x1 = *(const f32x4*)(src + 4) + v1;
        float* d = X + (size_t)row * DM + col0; *(f32x4*)d = x0; *(f32x4*)(d + 4) = x1;
        if (XB) *(v4u*)(XB + (size_t)row * DM + col0) = pack8(x0, x1);
        float q = (x0[0] * x0[0] + x0[1] * x0[1]) + (x0[2] * x0[2] + x0[3] * x0[3]) + (x1[0] * x1[0] + x1[1] * x1[1]) + (x1[2] * x1[2] + x1[3] * x1[3]);
        q += __shfl_xor(q, 16); q += __shfl_xor(q, 32);
        if (((threadIdx.x & 63) >> 4) == 0) __hip_atomic_fetch_add(SS + row, q, __ATOMIC_RELAXED, __HIP_MEMORY_SCOPE_AGENT);
    }
};
struct FScaleBf16 {
    const float* ss; bf16* dst; float scale;
    __device__ __forceinline__ void operator()(int row, int col0, f32x4 v0, f32x4 v1) const {
        const float rs = rstd_of(ss[row], DM) * scale; *(v4u*)(dst + (size_t)row * DM + col0) = pack8(v0 * rs, v1 * rs);
    }
};
__device__ __forceinline__ float silu_f(float x) { return x / (1.0f + __expf(-x)); }
struct FGateUp {
    const float* ss; bf16* U;
    __device__ __forceinline__ void operator()(int row, int col0, f32x4 g0, f32x4 g1, f32x4 u0, f32x4 u1) const {
        const float rs = rstd_of(ss[row], DM); f32x4 a, b;
#pragma unroll
        for (int i = 0; i < 4; ++i) { a[i] = silu_f(g0[i] * rs) * (u0[i] * rs); b[i] = silu_f(g1[i] * rs) * (u1[i] * rs); }
        *(v4u*)(U + (size_t)row * DFF + col0) = pack8(a, b);
    }
};

__device__ __forceinline__ void transpose_item(const float* W, int ldw, int src_col0, int k0, bf16* WT, int K, int dst_row0, const float* gk, LAS float* scr, int lane) {
#pragma unroll 8
    for (int i = 0; i < 32; ++i) { const int kk = 2 * i + (lane >> 5); float v = W[(size_t)(k0 + kk) * ldw + src_col0 + (lane & 31)]; if (gk) v *= gk[k0 + kk]; scr[kk * 33 + (lane & 31)] = v; }
    LDS_WAIT(); asm volatile("" ::: "memory");
    const int c = lane & 7;
#pragma unroll
    for (int j = 0; j < 4; ++j) { const int n = (lane >> 3) + 8 * j; const LAS float* s = scr + (8 * c) * 33 + n;
        v4u o; o.x = pk2(s[0 * 33], s[1 * 33]); o.y = pk2(s[2 * 33], s[3 * 33]); o.z = pk2(s[4 * 33], s[5 * 33]); o.w = pk2(s[6 * 33], s[7 * 33]);
        *(v4u*)(WT + (size_t)(dst_row0 + n) * K + k0 + 8 * c) = o; }
    LDS_WAIT(); asm volatile("" ::: "memory");
}
__device__ __forceinline__ float softplus_f(float x) { return fmaxf(x, 0.f) + log1pf(__expf(-fabsf(x))); }

__device__ __forceinline__ void p0_prologue(const Args& A, LAS unsigned char* lds, int tid, int lane, int wave, int wg, int nwg) {
    unsigned char* ws = A.ws;
    const float* w_in = (const float*)A.in[12];
    LAS float* scr = (LAS float*)(lds + wave * 8448);
    const int gw = wg * NWAVES + wave, NGW = nwg * NWAVES;
    constexpr int I_IN = 16 * 96, I_SQ = 16 * 32, I_CKV = 16 * 64, I_GU = 16 * 176, I_D = 44 * 32;
    constexpr int NITEMS = I_IN + 3 * I_SQ + I_CKV + I_GU + I_D;
    for (int it = gw; it < NITEMS; it += NGW) {
        int r = it;
        if (r < I_IN) { const int kb = r / 96, n0 = 32 * (r % 96); transpose_item(w_in, INCOLS, n0 < 1536 ? n0 : n0 + 8, 64 * kb, (bf16*)(ws + WS_WIN), DM, n0, (const float*)A.in[11], scr, lane); continue; } r -= I_IN;
        if (r < I_SQ) { const int kb = r / 32, n0 = 32 * (r % 32); transpose_item((const float*)A.in[20], DM, n0, 64 * kb, (bf16*)(ws + WS_WOUT), DM, n0, nullptr, scr, lane); continue; } r -= I_SQ;
        if (r < I_SQ) { const int kb = r / 32, n0 = 32 * (r % 32); transpose_item((const float*)A.in[23], DM, n0, 64 * kb, (bf16*)(ws + WS_WCQ), DM, n0, (const float*)A.in[21], scr, lane); continue; } r -= I_SQ;
        if (r < I_SQ) { const int kb = r / 32, n0 = 32 * (r % 32); transpose_item((const float*)A.in[26], DM, n0, 64 * kb, (bf16*)(ws + WS_WCO), DM, n0, nullptr, scr, lane); continue; } r -= I_SQ;
        if (r < I_CKV) { const int kb = r / 64, n0 = 32 * (r % 64); transpose_item((const float*)A.in[n0 < 1024 ? 24 : 25], DM, n0 & 1023, 64 * kb, (bf16*)(ws + WS_WCKV), DM, n0, (const float*)A.in[22], scr, lane); continue; } r -= I_CKV;
        if (r < I_GU) { const int kb = r / 176, n0 = 32 * (r % 176); const int pn = n0 >> 8, half = (n0 >> 7) & 1, j0 = n0 & 127;
            transpose_item((const float*)A.in[half ? 29 : 28], DFF, pn * 128 + j0, 64 * kb, (bf16*)(ws + WS_WGU), DM, n0, (const float*)A.in[27], scr, lane); continue; } r -= I_GU;
        { const int kb = r / 32, n0 = 32 * (r % 32); transpose_item((const float*)A.in[30], DM, n0, 64 * kb, (bf16*)(ws + WS_WD), DFF, n0, nullptr, scr, lane); }
    }
    __syncthreads();
    LAS float* wfd = (LAS float*)lds;
    { const float* g = (const float*)A.in[11];
      for (int idx = tid; idx < 16 * DM; idx += NTHREADS) { const int k = idx >> 4, c = idx & 15; wfd[c * DM + k] = w_in[(size_t)k * INCOLS + (c < 8 ? 1536 + c : 3080 + (c - 8))] * g[k]; } }
    __syncthreads();
    bf16* XB = (bf16*)(ws + WS_XB); bf16* MB = (bf16*)(ws + WS_MB);
    float* SS0 = (float*)(ws + WS_SS0); float* SSM = (float*)(ws + WS_SSM); float* LOGF = (float*)(ws + WS_LOGF); float* DT = (float*)(ws + WS_DT); float* AA = (float*)(ws + WS_AA);
    const float* b_forget = (const float*)A.in[13]; const float* dt_bias = (const float*)A.in[16]; const float* a_log = (const float*)A.in[17];
    for (int m = gw; m < MT + MMEM; m += NGW) {
        const float* src; bf16* dst;
        if (m < MP) { src = (const float*)A.in[0] + (size_t)m * DM; dst = XB + (size_t)m * DM; }
        else if (m < MT) { src = (const float*)A.in[1] + (size_t)(m - MP) * DM; dst = XB + (size_t)m * DM; }
        else { src = (const float*)A.in[2] + (size_t)(m - MT) * DM; dst = MB + (size_t)(m - MT) * DM; }
        f32x4 v[4]; float s = 0.f;
#pragma unroll
        for (int j = 0; j < 4; ++j) { v[j] = *((const f32x4*)src + lane + 64 * j); s += (v[j][0] * v[j][0] + v[j][1] * v[j][1]) + (v[j][2] * v[j][2] + v[j][3] * v[j][3]); }
        s = wave_sum(s);
#pragma unroll
        for (int j = 0; j < 4; ++j) { unsigned long long w = (unsigned long long)pk2(v[j][0], v[j][1]) | ((unsigned long long)pk2(v[j][2], v[j][3]) << 32); *((unsigned long long*)dst + lane + 64 * j) = w; }
        if (m >= MT) { if (lane == 0) SSM[m - MT] = s; continue; }
        if (lane == 0) SS0[m] = s;
        const float rs = rstd_of(s, DM);
        float mine = 0.f;
#pragma unroll
        for (int c = 0; c < 16; ++c) { float d = 0.f;
#pragma unroll
            for (int j = 0; j < 4; ++j) { const f32x4 w = *((const LAS f32x4*)(wfd + c * DM) + lane + 64 * j); d += (v[j][0] * w[0] + v[j][1] * w[1]) + (v[j][2] * w[2] + v[j][3] * w[3]); }
            d = wave_sum(d); if (lane == c) mine = d; }
        if (lane < 8) { const float x = mine * rs + b_forget[lane]; const float lf = fminf(x, 0.f) - log1pf(__expf(-fabsf(x)));
            LOGF[(size_t)m * 8 + lane] = lf; if (m < MP) A.out[OFF_FP + (size_t)m * 8 + lane] = lf; else A.out[OFF_FS + (size_t)(m - MP) * 8 + lane] = lf; }
        else if (lane < 16) { const int h = lane - 8; const float dt = softplus_f(mine * rs + dt_bias[h]); DT[(size_t)m * 8 + h] = dt; AA[(size_t)m * 8 + h] = -__expf(a_log[h]) * dt; }
    }
}

__device__ __forceinline__ float block_excl_scan(float v, LAS float* sh, int lane, int wave) {
    float inc = v;
#pragma unroll
    for (int o = 1; o < 64; o <<= 1) { const float t = __shfl_up(inc, o); if (lane >= o) inc += t; }
    __syncthreads();
    if (lane == 63) sh[wave] = inc;
    __syncthreads();
    float base = 0.f;
    for (int w = 0; w < wave; ++w) base += sh[w];
    return base + inc - v;
}
__device__ __forceinline__ void p1_cumsum(const Args& A, LAS unsigned char* lds, int tid, int lane, int wave, int bh) {
    const float* LOGF = (const float*)(A.ws + WS_LOGF); float* CUM = (float*)(A.ws + WS_CUM);
    const int b = bh >> 3, h = bh & 7, t0 = tid * 16;
    float v[16]; float run = 0.f;
#pragma unroll
    for (int j = 0; j < 16; ++j) { run += LOGF[((size_t)b * SEQ + t0 + j) * 8 + h]; v[j] = run; }
    const float ex = block_excl_scan(run, (LAS float*)lds, lane, wave);
#pragma unroll
    for (int j = 0; j < 16; ++j) CUM[(size_t)bh * SEQ + t0 + j] = ex + v[j];
    __syncthreads();
}

__device__ __forceinline__ void p2_conv(const Args& A, int tid, int wg, int nwg) {
    const bf16* XBC = (const bf16*)(A.ws + WS_XBC); float* ACT = (float*)(A.ws + WS_ACT);
    const float* state_conv = (const float*)A.in[9]; const float* conv_w = (const float*)A.in[14]; const float* conv_b = (const float*)A.in[15];
    for (int idx = wg * NTHREADS + tid; idx < MT * 256; idx += nwg * NTHREADS) {
        const int row = idx >> 8, c4 = (idx & 255) * 4;
        f32x4 acc = *(const f32x4*)(conv_b + c4);
#pragma unroll
        for (int j = 0; j < 4; ++j) {
            const f32x4 w = *(const f32x4*)(conv_w + j * CONVCH + c4); f32x4 x = {0.f, 0.f, 0.f, 0.f}; bool have = false;
            int tt;
            if (row < MP) { tt = (row & (SEQ - 1)) - 3 + j; have = tt >= 0; }
            else { const int s = row - MP; tt = (s & 3) - 3 + j; have = tt >= 0; if (!have) x = *(const f32x4*)(state_conv + ((size_t)(s >> 2) * 3 + (tt + 3)) * CONVCH + c4); }
            if (have) { const unsigned long long u = *(const unsigned long long*)(XBC + (size_t)(row - 3 + j) * CONVCH + c4);
                x[0] = bf2f((unsigned short)u); x[1] = bf2f((unsigned short)(u >> 16)); x[2] = bf2f((unsigned short)(u >> 32)); x[3] = bf2f((unsigned short)(u >> 48)); }
            acc = acc + w * x;
        }
        f32x4 o; o[0] = silu_f(acc[0]); o[1] = silu_f(acc[1]); o[2] = silu_f(acc[2]); o[3] = silu_f(acc[3]);
        *(f32x4*)(ACT + (size_t)row * CONVCH + c4) = o;
    }
}

__device__ __forceinline__ void p3_ssd_naive(const Args& A, LAS unsigned char* lds, int lane, int wave, int wg, int nwg) {
    const float* ACT = (const float*)(A.ws + WS_ACT); const float* DT = (const float*)(A.ws + WS_DT); const float* AA = (const float*)(A.ws + WS_AA); float* Y = (float*)(A.ws + WS_Y);
    const float* state_ssm = (const float*)A.in[10]; const float* d_skip = (const float*)A.in[18];
    LAS float* bc = (LAS float*)(lds + wave * 4096);
    const int gwt = wave * nwg + wg, NGW = nwg * NWAVES;
    const int pl = lane & 15, nq = lane >> 4, n0 = nq * 32;
    for (int it = gwt; it < (NBATCH * HSSM + DB * HSSM) * 4; it += NGW) {
        const int sh = it >> 2, p = (it & 3) * 16 + pl;
        int L, row0, h; float* sout; float hs[32];
        if (sh < NBATCH * HSSM) { const int b = sh >> 3; h = sh & 7; L = SEQ; row0 = b * SEQ; sout = A.out + OFF_SP + ((size_t)sh * PS + p) * NST + n0;
#pragma unroll
            for (int n = 0; n < 32; ++n) hs[n] = 0.f; }
        else { const int s = sh - NBATCH * HSSM, b = s >> 3; h = s & 7; L = DSQ; row0 = MP + b * DSQ; sout = A.out + OFF_SS + ((size_t)s * PS + p) * NST + n0;
            const float* h0 = state_ssm + ((size_t)s * PS + p) * NST + n0;
#pragma unroll
            for (int n = 0; n < 32; n += 4) { const f32x4 t = *(const f32x4*)(h0 + n); hs[n] = t[0]; hs[n + 1] = t[1]; hs[n + 2] = t[2]; hs[n + 3] = t[3]; } }
        const int g = h >> 2; const float dsk = d_skip[h];
        float nx[4], ndt[4], na[4]; f32x2 nb[4], nc[4];
#define SSD_LOAD(t_, i_) do { const size_t r_ = (size_t)row0 + (t_); nx[i_] = ACT[r_ * CONVCH + h * PS + p]; ndt[i_] = DT[r_ * 8 + h]; na[i_] = AA[r_ * 8 + h]; \
            nb[i_] = *(const f32x2*)(ACT + r_ * CONVCH + 512 + g * NST + 2 * lane); nc[i_] = *(const f32x2*)(ACT + r_ * CONVCH + 768 + g * NST + 2 * lane); } while (0)
#pragma unroll
        for (int i = 0; i < 4; ++i) SSD_LOAD(i, i);
        for (int t0 = 0; t0 < L; t0 += 4) {
            float cx[4], cdt[4], ca[4];
#pragma unroll
            for (int i = 0; i < 4; ++i) { cx[i] = nx[i]; cdt[i] = ndt[i]; ca[i] = na[i]; *(LAS f32x2*)(bc + i * 256 + 2 * lane) = nb[i]; *(LAS f32x2*)(bc + i * 256 + 128 + 2 * lane) = nc[i]; }
            if (t0 + 4 < L) {
#pragma unroll
                for (int i = 0; i < 4; ++i) SSD_LOAD(t0 + 4 + i, i);
            }
            asm volatile("s_waitcnt lgkmcnt(0)" ::: "memory");
#pragma unroll
            for (int i = 0; i < 4; ++i) {
                const float dA = __expf(ca[i]), xdt = cx[i] * cdt[i]; float y = 0.f;
#pragma unroll
                for (int n = 0; n < 32; n += 4) {
                    const f32x4 bn = *(const LAS f32x4*)(bc + i * 256 + n0 + n), cn = *(const LAS f32x4*)(bc + i * 256 + 128 + n0 + n);
                    hs[n] = dA * hs[n] + bn[0] * xdt; y += cn[0] * hs[n];
                    hs[n + 1] = dA * hs[n + 1] + bn[1] * xdt; y += cn[1] * hs[n + 1];
                    hs[n + 2] = dA * hs[n + 2] + bn[2] * xdt; y += cn[2] * hs[n + 2];
                    hs[n + 3] = dA * hs[n + 3] + bn[3] * xdt; y += cn[3] * hs[n + 3];
                }
                y += __shfl_xor(y, 16); y += __shfl_xor(y, 32);
                if (nq == 0) Y[((size_t)row0 + t0 + i) * DSSM + h * PS + p] = y + dsk * cx[i];
            }
            asm volatile("s_waitcnt lgkmcnt(0)" ::: "memory");
        }
#undef SSD_LOAD
#pragma unroll
        for (int n = 0; n < 32; n += 4) *(f32x4*)(sout + n) = (f32x4){hs[n], hs[n + 1], hs[n + 2], hs[n + 3]};
    }
}

__device__ __forceinline__ void p3_fox_prompt_naive(const Args& A, LAS unsigned char* lds, int tid, int wg, int nwg) {
    const bf16* Qb = (const bf16*)(A.ws + WS_Q); const bf16* Kb = (const bf16*)(A.ws + WS_K); const bf16* Vb = (const bf16*)(A.ws + WS_V); const float* CUM = (const float*)(A.ws + WS_CUM);
    bf16* MIX = (bf16*)(A.ws + WS_MIX);
    LAS float* Kt = (LAS float*)lds; LAS float* Vt = Kt + 64 * 68; LAS float* cs = Vt + 64 * 68;
    const int qi = tid >> 2, part = tid & 3;
    for (int u = wg; u < NBATCH * HATT * (SEQ / 128); u += nwg) {
        const int qb = (SEQ / 128 - 1) - (u >> 4), bh = u & 15, b = bh >> 3, h = bh & 7;
        const int t = qb * 128 + qi; const size_t row = (size_t)b * SEQ + t;
        float q[64], o[64];
#pragma unroll
        for (int d = 0; d < 64; d += 8) { const v4u w = *(const v4u*)(Qb + row * DATT + h * HD + d);
            q[d] = bf2f((unsigned short)w.x); q[d + 1] = bf2f((unsigned short)(w.x >> 16)); q[d + 2] = bf2f((unsigned short)w.y); q[d + 3] = bf2f((unsigned short)(w.y >> 16));
            q[d + 4] = bf2f((unsigned short)w.z); q[d + 5] = bf2f((unsigned short)(w.z >> 16)); q[d + 6] = bf2f((unsigned short)w.w); q[d + 7] = bf2f((unsigned short)(w.w >> 16)); }
#pragma unroll
        for (int d = 0; d < 64; ++d) o[d] = 0.f;
        const float ct = CUM[(size_t)bh * SEQ + t] * LOG2E; float mx = -INFINITY, l = 0.f;
        for (int kt = 0; kt <= 2 * qb + 1; ++kt) {
            __syncthreads();
            { const int key = tid >> 3, d0 = (tid & 7) * 8; const size_t kr = ((size_t)b * SEQ + kt * 64 + key) * DATT + h * HD + d0;
              const v4u kw = *(const v4u*)(Kb + kr), vw = *(const v4u*)(Vb + kr); LAS float* kd = Kt + key * 68 + d0; LAS float* vd = Vt + key * 68 + d0;
              kd[0] = bf2f((unsigned short)kw.x); kd[1] = bf2f((unsigned short)(kw.x >> 16)); kd[2] = bf2f((unsigned short)kw.y); kd[3] = bf2f((unsigned short)(kw.y >> 16));
              kd[4] = bf2f((unsigned short)kw.z); kd[5] = bf2f((unsigned short)(kw.z >> 16)); kd[6] = bf2f((unsigned short)kw.w); kd[7] = bf2f((unsigned short)(kw.w >> 16));
              vd[0] = bf2f((unsigned short)vw.x); vd[1] = bf2f((unsigned short)(vw.x >> 16)); vd[2] = bf2f((unsigned short)vw.y); vd[3] = bf2f((unsigned short)(vw.y >> 16));
              vd[4] = bf2f((unsigned short)vw.z); vd[5] = bf2f((unsigned short)(vw.z >> 16)); vd[6] = bf2f((unsigned short)vw.w); vd[7] = bf2f((unsigned short)(vw.w >> 16));
              if (tid < 64) cs[tid] = CUM[(size_t)bh * SEQ + kt * 64 + tid] * LOG2E; }
            __syncthreads();
            for (int j = 0; j < 16; ++j) {
                const int key = 4 * j + part;
                if (kt * 64 + key <= t) {
                    const LAS f32x4* kp = (const LAS f32x4*)(Kt + key * 68); float dot = 0.f;
#pragma unroll
                    for (int d = 0; d < 16; ++d) { const f32x4 kk = kp[d]; dot += (q[4 * d] * kk[0] + q[4 * d + 1] * kk[1]) + (q[4 * d + 2] * kk[2] + q[4 * d + 3] * kk[3]); }
                    const float sc = dot + ct - cs[key];
                    if (sc > mx) { const float f = exp2f(mx - sc); l *= f;
#pragma unroll
                        for (int d = 0; d < 64; ++d) o[d] *= f;
                        mx = sc; }
                    const float p = exp2f(sc - mx); l += p;
                    const LAS f32x4* vp = (const LAS f32x4*)(Vt + key * 68);
#pragma unroll
                    for (int d = 0; d < 16; ++d) { const f32x4 vv = vp[d]; o[4 * d] += p * vv[0]; o[4 * d + 1] += p * vv[1]; o[4 * d + 2] += p * vv[2]; o[4 * d + 3] += p * vv[3]; }
                }
            }
        }
#pragma unroll
        for (int x = 1; x <= 2; x <<= 1) {
            const float mo = __shfl_xor(mx, x), lo = __shfl_xor(l, x); const float mn = fmaxf(mx, mo);
            const float fa = (mx == -INFINITY) ? 0.f : exp2f(mx - mn), fb = (mo == -INFINITY) ? 0.f : exp2f(mo - mn);
            l = l * fa + lo * fb;
#pragma unroll
            for (int d = 0; d < 64; ++d) { const float oo = __shfl_xor(o[d], x); o[d] = o[d] * fa + oo * fb; }
            mx = mn;
        }
        const float il = 1.0f / l;
#pragma unroll
        for (int d = 0; d < 16; d += 8) {
            f32x4 a, c;
#pragma unroll
            for (int i = 0; i < 4; ++i) { float va = 0.f, vc = 0.f;
#pragma unroll
                for (int pp = 0; pp < 4; ++pp) { if (part == pp) { va = o[pp * 16 + d + i]; vc = o[pp * 16 + d + 4 + i]; } }
                a[i] = va * il; c[i] = vc * il; }
            *(v4u*)(MIX + row * DM + h * HD + part * 16 + d) = pack8(a, c);
        }
    }
    __syncthreads();
}

__device__ __forceinline__ void p3_fox_sample_naive(const Args& A, int lane, int wave, int wg, int nwg) {
    const bf16* Qb = (const bf16*)(A.ws + WS_Q); const bf16* Kb = (const bf16*)(A.ws + WS_K); const bf16* Vb = (const bf16*)(A.ws + WS_V); const float* LOGF = (const float*)(A.ws + WS_LOGF);
    bf16* MIX = (bf16*)(A.ws + WS_MIX);
    const float* cache_k = (const float*)A.in[3]; const float* cache_v = (const float*)A.in[4]; const float* cache_logf = (const float*)A.in[5]; const int* page_table = (const int*)A.in[6];
    const int gw = wg * NWAVES + wave, NGW = nwg * NWAVES;
    for (int it = gw; it < DB * HATT * DSQ; it += NGW) {
        const int b = it >> 5, h = (it >> 2) & 7, t = it & 3; const size_t row = (size_t)MP + b * DSQ + t;
        float q[64], o[64];
#pragma unroll
        for (int d = 0; d < 64; d += 8) { const v4u w = *(const v4u*)(Qb + row * DATT + h * HD + d);
            q[d] = bf2f((unsigned short)w.x); q[d + 1] = bf2f((unsigned short)(w.x >> 16)); q[d + 2] = bf2f((unsigned short)w.y); q[d + 3] = bf2f((unsigned short)(w.y >> 16));
            q[d + 4] = bf2f((unsigned short)w.z); q[d + 5] = bf2f((unsigned short)(w.z >> 16)); q[d + 6] = bf2f((unsigned short)w.w); q[d + 7] = bf2f((unsigned short)(w.w >> 16)); }
#pragma unroll
        for (int d = 0; d < 64; ++d) o[d] = 0.f;
        const int phys = page_table[b * NPAGES + (lane >> 2)], tok0 = (32 * lane) & (PAGE - 1);
        const size_t kbase = ((size_t)phys * PAGE + tok0) * HATT + h;
        float tot = 0.f;
        for (int i = 0; i < 32; ++i) tot += cache_logf[kbase + (size_t)i * HATT];
        float inc = tot;
#pragma unroll
        for (int x = 1; x < 64; x <<= 1) { const float tt = __shfl_up(inc, x); if (lane >= x) inc += tt; }
        const float total = __shfl(inc, 63);
        float R = total - inc;
        float mx = -INFINITY, l = 0.f;
        for (int i = 31; i >= 0; --i) {
            const float* kp = cache_k + (kbase + (size_t)i * HATT) * HD; const float* vp = cache_v + (kbase + (size_t)i * HATT) * HD;
            float dot = 0.f;
#pragma unroll
            for (int d = 0; d < 16; ++d) { const f32x4 kk = *((const f32x4*)kp + d); dot += (q[4 * d] * kk[0] + q[4 * d + 1] * kk[1]) + (q[4 * d + 2] * kk[2] + q[4 * d + 3] * kk[3]); }
            const float sc = dot + R * LOG2E;
            R += cache_logf[kbase + (size_t)i * HATT];
            if (sc > mx) { const float f = exp2f(mx - sc); l *= f;
#pragma unroll
                for (int d = 0; d < 64; ++d) o[d] *= f;
                mx = sc; }
            const float p = exp2f(sc - mx); l += p;
#pragma unroll
            for (int d = 0; d < 16; ++d) { const f32x4 vv = *((const f32x4*)vp + d); o[4 * d] += p * vv[0]; o[4 * d + 1] += p * vv[1]; o[4 * d + 2] += p * vv[2]; o[4 * d + 3] += p * vv[3]; }
        }
        if (lane <= t) {
            const size_t kr = (size_t)MP + b * DSQ + lane; float cn = 0.f;
            for (int i = 0; i <= lane; ++i) cn += LOGF[((size_t)MP + b * DSQ + i) * 8 + h];
            float dot = 0.f;
#pragma unroll
            for (int d = 0; d < 64; ++d) dot += q[d] * bf2f(Kb[kr * DATT + h * HD + d]);
            const float sc = dot - cn * LOG2E;
            if (sc > mx) { const float f = exp2f(mx - sc); l *= f;
#pragma unroll
                for (int d = 0; d < 64; ++d) o[d] *= f;
                mx = sc; }
            const float p = exp2f(sc - mx); l += p;
#pragma unroll
            for (int d = 0; d < 64; ++d) o[d] += p * bf2f(Vb[kr * DATT + h * HD + d]);
        }
#pragma unroll
        for (int x = 1; x < 64; x <<= 1) {
            const float mo = __shfl_xor(mx, x), lo = __shfl_xor(l, x); const float mn = fmaxf(mx, mo);
            const float fa = exp2f(mx - mn), fb = exp2f(mo - mn);
            l = l * fa + lo * fb;
#pragma unroll
            for (int d = 0; d < 64; ++d) { const float oo = __shfl_xor(o[d], x); o[d] = o[d] * fa + oo * fb; }
            mx = mn;
        }
        float mine = 0.f;
#pragma unroll
        for (int d = 0; d < 64; ++d) if (lane == d) mine = o[d];
        MIX[row * DM + h * HD + lane] = (bf16)f2bf(mine / l);
    }
}

__device__ __forceinline__ void p4_gate_norm(const Args& A, int lane, int wave, int wg, int nwg) {
    const float* Y = (const float*)(A.ws + WS_Y); const bf16* Zb = (const bf16*)(A.ws + WS_Z); bf16* MIX = (bf16*)(A.ws + WS_MIX); const float* g = (const float*)A.in[19];
    const int gw = wg * NWAVES + wave, NGW = nwg * NWAVES;
    for (int row = gw; row < MT; row += NGW) {
        const f32x4 y0 = *(const f32x4*)(Y + (size_t)row * DSSM + 8 * lane), y1 = *(const f32x4*)(Y + (size_t)row * DSSM + 8 * lane + 4);
        const v4u zw = *(const v4u*)(Zb + (size_t)row * DSSM + 8 * lane);
        float z[8] = {bf2f((unsigned short)zw.x), bf2f((unsigned short)(zw.x >> 16)), bf2f((unsigned short)zw.y), bf2f((unsigned short)(zw.y >> 16)), bf2f((unsigned short)zw.z), bf2f((unsigned short)(zw.z >> 16)), bf2f((unsigned short)zw.w), bf2f((unsigned short)(zw.w >> 16))};
        float v[8]; float s = 0.f;
#pragma unroll
        for (int i = 0; i < 8; ++i) { v[i] = (i < 4 ? y0[i] : y1[i - 4]) * silu_f(z[i]); s += v[i] * v[i]; }
        const float rs = rstd_of(wave_sum(s), DSSM);
        const f32x4 g0 = *(const f32x4*)(g + 8 * lane), g1 = *(const f32x4*)(g + 8 * lane + 4);
        f32x4 a = {v[0] * rs * g0[0], v[1] * rs * g0[1], v[2] * rs * g0[2], v[3] * rs * g0[3]}, c = {v[4] * rs * g1[0], v[5] * rs * g1[1], v[6] * rs * g1[2], v[7] * rs * g1[3]};
        *(v4u*)(MIX + (size_t)row * DM + DATT + 8 * lane) = pack8(a, c);
    }
}

__device__ __forceinline__ void p7_cross_naive(const Args& A, int lane, int wave, int wg, int nwg) {
    const bf16* QC = (const bf16*)(A.ws + WS_QC); bf16* OC = (bf16*)(A.ws + WS_OC); const bf16* MKb = (const bf16*)(A.ws + WS_MK); const bf16* MVb = (const bf16*)(A.ws + WS_MV);
    const float* cmk = (const float*)A.in[7]; const float* cmv = (const float*)A.in[8];
    const int gw = wg * NWAVES + wave, NGW = nwg * NWAVES;
    for (int it = gw; it < MT * HX; it += NGW) {
        const int row = it >> 2, hd = it & 3;
        const unsigned long long qw = *(const unsigned long long*)(QC + (size_t)row * DM + hd * HDX + 4 * lane);
        const float q0 = bf2f((unsigned short)qw), q1 = bf2f((unsigned short)(qw >> 16)), q2 = bf2f((unsigned short)(qw >> 32)), q3 = bf2f((unsigned short)(qw >> 48));
        float sc[4] = {0.f, 0.f, 0.f, 0.f};
        const bool prm = row < MP; const int b = prm ? (row >> 13) : ((row - MP) >> 2);
        for (int key = 0; key < NMEM; ++key) {
            float k0, k1, k2, k3;
            if (prm) { const unsigned long long kw = *(const unsigned long long*)(MKb + ((size_t)b * NMEM + key) * DM + hd * HDX + 4 * lane);
                k0 = bf2f((unsigned short)kw); k1 = bf2f((unsigned short)(kw >> 16)); k2 = bf2f((unsigned short)(kw >> 32)); k3 = bf2f((unsigned short)(kw >> 48)); }
            else { const f32x4 kk = *(const f32x4*)(cmk + (((size_t)b * NMEM + key) * HX + hd) * HDX + 4 * lane); k0 = kk[0]; k1 = kk[1]; k2 = kk[2]; k3 = kk[3]; }
            const float s = wave_sum((q0 * k0 + q1 * k1) + (q2 * k2 + q3 * k3));
            if ((key & 63) == lane) { if ((key >> 6) == 0) sc[0] = s; else if ((key >> 6) == 1) sc[1] = s; else if ((key >> 6) == 2) sc[2] = s; else sc[3] = s; }
        }
        const float mx = wave_max(fmaxf(fmaxf(sc[0], sc[1]), fmaxf(sc[2], sc[3])));
        float p[4]; float l = 0.f;
#pragma unroll
        for (int i = 0; i < 4; ++i) { p[i] = exp2f(sc[i] - mx); l += p[i]; }
        l = wave_sum(l);
        float o0 = 0.f, o1 = 0.f, o2 = 0.f, o3 = 0.f;
        for (int key = 0; key < NMEM; ++key) {
            const int kq = key >> 6; const float pk = __shfl(kq == 0 ? p[0] : kq == 1 ? p[1] : kq == 2 ? p[2] : p[3], key & 63);
            float v0, v1, v2, v3;
            if (prm) { const unsigned long long vw = *(const unsigned long long*)(MVb + ((size_t)b * NMEM + key) * DM + hd * HDX + 4 * lane);
                v0 = bf2f((unsigned short)vw); v1 = bf2f((unsigned short)(vw >> 16)); v2 = bf2f((unsigned short)(vw >> 32)); v3 = bf2f((unsigned short)(vw >> 48)); }
            else { const f32x4 vv = *(const f32x4*)(cmv + (((size_t)b * NMEM + key) * HX + hd) * HDX + 4 * lane); v0 = vv[0]; v1 = vv[1]; v2 = vv[2]; v3 = vv[3]; }
            o0 += pk * v0; o1 += pk * v1; o2 += pk * v2; o3 += pk * v3;
        }
        const float il = 1.0f / l;
        *(unsigned long long*)(OC + (size_t)row * DM + hd * HDX + 4 * lane) = (unsigned long long)pk2(o0 * il, o1 * il) | ((unsigned long long)pk2(o2 * il, o3 * il) << 32);
    }
}

__device__ __forceinline__ void p11_final_norm(const Args& A, int lane, int wave, int wg, int nwg) {
    const float* X = (const float*)(A.ws + WS_X); const float* g = (const float*)A.in[31];
    const int gw = wg * NWAVES + wave, NGW = nwg * NWAVES;
    for (int row = gw; row < MT; row += NGW) {
        f32x4 v[4]; float s = 0.f;
#pragma unroll
        for (int j = 0; j < 4; ++j) { v[j] = *((const f32x4*)(X + (size_t)row * DM) + lane + 64 * j); s += (v[j][0] * v[j][0] + v[j][1] * v[j][1]) + (v[j][2] * v[j][2] + v[j][3] * v[j][3]); }
        const float rs = rstd_of(wave_sum(s), DM);
        float* o = A.out + (row < MP ? OFF_YP + (size_t)row * DM : OFF_YS + (size_t)(row - MP) * DM);
#pragma unroll
        for (int j = 0; j < 4; ++j) { const f32x4 gg = *((const f32x4*)g + lane + 64 * j); *((f32x4*)o + lane + 64 * j) = v[j] * rs * gg; }
    }
}

template <class Epi> __device__ __forceinline__ void run_gemm(LAS unsigned char* lds, const bf16* Am, const bf16* Bt, int M, int N, int K, int nwg, int wg, const Epi& E) {
    pg8::Gemm g{Am, Bt, M, N, K}; pg8::StaticOrder S; S.init(M, N, nwg, wg);
    pg8::gemm_phase<Epi, pg8::StaticOrder, true, true>((PG8_LAS unsigned char*)lds, g, S, E);
}

__global__ void __launch_bounds__(NTHREADS, 2) mk_fwd(Args A) {
    extern __shared__ __attribute__((aligned(16))) unsigned char lds_raw[];
    LAS unsigned char* lds = (LAS unsigned char*)lds_raw;
    const int tid = threadIdx.x, lane = tid & 63, wave = __builtin_amdgcn_readfirstlane(tid >> 6);
    const int wg = blockIdx.x, nwg = gridDim.x;
    unsigned char* ws = A.ws;
    for (int u = tid; u < (LDS_BYTES - LDSCTL_OFF) / 4; u += NTHREADS) ((LAS unsigned*)(lds + LDSCTL_OFF))[u] = 0u;
    __syncthreads();
    volatile LAS unsigned* MISC = (volatile LAS unsigned*)(lds + MISC_OFF);
    XcdBarrier bar; bar.bar = (unsigned*)(ws + WS_CTL) + CW_BAR; bar.x = 0; bar.st = nullptr;
    if (MK_ONE_LAUNCH) bar = xcd_barrier_post((unsigned*)(ws + WS_CTL) + CW_BAR, MISC + 8);
    const int lo = A.ph_lo, hi = A.ph_hi;
#define IN(k) (lo <= (k) && (k) < hi)
#define SEAM(k) do { if (MK_ONE_LAUNCH && IN(k) && IN((k) + 1)) xcd_barrier(bar); } while (0)
    bf16* XB = (bf16*)(ws + WS_XB); float* X = (float*)(ws + WS_X);

    if (IN(0)) { p0_prologue(A, lds, tid, lane, wave, wg, nwg); } SEAM(0);
    if (IN(1)) {
        if (wg < NBATCH * HATT) p1_cumsum(A, lds, tid, lane, wave, wg);
        { pg8::Epi8<FInproj> E{{(const float*)(ws + WS_SS0), (bf16*)(ws + WS_Q), (bf16*)(ws + WS_K), (bf16*)(ws + WS_V), (bf16*)(ws + WS_Z), (bf16*)(ws + WS_XBC), A.out}};
          run_gemm(lds, XB, (const bf16*)(ws + WS_WIN), MT, 3072, DM, nwg, wg, E); }
        { pg8::Epi8<FMemKV> E{{(const float*)(ws + WS_SSM), (bf16*)(ws + WS_MK), (bf16*)(ws + WS_MV), A.out}};
          run_gemm(lds, (const bf16*)(ws + WS_MB), (const bf16*)(ws + WS_WCKV), MMEM, 2048, DM, nwg, wg, E); }
    } SEAM(1);
    if (IN(2)) { p2_conv(A, tid, wg, nwg); } SEAM(2);
    if (IN(3)) { p3_ssd_naive(A, lds, lane, wave, wg, nwg); __syncthreads(); p3_fox_sample_naive(A, lane, wave, wg, nwg); p3_fox_prompt_naive(A, lds, tid, wg, nwg); } SEAM(3);
    if (IN(4)) { p4_gate_norm(A, lane, wave, wg, nwg); } SEAM(4);
    if (IN(5)) { pg8::Epi8<FRes> E{{(const float*)A.in[0], (const float*)A.in[1], X, XB, (float*)(ws + WS_SS1)}};
        run_gemm(lds, (const bf16*)(ws + WS_MIX), (const bf16*)(ws + WS_WOUT), MT, DM, DM, nwg, wg, E); } SEAM(5);
    if (IN(6)) { pg8::Epi8<FScaleBf16> E{{(const float*)(ws + WS_SS1), (bf16*)(ws + WS_QC), XC2}};
        run_gemm(lds, XB, (const bf16*)(ws + WS_WCQ), MT, DM, DM, nwg, wg, E); } SEAM(6);
    if (IN(7)) { p7_cross_naive(A, lane, wave, wg, nwg); } SEAM(7);
    if (IN(8)) { pg8::Epi8<FRes> E{{X, X + (size_t)MP * DM, X, XB, (float*)(ws + WS_SS2)}};
        run_gemm(lds, (const bf16*)(ws + WS_OC), (const bf16*)(ws + WS_WCO), MT, DM, DM, nwg, wg, E); } SEAM(8);
    if (IN(9)) { pg8::EpiGU<FGateUp> E{{(const float*)(ws + WS_SS2), (bf16*)(ws + WS_U)}};
        run_gemm(lds, XB, (const bf16*)(ws + WS_WGU), MT, 2 * DFF, DM, nwg, wg, E); } SEAM(9);
    if (IN(10)) { pg8::Epi8<FRes> E{{X, X + (size_t)MP * DM, X, nullptr, (float*)(ws + WS_SS3)}};
        run_gemm(lds, (const bf16*)(ws + WS_U), (const bf16*)(ws + WS_WD), MT, DM, DFF, nwg, wg, E); } SEAM(10);
    if (IN(11)) { p11_final_norm(A, lane, wave, wg, nwg); }
#undef IN
#undef SEAM
}

extern "C" void kernel_launch(void* const* d_in, const int* in_sizes, int n_in, void* d_out, int out_size, void* d_ws, size_t ws_size, hipStream_t stream) {
    static int grid = 0;
    if (grid == 0) {
        if (n_in != 32 || out_size != (int)OUT_TOTAL || ws_size < WS_END) { fprintf(stderr, "kernel_launch: unexpected shapes (n_in %d out %d ws %zu)\n", n_in, out_size, ws_size); grid = -1; return; }
        int dev = 0, cus = 0, per_cu = 0;
        if (hipGetDevice(&dev) != hipSuccess || hipDeviceGetAttribute(&cus, hipDeviceAttributeMultiprocessorCount, dev) != hipSuccess) { grid = -1; return; }
        if (hipFuncSetAttribute((const void*)mk_fwd, hipFuncAttributeMaxDynamicSharedMemorySize, LDS_BYTES) != hipSuccess) { fprintf(stderr, "kernel_launch: hipFuncSetAttribute failed\n"); grid = -1; return; }
        if (hipOccupancyMaxActiveBlocksPerMultiprocessor(&per_cu, (const void*)mk_fwd, NTHREADS, LDS_BYTES) != hipSuccess || per_cu < 1) fprintf(stderr, "kernel_launch: occupancy query reports %d\n", per_cu);
        (void)hipGetLastError();
        grid = cus;
    }
    if (grid < 0) return;
    (void)hipMemsetAsync((char*)d_ws + WS_CTL, 0, CTL_ZERO_BYTES, stream);
    Args a{};
    for (int i = 0; i < 32; ++i) a.in[i] = d_in[i];
    a.out = (float*)d_out; a.ws = (unsigned char*)d_ws;
    if (MK_ONE_LAUNCH) { a.ph_lo = 0; a.ph_hi = NPH; hipLaunchKernelGGL(mk_fwd, dim3(grid), dim3(NTHREADS), LDS_BYTES, stream, a); }
    else for (int p = 0; p < NPH; ++p) { a.ph_lo = p; a.ph_hi = p + 1; hipLaunchKernelGGL(mk_fwd, dim3(grid), dim3(NTHREADS), LDS_BYTES, stream, a); }
}
```

```cpp
#include <hip/hip_runtime.h>
#include <cstdio>
#include <cstdint>
#include <cmath>
#define GAS __attribute__((address_space(1)))
#define LAS __attribute__((address_space(3)))
typedef unsigned short bf16;
typedef unsigned v4u __attribute__((ext_vector_type(4)));
typedef float f32x4 __attribute__((ext_vector_type(4)));
typedef short bf16x8 __attribute__((ext_vector_type(8)));
typedef GAS unsigned gu32;
typedef GAS unsigned long long gu64;
#define RLX_AGENT __ATOMIC_RELAXED, __HIP_MEMORY_SCOPE_AGENT
#define LDS_WAIT() asm volatile("s_waitcnt lgkmcnt(0)" ::: "memory")
#define VM_WAIT() asm volatile("s_waitcnt vmcnt(0)" ::: "memory")
__device__ __forceinline__ unsigned long long rt() { return __builtin_amdgcn_s_memrealtime(); }
__device__ __forceinline__ unsigned f2bf(float f) { unsigned u = __builtin_bit_cast(unsigned, f); return (u + 0x7fffu + ((u >> 16) & 1u)) >> 16; }
__device__ __forceinline__ unsigned pk2(float lo, float hi) { return f2bf(lo) | (f2bf(hi) << 16); }
typedef float f32x2 __attribute__((ext_vector_type(2)));
namespace pg8 {
#define PG8_LAS __attribute__((address_space(3)))
typedef unsigned short bf16_t;
typedef short bf16x8 __attribute__((ext_vector_type(8)));
typedef float f32x4 __attribute__((ext_vector_type(4)));
typedef unsigned u32x4 __attribute__((ext_vector_type(4)));
constexpr int BM = 256, BK = 64, HALF = 128, HTB = HALF * BK * 2  , STAGE_BYTES = 8 * HTB, NXCD = 8, WGM = 8;

__host__ __device__ __forceinline__ int lds_byte(int r, int c) { const int st = (r >> 4) * 2 + (c >> 5), rr = r & 15, cc = c & 31, ob = rr * 64 + cc * 2; return st * 1024 + (ob ^ (((ob >> 9) & 1) << 5)); }
__host__ __device__ __forceinline__ void stage_rc(int b, int& R, int& C) { const int st = b / 1024, sb = b % 1024, swz = sb ^ (((sb >> 9) & 1) << 5); R = (st >> 1) * 16 + swz / 64; C = (st & 1) * 32 + (swz % 64) / 2; }
__host__ __device__ __forceinline__ int perm32(int rho) { const int n = rho >> 4, i = rho & 15; return 8 * (i >> 2) + 4 * n + (i & 3); }

struct Unit { int pm, pn; };
struct Gemm { const bf16_t* A; const bf16_t* Bt; int M, N, K; };

struct StaticOrder {
    int nM, nN, nwg, G, c;
    __host__ __device__ void init(int M, int N, int G_, int c_) { nM = M / BM; nN = N / BM; nwg = nM * nN; G = G_; c = c_; }
    __host__ __device__ bool next(int i, Unit& u) const {
        const long L = (long)i * G + c; if (L >= nwg) return false;
        int wgid = (int)L; { const int q = nwg / NXCD, r = nwg % NXCD, xcd = wgid % NXCD, off = wgid / NXCD; wgid = (xcd < r ? xcd * (q + 1) : r * (q + 1) + (xcd - r) * q) + off; }
        const int nig = WGM * nN, gid = wgid / nig, fm = gid * WGM, gsz = (nM - fm) < WGM ? (nM - fm) : WGM;
        u.pm = fm + ((wgid % nig) % gsz); u.pn = (wgid % nig) / gsz; return true;
    }
    __device__ __forceinline__ void a_ready(const Unit&) const {}
    __device__ __forceinline__ void done(const Unit&) const {}
};

__device__ __forceinline__ unsigned cvt_pk_bf16(float lo, float hi) { unsigned r; asm volatile("v_cvt_pk_bf16_f32 %0, %1, %2" : "=v"(r) : "v"(lo), "v"(hi)); return r; }
typedef float f32x2 __attribute__((ext_vector_type(2)));
template <class F> struct Epi8 {
    static constexpr bool PERM = true, AFTER_DRAIN = false;
    F f;
    __device__ __forceinline__ void operator()(const f32x4 (&acc)[2][2][4][2], const Unit& u, int wr, int wc, int fr, int fq) const {
        const int row0 = u.pm * BM + wr * 64 + fr, col0 = u.pn * BM + wc * 32 + 8 * fq;
#pragma unroll
        for (int ai = 0; ai < 2; ++ai) { typename F::Pre pre[4][2];
#pragma unroll
            for (int m = 0; m < 4; ++m)
#pragma unroll
                for (int bj = 0; bj < 2; ++bj) f.prefetch(row0 + ai * HALF + m * 16, col0 + bj * HALF, pre[m][bj]);
#pragma unroll
            for (int m = 0; m < 4; ++m)
#pragma unroll
                for (int bj = 0; bj < 2; ++bj) f.apply(row0 + ai * HALF + m * 16, col0 + bj * HALF, acc[ai][bj][m][0], acc[ai][bj][m][1], pre[m][bj]); }
    }
};
template <class F> struct EpiGU {
    static constexpr bool PERM = true, AFTER_DRAIN = false;
    F f;
    __device__ __forceinline__ void operator()(const f32x4 (&acc)[2][2][4][2], const Unit& u, int wr, int wc, int fr, int fq) const {
        const int row0 = u.pm * BM + wr * 64 + fr, col0 = u.pn * HALF + wc * 32 + 8 * fq;
        typename F::Pre pre[2][4];
#pragma unroll
        for (int ai = 0; ai < 2; ++ai)
#pragma unroll
            for (int m = 0; m < 4; ++m) f.prefetch(row0 + ai * HALF + m * 16, col0, pre[ai][m]);
#pragma unroll
        for (int ai = 0; ai < 2; ++ai)
#pragma unroll
            for (int m = 0; m < 4; ++m) f.apply(row0 + ai * HALF + m * 16, col0, acc[ai][0][m][0], acc[ai][0][m][1], acc[ai][1][m][0], acc[ai][1][m][1], pre[ai][m]);
    }
};
template <class Epi, class Sched, bool ALIGN_EPI = false, bool SP2 = false>
__device__ __forceinline__ void gemm_phase(PG8_LAS unsigned char* lds, const Gemm g, const Sched& S, const Epi& E) {
    const int tid = threadIdx.x, wid = __builtin_amdgcn_readfirstlane(tid >> 6), lane = tid & 63, wr = wid >> 2, wc = wid & 3, fr = lane & 15, fq = lane >> 4;
    const int K = g.K, nt = K / BK;
    unsigned voffA[2], voffB[2];
#pragma unroll
    for (int i = 0; i < 2; ++i) { int R, C; stage_rc(tid * 16 + i * 8192, R, C); const int Rb = Epi::PERM ? ((R & ~31) + perm32(R & 31)) : R;
        voffA[i] = (unsigned)(R * K + C) * 2u; voffB[i] = (unsigned)(Rb * K + C) * 2u; }
    const size_t kstep = (size_t)(BK * 2);
    const size_t hstep = (size_t)HALF * K * 2;
    const size_t tstep = 2 * hstep;
    const unsigned ldsw = (unsigned)wid * 1024u;
    const int aoff = lds_byte(wr * 64 + fr, fq * 8), boff = lds_byte(wc * 32 + fr, fq * 8);
#define PG8_SA(b, h) (((b) * 2 + (h)) * HTB)
#define PG8_SB(b, h) ((4 + (b) * 2 + (h)) * HTB)
#define PG8_STAGE(bufoff, gbase, voff) do { _Pragma("unroll") for (int _i = 0; _i < 2; ++_i) \
        __builtin_amdgcn_global_load_lds((const unsigned*)((const char*)(gbase) + (voff)[_i]), (PG8_LAS unsigned*)(lds + (bufoff) + ldsw + _i * 8192), 16, 0, 0); } while (0)
#define PG8_LDA(dst, b, h) do { _Pragma("unroll") for (int m = 0; m < 4; ++m) _Pragma("unroll") for (int k = 0; k < 2; ++k) dst[m][k] = *(const PG8_LAS bf16x8*)(lds + PG8_SA(b, h) + aoff + m * 2048 + k * 1024); } while (0)
#define PG8_LDB(dst, b, h) do { _Pragma("unroll") for (int n = 0; n < 2; ++n) _Pragma("unroll") for (int k = 0; k < 2; ++k) dst[n][k] = *(const PG8_LAS bf16x8*)(lds + PG8_SB(b, h) + boff + n * 2048 + k * 1024); } while (0)
#define PG8_MMA(ai, bj, At, Bt) do { __builtin_amdgcn_s_setprio(1); _Pragma("unroll") for (int m = 0; m < 4; ++m) _Pragma("unroll") for (int n = 0; n < 2; ++n) _Pragma("unroll") for (int k = 0; k < 2; ++k) \
        acc[ai][bj][m][n] = __builtin_amdgcn_mfma_f32_16x16x32_bf16(Bt[n][k], At[m][k], acc[ai][bj][m][n], 0, 0, 0); __builtin_amdgcn_s_setprio(0); } while (0)
#define PG8_WAIT_V(n) asm volatile("s_waitcnt vmcnt(" #n ")" ::: "memory")
#define PG8_WAIT_L(n) asm volatile("s_waitcnt lgkmcnt(" #n ")" ::: "memory")
#define PG8_BAR __builtin_amdgcn_s_barrier()
#define PG8_SCHED __builtin_amdgcn_sched_barrier(0)
    Unit cur, nxt; int ui = 0;
    if (!S.next(0, cur)) return;
    f32x4 acc[2][2][4][2];
#pragma unroll
    for (int a = 0; a < 2; ++a)
#pragma unroll
        for (int b = 0; b < 2; ++b)
#pragma unroll
            for (int m = 0; m < 4; ++m)
#pragma unroll
                for (int n = 0; n < 2; ++n) acc[a][b][m][n] = (f32x4){0.f, 0.f, 0.f, 0.f};
    bf16x8 At[4][2], B0[2][2], B1[2][2];
    const char* cA = (const char*)g.A + (size_t)cur.pm * tstep; const char* cB = (const char*)g.Bt + (size_t)cur.pn * tstep;
    S.a_ready(cur);
    if constexpr (SP2) {
        PG8_STAGE(PG8_SB(0, 0), cB, voffB); PG8_STAGE(PG8_SB(0, 1), cB + hstep, voffB); PG8_STAGE(PG8_SA(0, 0), cA, voffA); PG8_STAGE(PG8_SA(0, 1), cA + hstep, voffA);
        if (wr == 1) PG8_BAR;
        PG8_WAIT_V(2); PG8_BAR;
        PG8_STAGE(PG8_SB(1, 0), cB + kstep, voffB); PG8_STAGE(PG8_SA(1, 0), cA + kstep, voffA); PG8_STAGE(PG8_SB(1, 1), cB + hstep + kstep, voffB);
        PG8_WAIT_V(6); PG8_BAR;
    } else {
        PG8_STAGE(PG8_SB(0, 0), cB, voffB); PG8_STAGE(PG8_SA(0, 0), cA, voffA); PG8_STAGE(PG8_SB(0, 1), cB + hstep, voffB); PG8_STAGE(PG8_SA(0, 1), cA + hstep, voffA);
        if (wr == 1) PG8_BAR;
        PG8_WAIT_V(4); PG8_BAR;
        PG8_STAGE(PG8_SB(1, 0), cB + kstep, voffB); PG8_STAGE(PG8_SA(1, 0), cA + kstep, voffA); PG8_STAGE(PG8_SB(1, 1), cB + hstep + kstep, voffB);
        PG8_WAIT_V(6); PG8_BAR;
    }
    for (;;) {
        const bool has_next = S.next(ui + 1, nxt);
        const char* nA = has_next ? (const char*)g.A + (size_t)nxt.pm * tstep : cA; const char* nB = has_next ? (const char*)g.Bt + (size_t)nxt.pn * tstep : cB;
        for (int t = 0; t < nt; t += 2) {
            const bool last = (t == nt - 2);
            const char* a1 = cA + (size_t)(t + 1) * kstep;
            const char* a2 = last ? nA : cA + (size_t)(t + 2) * kstep; const char* b2 = last ? nB : cB + (size_t)(t + 2) * kstep;
            const char* a3 = a2 + kstep; const char* b3 = b2 + kstep;
            if (last && has_next) S.a_ready(nxt);
            if constexpr (SP2) {
            PG8_LDB(B0, 0, 0); PG8_LDB(B1, 0, 1); PG8_SCHED; PG8_LDA(At, 0, 0); PG8_STAGE(PG8_SA(1, 1), a1 + hstep, voffA);
            PG8_WAIT_V(8); PG8_WAIT_L(0); PG8_BAR; PG8_MMA(0, 0, At, B0); PG8_MMA(0, 1, At, B1); PG8_BAR; PG8_SCHED;
            PG8_LDA(At, 0, 1); PG8_STAGE(PG8_SB(0, 0), b2, voffB); PG8_STAGE(PG8_SB(0, 1), b2 + hstep, voffB); PG8_STAGE(PG8_SA(0, 0), a2, voffA);
            PG8_WAIT_V(8); PG8_WAIT_L(0); PG8_BAR; PG8_MMA(1, 0, At, B0); PG8_MMA(1, 1, At, B1); PG8_BAR; PG8_SCHED;
            PG8_LDB(B0, 1, 0); PG8_LDB(B1, 1, 1); PG8_SCHED; PG8_LDA(At, 1, 0); PG8_STAGE(PG8_SA(0, 1), a2 + hstep, voffA);
            PG8_WAIT_V(8); PG8_WAIT_L(0); PG8_BAR; PG8_MMA(0, 0, At, B0); PG8_MMA(0, 1, At, B1); PG8_BAR; PG8_SCHED;
            PG8_LDA(At, 1, 1); PG8_STAGE(PG8_SB(1, 0), b3, voffB); PG8_STAGE(PG8_SB(1, 1), b3 + hstep, voffB); PG8_STAGE(PG8_SA(1, 0), a3, voffA);
            PG8_WAIT_V(8); PG8_WAIT_L(0); PG8_BAR; PG8_MMA(1, 0, At, B0); PG8_MMA(1, 1, At, B1); PG8_BAR; PG8_SCHED;
            } else {
            PG8_LDB(B0, 0, 0); PG8_SCHED; PG8_LDA(At, 0, 0); PG8_STAGE(PG8_SA(1, 1), a1 + hstep, voffA);
            PG8_WAIT_L(8); PG8_BAR; PG8_WAIT_L(0); PG8_MMA(0, 0, At, B0); PG8_BAR; PG8_SCHED;
            PG8_LDB(B1, 0, 1); PG8_STAGE(PG8_SB(0, 0), b2, voffB);
            PG8_BAR; PG8_WAIT_L(0); PG8_MMA(0, 1, At, B1); PG8_BAR;
            PG8_LDA(At, 0, 1); PG8_STAGE(PG8_SA(0, 0), a2, voffA);
            PG8_BAR; PG8_WAIT_L(0); PG8_MMA(1, 0, At, B0); PG8_BAR; PG8_SCHED;
            PG8_STAGE(PG8_SB(0, 1), b2 + hstep, voffB);
            PG8_WAIT_V(6); PG8_BAR; PG8_MMA(1, 1, At, B1); PG8_BAR;
            PG8_LDB(B0, 1, 0); PG8_SCHED; PG8_LDA(At, 1, 0); PG8_STAGE(PG8_SA(0, 1), a2 + hstep, voffA);
            PG8_WAIT_L(8); PG8_BAR; PG8_WAIT_L(0); PG8_MMA(0, 0, At, B0); PG8_BAR; PG8_SCHED;
            PG8_LDB(B1, 1, 1); PG8_STAGE(PG8_SB(1, 0), b3, voffB);
            PG8_BAR; PG8_WAIT_L(0); PG8_MMA(0, 1, At, B1); PG8_BAR;
            PG8_LDA(At, 1, 1); PG8_STAGE(PG8_SA(1, 0), a3, voffA);
            PG8_BAR; PG8_WAIT_L(0); PG8_MMA(1, 0, At, B0); PG8_BAR; PG8_SCHED;
            PG8_STAGE(PG8_SB(1, 1), b3 + hstep, voffB);
            PG8_WAIT_V(6); PG8_BAR; PG8_MMA(1, 1, At, B1); PG8_BAR;
            }
        }
        if constexpr (ALIGN_EPI) { if (wr == 0) PG8_BAR; }
        if constexpr (!Epi::AFTER_DRAIN) { E(acc, cur, wr, wc, fr, fq); S.done(cur); }
        if (!has_next) break;
#pragma unroll
        for (int a = 0; a < 2; ++a)
#pragma unroll
            for (int b = 0; b < 2; ++b)
#pragma unroll
                for (int m = 0; m < 4; ++m)
#pragma unroll
                    for (int n = 0; n < 2; ++n) acc[a][b][m][n] = (f32x4){0.f, 0.f, 0.f, 0.f};
        cur = nxt; cA = nA; cB = nB; ++ui;
        if constexpr (ALIGN_EPI) { if (wr == 1) PG8_BAR; }
    }
    PG8_WAIT_V(0);
    if constexpr (!ALIGN_EPI) { if (wr == 0) PG8_BAR; }
    PG8_BAR;
    if constexpr (Epi::AFTER_DRAIN) { E.fused(acc, cur, wr, wc, fr, fq, lds, wid, lane); S.done(cur); }
#undef PG8_SA
#undef PG8_SB
#undef PG8_STAGE
#undef PG8_LDA
#undef PG8_LDB
#undef PG8_MMA
#undef PG8_WAIT_V
#undef PG8_WAIT_L
#undef PG8_BAR
#undef PG8_SCHED
}
}
#define XB_TMO      128
#define XB_XCNT(j)  (256  + 64 * (j))
#define XB_XSUB(j)  (1280 + 64 * (j))
#define XB_XGEN(j)  (2304 + 64 * (j))
#define XB_TOP      3328
#define XB_TOPGEN   3392
#define XCD_BAR_WORDS 3456
#define XB_SPIN_CAP (1u << 18)

__device__ __forceinline__ unsigned xb_ld(unsigned* p)              { return __hip_atomic_load(p, __ATOMIC_RELAXED, __HIP_MEMORY_SCOPE_AGENT); }
__device__ __forceinline__ unsigned xb_add(unsigned* p, unsigned v) { return __hip_atomic_fetch_add(p, v, __ATOMIC_RELAXED, __HIP_MEMORY_SCOPE_AGENT); }
__device__ __forceinline__ unsigned xb_xcc_id() { return (unsigned)__builtin_amdgcn_s_getreg((3 << 11) | 20) & 0xFu; }
#define XB_SPIN(cond, bar) do { unsigned _sp = 0; while (cond) { __builtin_amdgcn_s_sleep(1); \
    if ((++_sp & 255u) == 0u) { if (xb_ld(&(bar)[XB_TMO])) break; if (_sp > XB_SPIN_CAP) { atomicAdd(&(bar)[XB_TMO], 1u); break; } } } } while (0)

struct XcdBarrier {
    unsigned* bar; unsigned x;
    volatile LAS unsigned* st;
};

__device__ __forceinline__ XcdBarrier xcd_barrier_post(unsigned* bar, volatile LAS unsigned* st) {
    XcdBarrier b; b.bar = bar; b.x = xb_xcc_id(); b.st = st;
    if (threadIdx.x == 0) (void)xb_add(&bar[XB_XCNT(b.x)], 1u);
    return b;
}
__device__ __forceinline__ void xcd_barrier_complete(unsigned* bar, unsigned x, unsigned& nloc, unsigned& nx) {
    const unsigned G = gridDim.x * gridDim.y * gridDim.z;
    unsigned sum, cnt, mine, sp = 0u;
    for (;;) {
        sum = 0u; cnt = 0u; mine = 0u;
#pragma unroll
        for (unsigned j = 0; j < 16; ++j) { const unsigned c = xb_ld(&bar[XB_XCNT(j)]); sum += c; cnt += (c > 0u) ? 1u : 0u; mine = (j == x) ? c : mine; }
        if (sum == G) break;
        __builtin_amdgcn_s_sleep(1);
        if ((++sp & 255u) == 0u) { if (xb_ld(&bar[XB_TMO])) break; if (sp > XB_SPIN_CAP) { atomicAdd(&bar[XB_TMO], 1u); break; } }
    }
    nloc = mine > 0u ? mine : 1u; nx = cnt > 0u ? cnt : 1u;
}

__device__ __forceinline__ void xcd_barrier(const XcdBarrier& b) {
    asm volatile("s_waitcnt vmcnt(0)" ::: "memory");
    __syncthreads();
    if (threadIdx.x == 0) {
        unsigned* bar = b.bar;
        __builtin_amdgcn_s_waitcnt(0);
        unsigned nloc = b.st[0], nx = b.st[1];
        if (nloc == 0u) { xcd_barrier_complete(bar, b.x, nloc, nx); b.st[0] = nloc; b.st[1] = nx; }
        const unsigned old = xb_add(&bar[XB_XSUB(b.x)], 1u);
        const unsigned gen = old / nloc;
        if (old + 1u == (gen + 1u) * nloc) {
            __builtin_amdgcn_fence(__ATOMIC_RELEASE, "agent");
            asm volatile("s_waitcnt vmcnt(0)" ::: "memory");
            const unsigned og = xb_add(&bar[XB_TOP], 1u);
            const unsigned tg = og / nx;
            if (og + 1u == (tg + 1u) * nx) xb_add(&bar[XB_TOPGEN], 1u);
            else XB_SPIN(xb_ld(&bar[XB_TOPGEN]) == tg, bar);
            __builtin_amdgcn_fence(__ATOMIC_ACQUIRE, "agent");
            xb_add(&bar[XB_XGEN(b.x)], 1u);
            asm volatile("s_waitcnt vmcnt(0)" ::: "memory");
        } else {
            XB_SPIN(xb_ld(&bar[XB_XGEN(b.x)]) == gen, bar);
            __builtin_amdgcn_fence(__ATOMIC_ACQUIRE, "agent");
            asm volatile("s_waitcnt vmcnt(0)" ::: "memory");
        }
    }
    __syncthreads();
}
#include <hip/hip_bf16.h>
#include <cmath>
namespace attn_body {
using bf16=__hip_bfloat16;
using bf16x8=__attribute__((ext_vector_type(8)))short;
using s16x4=__attribute__((ext_vector_type(4)))short;
using f32x16=__attribute__((ext_vector_type(16)))float;
using u32x4=__attribute__((ext_vector_type(4)))unsigned;
constexpr int BATCH=2,NHEAD=8,SEQ=8192,D=64,DM=NHEAD*D,ODM=1024;
constexpr int NW=8,QBLK=32,QB=QBLK*NW,KVBLK=64,NQB=SEQ/QB;
constexpr int ATTN_PITCH=DM, ATTN_UNIT_ROWS=QB;
__device__ __forceinline__ int crow(int r,int hi){return (r&3)+8*(r>>2)+4*hi;}
#define SBAR() __builtin_amdgcn_sched_barrier(0)
__device__ __forceinline__ void cmask(f32x16&p0,f32x16&p1,int jb,int qrel,int hi){
  const float NEG=-INFINITY; int kb=64*jb+4*hi;
  #pragma unroll
  for(int r=0;r<16;++r){int kv=kb+(r&3)+8*(r>>2); if(kv>qrel)p0[r]=NEG; if(kv+32>qrel)p1[r]=NEG;}
}

constexpr int NSLOT=3, SLOTB=8192;
constexpr int LDS_K=0, LDS_V=NSLOT*SLOTB, LDS_WS=2*NSLOT*SLOTB, LDS_OST=LDS_WS+NW*64*4, LDS_BYTES=LDS_OST+NW*4096; constexpr int LDS_KBIAS=LDS_BYTES, LDS_KZERO=LDS_KBIAS+SEQ*8;
constexpr float C2=0.125f*1.4426950408889634f;
__device__ __forceinline__ void glds16(const void*gsrc,unsigned lds_dst){unsigned keep;
  asm volatile("s_mov_b32 %0, m0\n\ts_mov_b32 m0, %2\n\ts_nop 0\n\tglobal_load_lds_dwordx4 %1, off\n\ts_mov_b32 m0, %0":"=&s"(keep):"v"(gsrc),"s"(lds_dst):"memory");}
__device__ __forceinline__ float max3f(float a,float b,float c){float r;asm("v_max3_f32 %0, %1, %2, %3":"=v"(r):"v"(a),"v"(b),"v"(c));return r;}
__device__ __forceinline__ float max2f(float a,float b){float r;asm("v_max_f32_e32 %0, %1, %2":"=v"(r):"v"(a),"v"(b));return r;}
__device__ __forceinline__ float fadd_s(float a,float b){float r;asm("v_add_f32_e32 %0, %1, %2":"=v"(r):"v"(a),"v"(b));return r;}
__device__ __forceinline__ float fsub_s(float a,float b){float r;asm("v_sub_f32_e32 %0, %1, %2":"=v"(r):"v"(a),"v"(b));return r;}
typedef float f32x2_t __attribute__((ext_vector_type(2))); typedef float f32x4_t __attribute__((ext_vector_type(4))); typedef __bf16 bf16x2_t __attribute__((ext_vector_type(2)));
__device__ __forceinline__ unsigned cvtpk_s(float lo,float hi){f32x2_t v={lo,hi};bf16x2_t b=__builtin_convertvector(v,bf16x2_t);return __builtin_bit_cast(unsigned,b);}
#define WAIT_BAR(N) asm volatile("s_waitcnt vmcnt(" #N ") lgkmcnt(0)\n\ts_barrier":::"memory")

__device__ __forceinline__ void qkt(f32x16&p0,f32x16&p1,const char*Kslot,const bf16x8*qr,const f32x16&negm,int r32,int hi){
  const char*kb=Kslot+hi*1024+r32*16;
  #pragma unroll
  for(int d0=0;d0<4;++d0){
    const bf16x8 b0=*reinterpret_cast<const bf16x8*>(kb+d0*2048);
    const bf16x8 b1=*reinterpret_cast<const bf16x8*>(kb+d0*2048+512);
    if(d0==0){p0=__builtin_amdgcn_mfma_f32_32x32x16_bf16(b0,qr[0],negm,0,0,0);p1=__builtin_amdgcn_mfma_f32_32x32x16_bf16(b1,qr[0],negm,0,0,0);}
    else{p0=__builtin_amdgcn_mfma_f32_32x32x16_bf16(b0,qr[d0],p0,0,0,0);p1=__builtin_amdgcn_mfma_f32_32x32x16_bf16(b1,qr[d0],p1,0,0,0);}}
}
typedef __attribute__((address_space(3))) const char* lds_cptr;
typedef short v4i16_t __attribute__((ext_vector_type(4)));
__device__ __forceinline__ void kload8(bf16x8*kf,lds_cptr kp){
  kf[0]=*(const __attribute__((address_space(3))) bf16x8*)(kp);      kf[1]=*(const __attribute__((address_space(3))) bf16x8*)(kp+512);
  kf[2]=*(const __attribute__((address_space(3))) bf16x8*)(kp+2048); kf[3]=*(const __attribute__((address_space(3))) bf16x8*)(kp+2560);
  kf[4]=*(const __attribute__((address_space(3))) bf16x8*)(kp+4096); kf[5]=*(const __attribute__((address_space(3))) bf16x8*)(kp+4608);
  kf[6]=*(const __attribute__((address_space(3))) bf16x8*)(kp+6144); kf[7]=*(const __attribute__((address_space(3))) bf16x8*)(kp+6656);
}
__device__ __forceinline__ void kload2(bf16x8*kf,lds_cptr kp,int j){ kf[2*j]=*(const __attribute__((address_space(3))) bf16x8*)(kp+j*2048); kf[2*j+1]=*(const __attribute__((address_space(3))) bf16x8*)(kp+j*2048+512); }
__device__ __forceinline__ s16x4 vtr(lds_cptr p){ return __builtin_bit_cast(s16x4,__builtin_amdgcn_ds_read_tr16_b64_v4i16((__attribute__((address_space(3))) v4i16_t*)p)); }
__device__ __forceinline__ float rowmax(const f32x16&p0,const f32x16&p1){
  float a=max3f(p0[0],p0[1],p1[0]),b=max3f(p0[2],p0[3],p1[1]);a=max3f(a,p1[2],p1[3]);
  #pragma unroll
  for(int r=4;r<16;r+=4){a=max3f(a,p0[r],p0[r+1]);b=max3f(b,p0[r+2],p0[r+3]);a=max3f(a,p1[r],p1[r+1]);b=max3f(b,p1[r+2],p1[r+3]);}
  const float m=max2f(a,b);
  auto rr=__builtin_amdgcn_permlane32_swap(__float_as_uint(m),__float_as_uint(m),false,false);
  return max2f(__uint_as_float(rr[0]),__uint_as_float(rr[1]));
}
__device__ __forceinline__ void pv(f32x16*o,int vb,bf16x8 pa0,bf16x8 pa1,bf16x8 pa2,bf16x8 pa3){
  #pragma unroll
  for(int d0=0;d0<2;++d0){s16x4 lo[4],hi[4];
    #pragma unroll
    for(int ks=0;ks<4;++ks){
      asm volatile("ds_read_b64_tr_b16 %0,%1 offset:%c2":"=&v"(lo[ks]):"v"(vb),"i"(d0*4096+ks*1024):"memory");
      asm volatile("ds_read_b64_tr_b16 %0,%1 offset:%c2":"=&v"(hi[ks]):"v"(vb),"i"(d0*4096+ks*1024+512):"memory");}
    asm volatile("s_waitcnt lgkmcnt(0)":::"memory");SBAR();
    #define PK(k) (bf16x8){lo[k][0],lo[k][1],lo[k][2],lo[k][3],hi[k][0],hi[k][1],hi[k][2],hi[k][3]}
    o[d0]=__builtin_amdgcn_mfma_f32_32x32x16_bf16(pa0,PK(0),o[d0],0,0,0);
    o[d0]=__builtin_amdgcn_mfma_f32_32x32x16_bf16(pa1,PK(1),o[d0],0,0,0);
    o[d0]=__builtin_amdgcn_mfma_f32_32x32x16_bf16(pa2,PK(2),o[d0],0,0,0);
    o[d0]=__builtin_amdgcn_mfma_f32_32x32x16_bf16(pa3,PK(3),o[d0],0,0,0);
    #undef PK
  }
}

#ifndef ATTN_STORE16
#define ATTN_STORE16(p,v) (*(u32x4*)(p)=(v))
#endif
template<int THRL> __device__ __forceinline__ void attn_unit(int b,int h,int qb,const bf16*Q,const bf16*__restrict__ K,const bf16*__restrict__ V,bf16*O,const float*__restrict__ CUM,const float*__restrict__ KN,const float*__restrict__ QN,char*shm){
  int tid_=threadIdx.x; asm volatile("":"+v"(tid_));
  const int tid=tid_,lane=tid&63,r32=lane&31,hi=lane>>5; const int wid=__builtin_amdgcn_readfirstlane(tid>>6);
  const long rowbase=(long)b*SEQ; const int q0=qb*QB;
  const bf16*Qw=Q+(rowbase+q0+wid*QBLK)*DM+h*D;
  const int NTF=(q0+QB)/KVBLK; int t0;
  { const float*cb=CUM+(long)(b*NHEAD+h)*SEQ; const float*kn=KN+(b*NHEAD+h)*(SEQ/KVBLK); const float*qn=QN+(b*NHEAD+h)*(SEQ/KVBLK); const float cref=cb[q0];
    const float kd=fmaxf(fmaxf(kn[NTF-4],kn[NTF-3]),fmaxf(kn[NTF-2],kn[NTF-1])), qm=1.01f*fmaxf(fmaxf(qn[NTF-4],qn[NTF-3]),fmaxf(qn[NTF-2],qn[NTF-1]));
    const int nb_=NTF-4, j0=lane, j1=lane+64; bool ok0=false, ok1=false;
    if(j0<nb_) ok0=((cref-cb[64*j0+63])*1.4426950408889634f+qm*(kn[j0]+kd)+1.0f<=-64.0f);
    if(j1<nb_) ok1=((cref-cb[64*j1+63])*1.4426950408889634f+qm*(kn[j1]+kd)+1.0f<=-64.0f);
    const unsigned long long m0=__ballot(!ok0), m1=__ballot(!ok1);
    const int f_=m0?__builtin_ctzll(m0):(m1?64+__builtin_ctzll(m1):128);
    t0=__builtin_amdgcn_readfirstlane((f_<nb_?f_:nb_)&~1); }
  const bf16*Kh=K+(rowbase+(long)t0*KVBLK)*DM+h*D,*Vh=V+(rowbase+(long)t0*KVBLK)*DM+h*D;
  const unsigned lds0=(unsigned)(uintptr_t)shm;
  float*wsf=(float*)(shm+LDS_WS)+wid*64;
  const bf16*ksrc=Kh+(long)lane*DM+wid*8;
  const bf16*vsrc=Vh+(long)(16*(wid&3)+(lane>>2))*DM+(wid>>2)*32+(lane&3)*8;
  const unsigned kdst=lds0+LDS_K+wid*1024, vdst=lds0+LDS_V+wid*1024;
  #define DMA_K(t,slot) glds16(ksrc+(long)(t)*KVBLK*DM,(unsigned)__builtin_amdgcn_readfirstlane(kdst+(slot)))
  #define DMA_V(t,slot) glds16(vsrc+(long)(t)*KVBLK*DM,(unsigned)__builtin_amdgcn_readfirstlane(vdst+(slot)))
  const int vb0=(int)(lds0+LDS_V)+((lane>>4)&1)*32+(lane&3)*8+(4*hi+((lane&15)>>2))*64;
  const char*Kbase=shm+LDS_K; bf16x8 kf[8];
  const lds_cptr shm3=(lds_cptr)shm; const lds_cptr kp0=shm3+LDS_K+hi*1024+r32*16; const lds_cptr vp0=shm3+LDS_V+((lane>>4)&1)*32+(lane&3)*8+(4*hi+((lane&15)>>2))*64;
  const int NT=NTF-t0;
  { const float*cb=CUM+(long)(b*NHEAD+h)*SEQ; const float cref=cb[q0];
    __attribute__((address_space(3))) unsigned long long*kbw=(__attribute__((address_space(3))) unsigned long long*)((__attribute__((address_space(3))) char*)shm+LDS_KBIAS);
    float cv_[16];
    _Pragma("unroll") for(int j=0;j<16;++j){ const int i=tid+NW*64*j; cv_[j]=(i<NT*KVBLK)?cb[i+t0*KVBLK]:cref; }
    _Pragma("unroll") for(int j=0;j<16;++j){ const int i=tid+NW*64*j; if(i<NT*KVBLK){ const float bv=(cref-cv_[j])*1.4426950408889634f;
      const unsigned hb=__float_as_uint(bv)&0xffff0000u; const float r1=bv-__uint_as_float(hb); const unsigned mb=__float_as_uint(r1)&0xffff0000u; const float r2=r1-__uint_as_float(mb);
      const unsigned lb=__float_as_uint(r2)>>16; kbw[i]=(unsigned long long)((hb>>16)|mb)|((unsigned long long)lb<<32); } }
    if(tid==0)kbw[SEQ]=0ull; }
  const __attribute__((address_space(3))) unsigned long long* kaug_p=(const __attribute__((address_space(3))) unsigned long long*)((lds_cptr)shm+(hi?LDS_KZERO:LDS_KBIAS+r32*8));
  const int kaug_s=hi?0:KVBLK, kaug_h=hi?0:32;
  bf16x8 qaug; { u32x4 qa_={0x3f803f80u,0x00003f80u,0u,0u}; asm volatile("":"+v"(qa_)); qaug=__builtin_bit_cast(bf16x8,qa_); }
  #define KAUG(t,half) __builtin_bit_cast(bf16x8,(u32x4){(unsigned)kaug_p[(t)*kaug_s+(half)*kaug_h],(unsigned)(kaug_p[(t)*kaug_s+(half)*kaug_h]>>32),0u,0u})
  DMA_K(0,0);DMA_V(0,0);DMA_K(1,SLOTB);
  bf16x8 qr[4];
  #pragma unroll
  for(int d0=0;d0<4;++d0)qr[d0]=*reinterpret_cast<const bf16x8*>(&Qw[(long)r32*DM+d0*16+hi*8]);
  float zz_; asm volatile("v_mov_b32 %0, 0":"=v"(zz_));
  float mhat=0.f,l_reg=0.f;f32x16 o[2],negm;
  _Pragma("unroll") for(int r=0;r<16;++r){o[0][r]=zz_;o[1][r]=zz_;negm[r]=zz_;} asm volatile("":"+v"(negm));
  const int qrel=wid*QBLK+r32;
  #define CMASK(P0,P1,t) do{int jb_=(t)-(NT-4); if(jb_>=0)cmask(P0,P1,jb_,qrel,hi);}while(0)
  bool resc=false;
  #define START(P0,P1) do{ const float rm=rowmax(P0,P1); resc=false; \
    { const float dl=rm; mhat=fadd_s(mhat,dl); \
      _Pragma("unroll") for(int r=0;r<16;++r){P0[r]=fsub_s(P0[r],dl);P1[r]=fsub_s(P1[r],dl);} \
      _Pragma("unroll") for(int r=0;r<16;++r)negm[r]=-mhat; asm volatile("":"+v"(negm)); } \
    _Pragma("unroll") for(int r=0;r<16;++r)P0[r]=__builtin_amdgcn_exp2f(P0[r]); }while(0)
  #define RESC() do{ if(resc){ asm volatile("s_waitcnt lgkmcnt(0)":::"memory"); \
      _Pragma("unroll") for(int d_=0;d_<2;++d_) _Pragma("unroll") for(int r=0;r<16;++r)o[d_][r]*=wsf[crow(r,hi)]; } }while(0)
  f32x16 pA0,pA1,pB0,pB1;
  int sl_prev=0,sl_cur=0,sl_next=SLOTB;
  #define ROT() do{sl_prev=sl_cur;sl_cur=sl_next;sl_next=(sl_next==(NSLOT-1)*SLOTB)?0:sl_next+SLOTB;}while(0)
  DMA_K(2,2*SLOTB);
  WAIT_BAR(3);
  qkt(pA0,pA1,Kbase,qr,negm,r32,hi);{const bf16x8 ka0_=KAUG(0,0),ka1_=KAUG(0,1);pA0=__builtin_amdgcn_mfma_f32_32x32x16_bf16(ka0_,qaug,pA0,0,0,0);pA1=__builtin_amdgcn_mfma_f32_32x32x16_bf16(ka1_,qaug,pA1,0,0,0);}asm volatile("s_nop 15\n\ts_nop 7":"+v"(pA0),"+v"(pA1));CMASK(pA0,pA1,0);
  START(pA0,pA1);
  _Pragma("unroll") for(int r=0;r<16;++r)pA1[r]=__builtin_amdgcn_exp2f(pA1[r]);
  WAIT_BAR(0);
  DMA_K(3,0);DMA_V(1,SLOTB);
  ROT();
  kload8(kf,kp0+sl_cur);
  WAIT_BAR(2);
  s16x4 vlo[8],vhi[8]; u32x4 pw0,pw1,pw2,pw3;
  #define PKW(P,B) cvtpk_s(P[B],P[B+1])
  #define PAF(k) __builtin_bit_cast(bf16x8,pw##k)
  #define VFR(i) (bf16x8){vlo[i][0],vlo[i][1],vlo[i][2],vlo[i][3],vhi[i][0],vhi[i][1],vhi[i][2],vhi[i][3]}
  #define PIN(x) asm volatile("":"+v"(x))
  #define MX3(a,b,c) __builtin_fmaxf(__builtin_fmaxf((a),(b)),(c))
  #define GAPA(MF,A0,A1,A2,A3,W0,W1,PW) do{ MF; sacc+=A0; sacc+=A1; sacc+=A2; sacc+=A3; PIN(sacc); W0; W1; PIN(PW); SBAR(); }while(0)
  #define EX(v) __builtin_amdgcn_exp2f(v)
  #define GAPB(MF,X,B) do{ MF; X[B]=EX(X[B]); X[B+1]=EX(X[B+1]); X[B+2]=EX(X[B+2]); X[B+3]=EX(X[B+3]); PIN(X); SBAR(); }while(0)
  #define VRD(i) do{ vlo[i]=vtr(vp_+(((i)>>2)*4096+((i)&3)*1024)); vhi[i]=vtr(vp_+(((i)>>2)*4096+((i)&3)*1024+512)); }while(0)
  #define KRD(G,j) do{ if(G){ kload2(kf,kp0+sl_next,j); SBAR(); } }while(0)
  #define STEP(C0,C1,P0,P1,t,GK,GV,GL) do{ SBAR(); \
    const lds_cptr vp_=vp0+sl_prev; \
    const bf16x8 ka0_=KAUG(t,0),ka1_=KAUG(t,1); VRD(0); SBAR(); float sacc=(P0[0]+P0[1]); \
    GAPA(C0=__builtin_amdgcn_mfma_f32_32x32x16_bf16(kf[0],qr[0],negm,0,0,0), P0[2],P0[3],P0[4],P0[5],     pw0[0]=PKW(P0,0), pw0[1]=PKW(P0,2), pw0); \
    VRD(4); SBAR(); GAPA(C1=__builtin_amdgcn_mfma_f32_32x32x16_bf16(kf[1],qr[0],negm,0,0,0), P0[6],P0[7],P0[8],P0[9],     pw0[2]=PKW(P0,4), pw0[3]=PKW(P0,6), pw0); \
    VRD(1); SBAR(); GAPA(C0=__builtin_amdgcn_mfma_f32_32x32x16_bf16(kf[2],qr[1],C0,0,0,0),   P0[10],P0[11],P0[12],P0[13], pw1[0]=PKW(P0,8), pw1[1]=PKW(P0,10), pw1); \
    VRD(5); SBAR(); GAPA(C1=__builtin_amdgcn_mfma_f32_32x32x16_bf16(kf[3],qr[1],C1,0,0,0),   P0[14],P0[15],P1[0],P1[1],   pw1[2]=PKW(P0,12),pw1[3]=PKW(P0,14), pw1); \
    VRD(2); SBAR(); GAPA(C0=__builtin_amdgcn_mfma_f32_32x32x16_bf16(kf[4],qr[2],C0,0,0,0),   P1[2],P1[3],P1[4],P1[5],     pw2[0]=PKW(P1,0), pw2[1]=PKW(P1,2), pw2); \
    VRD(6); SBAR(); GAPA(C1=__builtin_amdgcn_mfma_f32_32x32x16_bf16(kf[5],qr[2],C1,0,0,0),   P1[6],P1[7],P1[8],P1[9],     pw2[2]=PKW(P1,4), pw2[3]=PKW(P1,6), pw2); \
    VRD(3); SBAR(); GAPA(C0=__builtin_amdgcn_mfma_f32_32x32x16_bf16(kf[6],qr[3],C0,0,0,0),   P1[10],P1[11],P1[12],P1[13], pw3[0]=PKW(P1,8), pw3[1]=PKW(P1,10), pw3); \
    VRD(7); SBAR(); GAPA(C1=__builtin_amdgcn_mfma_f32_32x32x16_bf16(kf[7],qr[3],C1,0,0,0),   P1[14],P1[15],0.f,0.f,       pw3[2]=PKW(P1,12),pw3[3]=PKW(P1,14), pw3); \
    C0=__builtin_amdgcn_mfma_f32_32x32x16_bf16(ka0_,qaug,C0,0,0,0); C1=__builtin_amdgcn_mfma_f32_32x32x16_bf16(ka1_,qaug,C1,0,0,0); SBAR(); \
    l_reg+=sacc; \
    if(GK){DMA_K((t)+3,sl_cur);} if(GV){DMA_V((t)+1,sl_next);} \
    CMASK(C0,C1,t); \
    { float a=MX3(C0[0],C0[1],C1[0]),b=MX3(C0[2],C0[3],C1[1]); a=MX3(a,C1[2],C1[3]); \
      _Pragma("unroll") for(int r=4;r<16;r+=4){a=MX3(a,C0[r],C0[r+1]);b=MX3(b,C0[r+2],C0[r+3]);a=MX3(a,C1[r],C1[r+1]);b=MX3(b,C1[r+2],C1[r+3]);} \
      float rm=__builtin_fmaxf(a,b); { auto rr=__builtin_amdgcn_permlane32_swap(__float_as_uint(rm),__float_as_uint(rm),false,false); rm=__builtin_fmaxf(__uint_as_float(rr[0]),__uint_as_float(rr[1])); } \
      resc=false; \
      if(__builtin_expect(__any(rm>(float)THRL),0)){ const float dl=__builtin_fmaxf(rm,0.f); mhat+=dl; \
        _Pragma("unroll") for(int r=0;r<16;++r){C0[r]-=dl;C1[r]-=dl;} \
        _Pragma("unroll") for(int r=0;r<16;++r)negm[r]=-mhat; asm volatile("":"+v"(negm)); \
        const float f=__builtin_amdgcn_exp2f(-dl); l_reg*=f; if(hi==0)wsf[r32]=f; resc=true; } } \
    SBAR(); \
    GAPB(o[0]=__builtin_amdgcn_mfma_f32_32x32x16_bf16(PAF(0),VFR(0),o[0],0,0,0), C0,0); \
    GAPB(o[1]=__builtin_amdgcn_mfma_f32_32x32x16_bf16(PAF(0),VFR(4),o[1],0,0,0), C0,4); \
    KRD(GL,0); GAPB(o[0]=__builtin_amdgcn_mfma_f32_32x32x16_bf16(PAF(1),VFR(1),o[0],0,0,0), C0,8); \
    KRD(GL,1); GAPB(o[1]=__builtin_amdgcn_mfma_f32_32x32x16_bf16(PAF(1),VFR(5),o[1],0,0,0), C0,12); \
    KRD(GL,2); GAPB(o[0]=__builtin_amdgcn_mfma_f32_32x32x16_bf16(PAF(2),VFR(2),o[0],0,0,0), C1,0); \
    KRD(GL,3); GAPB(o[1]=__builtin_amdgcn_mfma_f32_32x32x16_bf16(PAF(2),VFR(6),o[1],0,0,0), C1,4); \
    GAPB(o[0]=__builtin_amdgcn_mfma_f32_32x32x16_bf16(PAF(3),VFR(3),o[0],0,0,0), C1,8); \
    GAPB(o[1]=__builtin_amdgcn_mfma_f32_32x32x16_bf16(PAF(3),VFR(7),o[1],0,0,0), C1,12); \
    }while(0)
  int t=1;
  #undef CMASK
  #define CMASK(P0,P1,t) do{}while(0)
  for(;t+5<NT;t+=2){
    STEP(pB0,pB1,pA0,pA1,t,true,true,true);     WAIT_BAR(2); RESC(); ROT();
    STEP(pA0,pA1,pB0,pB1,t+1,true,true,true);   WAIT_BAR(2); RESC(); ROT();
  }
  #undef CMASK
  #define CMASK(P0,P1,t) do{int jb_=(t)-(NT-4); if(jb_>=0)cmask(P0,P1,jb_,qrel,hi);}while(0)
  #define ENDW(tt) do{ if((tt)+3<NT){WAIT_BAR(2);} else if((tt)+2<NT){WAIT_BAR(1);} else {WAIT_BAR(0);} }while(0)
  for(;t+1<NT;t+=2){
    STEP(pB0,pB1,pA0,pA1,t,(t+3<NT),(t+1<NT),(t+1<NT));       ENDW(t);   RESC(); ROT();
    STEP(pA0,pA1,pB0,pB1,t+1,(t+4<NT),(t+2<NT),(t+2<NT));     ENDW(t+1); RESC(); ROT();
  }
  STEP(pB0,pB1,pA0,pA1,NT-1,false,false,false); RESC();
  { float sacc=pB0[0]+pB0[1]; _Pragma("unroll") for(int r=2;r<16;++r)sacc+=pB0[r]; _Pragma("unroll") for(int r=0;r<16;++r)sacc+=pB1[r]; l_reg+=sacc;
    pw0=(u32x4){PKW(pB0,0),PKW(pB0,2),PKW(pB0,4),PKW(pB0,6)};pw1=(u32x4){PKW(pB0,8),PKW(pB0,10),PKW(pB0,12),PKW(pB0,14)};pw2=(u32x4){PKW(pB1,0),PKW(pB1,2),PKW(pB1,4),PKW(pB1,6)};pw3=(u32x4){PKW(pB1,8),PKW(pB1,10),PKW(pB1,12),PKW(pB1,14)};
    SBAR(); pv(o,vb0+sl_cur,PAF(0),PAF(1),PAF(2),PAF(3)); }
  #undef PKW
  #undef PAF
  #undef VFR
  #undef PIN
  #undef MX3
  #undef GAPA
  #undef GAPB
  #undef EX
  #undef VRD
  #undef KRD
  #undef STEP
  #undef ENDW
  {auto rr=__builtin_amdgcn_permlane32_swap(__float_as_uint(l_reg),__float_as_uint(l_reg),false,false);l_reg=__uint_as_float(rr[0])+__uint_as_float(rr[1]);}
  if(hi==0)wsf[32+r32]=l_reg;asm volatile("s_waitcnt lgkmcnt(0)":::"memory");
  float rli[16];
  #pragma unroll
  for(int r=0;r<16;++r)rli[r]=__builtin_amdgcn_rcpf(wsf[32+crow(r,hi)]);
  bf16*Ow=O+(rowbase+q0+wid*QBLK)*ODM+h*D;
  { bf16*stg=(bf16*)(shm+LDS_OST)+wid*2048;
    #pragma unroll
    for(int r=0;r<16;++r){const int orow=crow(r,hi);
      #pragma unroll
      for(int d0=0;d0<2;++d0)stg[orow*64+d0*32+r32]=__float2bfloat16(o[d0][r]*rli[r]);}
    asm volatile("s_waitcnt lgkmcnt(0)":::"memory");
    #pragma unroll
    for(int i=0;i<4;++i){const int row=i*8+(lane>>3),ch=lane&7; const u32x4 v=*(const u32x4*)(stg+row*64+ch*8); ATTN_STORE16(Ow+(long)row*ODM+ch*8,v);} }
  asm volatile("s_waitcnt lgkmcnt(0)\n\ts_barrier":::"memory");
  #undef DMA_K
  #undef DMA_V
  #undef CMASK
  #undef KAUG
  #undef START
  #undef RESC
  #undef ROT
}
constexpr int ATTN_LDS_BYTES=LDS_BYTES+SEQ*8+16;
struct AttnTensors { const bf16* Q; const bf16* K; const bf16* V; bf16* O; const float* CUM; const float* KN; const float* QN; };
struct AttnUnit { int bh; int qb; };
struct StaticOrder {
  int vcu, G;
  __device__ __forceinline__ explicit StaticOrder(int grid,int block):vcu((grid%8==0)?(block%8)*(grid/8)+block/8:block),G(grid){}
  __device__ __forceinline__ bool next(int i,AttnUnit&u)const{ const int pair=vcu+(i>>1)*G; if(pair>=BATCH*NHEAD*(NQB/2))return false; const int s=pair&15; u.bh=pair>>4; u.qb=(i&1)?(NQB-1-s):s; return true; }
  __device__ __forceinline__ void a_ready(const AttnUnit&)const{}
  __device__ __forceinline__ void done(const AttnUnit&)const{}
};
template<class Sched,int THRL=8> __device__ __forceinline__ void attn_phase(char*lds,const AttnTensors&T,const Sched&S){
  AttnUnit u;
  for(int i=0;S.next(i,u);++i){ S.a_ready(u); attn_unit<THRL>(u.bh/NHEAD,u.bh%NHEAD,u.qb,T.Q,T.K,T.V,T.O,T.CUM,T.KN,T.QN,lds); S.done(u); }
}
#undef SBAR
#undef WAIT_BAR
}
constexpr int DM = 1024, SEQ = 8192, NBATCH = 2, MP = NBATCH * SEQ, DB = 128, DSQ = 4, MS = DB * DSQ, MT = MP + MS;
constexpr int NMEM = 256, MMEM = NBATCH * NMEM;
constexpr int HATT = 8, HD = 64, DATT = 512, HSSM = 8, PS = 64, NST = 128, DSSM = 512, CONVCH = 1024, DFF = 2816, INCOLS = 3088, HX = 4, HDX = 256;
constexpr int NPAGES = 16, PAGE = 128, PAST = 2048;
constexpr float EPS = 1e-6f, LOG2E = 1.4426950408889634f;
constexpr float C2 = 0.125f * LOG2E;
constexpr float XC2 = 0.0625f * LOG2E;
constexpr size_t OFF_YP = 0, OFF_YS = OFF_YP + (size_t)MP * DM, OFF_KP = OFF_YS + (size_t)MS * DM, OFF_VP = OFF_KP + (size_t)MP * DATT, OFF_FP = OFF_VP + (size_t)MP * DATT,
                 OFF_MKP = OFF_FP + (size_t)MP * HATT, OFF_MVP = OFF_MKP + (size_t)MMEM * DM, OFF_CP = OFF_MVP + (size_t)MMEM * DM, OFF_SP = OFF_CP + (size_t)NBATCH * 3 * CONVCH,
                 OFF_KS = OFF_SP + (size_t)NBATCH * HSSM * PS * NST, OFF_VS = OFF_KS + (size_t)MS * DATT, OFF_FS = OFF_VS + (size_t)MS * DATT, OFF_CS = OFF_FS + (size_t)MS * HATT,
                 OFF_SS = OFF_CS + (size_t)DB * 3 * CONVCH, OUT_TOTAL = OFF_SS + (size_t)DB * HSSM * PS * NST;
static_assert(OUT_TOTAL == 44705792, "output size");
constexpr size_t MiB = 1u << 20;
constexpr size_t WS_CTL = 0, CTL_ZERO_BYTES = 1 * MiB;
constexpr int CW_BAR = 4096;
constexpr int CW_AQ = 8192;
constexpr size_t WS_SS1 = 256 * 1024, WS_SS2 = 384 * 1024, WS_SS3 = 512 * 1024;
constexpr size_t WS_WIN = 2 * MiB, WS_WOUT = 8 * MiB, WS_WCQ = 10 * MiB, WS_WCO = 12 * MiB, WS_WCKV = 14 * MiB, WS_WGU = 18 * MiB, WS_WD = 29 * MiB;
constexpr size_t WS_SS0 = 35 * MiB, WS_SSM = 35 * MiB + 128 * 1024, WS_LOGF = 36 * MiB, WS_DT = 37 * MiB, WS_AA = 38 * MiB, WS_CUM = 39 * MiB;
constexpr size_t WS_XB = 40 * MiB, WS_MB = 74 * MiB, WS_Q = 76 * MiB, WS_K = 93 * MiB, WS_V = 110 * MiB, WS_Z = 127 * MiB, WS_XBC = 144 * MiB, WS_ACT = 178 * MiB, WS_Y = 244 * MiB;
constexpr size_t WS_MIX = 278 * MiB, WS_X = 312 * MiB, WS_QC = 378 * MiB, WS_OC = 412 * MiB, WS_U = 446 * MiB, WS_MK = 538 * MiB, WS_MV = 539 * MiB, WS_END = 540 * MiB;
static_assert(WS_SS3 + (size_t)MT * 4 <= CTL_ZERO_BYTES && (CW_BAR + 3456) * 4 <= (int)WS_SS1, "ctl map");
static_assert(WS_XB + (size_t)MT * DM * 2 <= WS_MB && WS_Q + (size_t)MT * DATT * 2 <= WS_K && WS_XBC + (size_t)MT * DM * 2 <= WS_ACT && WS_ACT + (size_t)MT * DM * 4 <= WS_Y && WS_Y + (size_t)MT * DSSM * 4 <= WS_MIX, "ws map 1");
static_assert(WS_MIX + (size_t)MT * DM * 2 <= WS_X && WS_X + (size_t)MT * DM * 4 <= WS_QC && WS_QC + (size_t)MT * DM * 2 <= WS_OC && WS_OC + (size_t)MT * DM * 2 <= WS_U && WS_U + (size_t)MT * DFF * 2 <= WS_MK, "ws map 2");
static_assert(WS_WGU + (size_t)2 * DFF * DM * 2 <= WS_WD && WS_WD + (size_t)DM * DFF * 2 <= WS_SS0 && WS_WIN + (size_t)3072 * DM * 2 <= WS_WOUT && WS_WCKV + (size_t)2048 * DM * 2 <= WS_WGU, "ws map 3");
constexpr int LDS_BYTES = 163840, LDSCTL_OFF = LDS_BYTES - 512, MISC_OFF = LDSCTL_OFF + 320;
constexpr int NWAVES = 8, NTHREADS = 512;
#ifndef MK_ONE_LAUNCH
#define MK_ONE_LAUNCH 1
#endif
constexpr int NPH = 12;

struct Args { const void* in[32]; float* out; unsigned char* ws; int ph_lo, ph_hi; };

__device__ __forceinline__ float bf2f(unsigned short h) { return __uint_as_float((unsigned)h << 16); }
__device__ __forceinline__ float wave_sum(float v) {
#pragma unroll
    for (int o = 1; o < 64; o <<= 1) v += __shfl_xor(v, o);
    return v;
}
__device__ __forceinline__ float wave_max(float v) {
#pragma unroll
    for (int o = 1; o < 64; o <<= 1) v = fmaxf(v, __shfl_xor(v, o));
    return v;
}
__device__ __forceinline__ v4u pack8(f32x4 a, f32x4 b) { v4u w; w.x = pk2(a[0], a[1]); w.y = pk2(a[2], a[3]); w.z = pk2(b[0], b[1]); w.w = pk2(b[2], b[3]); return w; }
__device__ __forceinline__ float rstd_of(float ss, int n) { return rsqrtf(ss * (1.0f / (float)n) + EPS); }

struct FInproj {
    const float* ss0; bf16 *Qb, *Kb, *Vb, *Zb, *XBCb; float* out;
    struct Pre { float s; };
    __device__ __forceinline__ void prefetch(int row, int, Pre& p) const { p.s = ss0[row]; }
    __device__ __forceinline__ void operator()(int row, int col0, f32x4 v0, f32x4 v1) const { Pre p; prefetch(row, col0, p); apply(row, col0, v0, v1, p); }
    __device__ __forceinline__ void apply(int row, int col0, f32x4 v0, f32x4 v1, const Pre& p) const {
        const float rs = rstd_of(p.s, DM); v0 = v0 * rs; v1 = v1 * rs;
        if (col0 < 512) { *(v4u*)(Qb + (size_t)row * DATT + col0) = pack8(v0 * C2, v1 * C2); }
        else if (col0 < 1536) {
            const bool isk = col0 < 1024; const int c = col0 - (isk ? 512 : 1024);
            *(v4u*)((isk ? Kb : Vb) + (size_t)row * DATT + c) = pack8(v0, v1);
            float* o = out + (row < MP ? (isk ? OFF_KP : OFF_VP) + (size_t)row * DATT : (isk ? OFF_KS : OFF_VS) + (size_t)(row - MP) * DATT) + c;
            *(f32x4*)o = v0; *(f32x4*)(o + 4) = v1;
        } else if (col0 < 2048) { *(v4u*)(Zb + (size_t)row * DSSM + (col0 - 1536)) = pack8(v0, v1); }
        else {
            const int c = col0 - 2048; *(v4u*)(XBCb + (size_t)row * CONVCH + c) = pack8(v0, v1);
            float* o = nullptr;
            if (row < MP) { const int t = row & (SEQ - 1); if (t >= SEQ - 3) o = out + OFF_CP + ((size_t)(row >> 13) * 3 + (t - (SEQ - 3))) * CONVCH + c; }
            else { const int s = row - MP, t = s & 3; if (t >= 1) o = out + OFF_CS + ((size_t)(s >> 2) * 3 + (t - 1)) * CONVCH + c; }
            if (o) { *(f32x4*)o = v0; *(f32x4*)(o + 4) = v1; }
        }
    }
};
struct FMemKV {
    const float* ssm; bf16 *MKb, *MVb; float* out;
    __device__ __forceinline__ void operator()(int row, int col0, f32x4 v0, f32x4 v1) const {
        const float rs = rstd_of(ssm[row], DM); v0 = v0 * rs; v1 = v1 * rs;
        const bool isk = col0 < 1024; const int c = isk ? col0 : col0 - 1024;
        if (isk) *(v4u*)(MKb + (size_t)row * DM + c) = pack8(v0, v1);
        else { bf16* vt = MVb + (((size_t)(row >> 8) * HX + (c >> 8)) * HDX + (c & 255)) * NMEM + (row & 255);
#pragma unroll
            for (int i = 0; i < 4; ++i) { vt[(size_t)i * NMEM] = (bf16)f2bf(v0[i]); vt[(size_t)(i + 4) * NMEM] = (bf16)f2bf(v1[i]); } }
        float* o = out + (isk ? OFF_MKP : OFF_MVP) + (size_t)row * DM + c; *(f32x4*)o = v0; *(f32x4*)(o + 4) = v1;
    }
};
struct FRes {
    const float* xin_p; const float* xin_s; bf16* XB; float* SS;
    struct Pre { f32x4 a, b; };
    __device__ __forceinline__ void prefetch(int row, int col0, Pre& p) const {
        if (xin_p) { const float* src = (row < MP ? xin_p + (size_t)row * DM : xin_s + (size_t)(row - MP) * DM) + col0; p.a = *(const f32x4*)src; p.b = *(const f32x4*)(src + 4); }
        else { const v4u w = *(const v4u*)(XB + (size_t)row * DM + col0);
            p.a = (f32x4){__uint_as_float(w.x << 16), __uint_as_float(w.x & 0xffff0000u), __uint_as_float(w.y << 16), __uint_as_float(w.y & 0xffff0000u)};
            p.b = (f32x4){__uint_as_float(w.z << 16), __uint_as_float(w.z & 0xffff0000u), __uint_as_float(w.w << 16), __uint_as_float(w.w & 0xffff0000u)}; } }
    __device__ __forceinline__ void operator()(int row, int col0, f32x4 v0, f32x4 v1) const { Pre p; prefetch(row, col0, p); apply(row, col0, v0, v1, p); }
    __device__ __forceinline__ void apply(int row, int col0, f32x4 v0, f32x4 v1, const Pre& p) const {
        const f32x4 x0 = p.a + v0, x1 = p.b + v1;
        *(v4u*)(XB + (size_t)row * DM + col0) = pack8(x0, x1);
        float q = (x0[0] * x0[0] + x0[1] * x0[1]) + (x0[2] * x0[2] + x0[3] * x0[3]) + (x1[0] * x1[0] + x1[1] * x1[1]) + (x1[2] * x1[2] + x1[3] * x1[3]);
        q += __shfl_xor(q, 16); q += __shfl_xor(q, 32);
        if (((threadIdx.x & 63) >> 4) == 0) __hip_atomic_fetch_add(SS + row, q, __ATOMIC_RELAXED, __HIP_MEMORY_SCOPE_AGENT);
    }
};
struct FScaleBf16 {
    const float* ss; bf16* dst; float scale;
    struct Pre { float s; };
    __device__ __forceinline__ void prefetch(int row, int, Pre& p) const { p.s = ss[row]; }
    __device__ __forceinline__ void operator()(int row, int col0, f32x4 v0, f32x4 v1) const { Pre p; prefetch(row, col0, p); apply(row, col0, v0, v1, p); }
    __device__ __forceinline__ void apply(int row, int col0, f32x4 v0, f32x4 v1, const Pre& p) const {
        const float rs = rstd_of(p.s, DM) * scale; *(v4u*)(dst + (size_t)row * DM + col0) = pack8(v0 * rs, v1 * rs);
    }
};
__device__ __forceinline__ float silu_f(float x) { return x / (1.0f + __expf(-x)); }
struct FGateUp {
    const float* ss; bf16* U;
    struct Pre { float s; };
    __device__ __forceinline__ void prefetch(int row, int, Pre& p) const { p.s = ss[row]; }
    __device__ __forceinline__ void apply(int row, int col0, f32x4 g0, f32x4 g1, f32x4 u0, f32x4 u1, const Pre& p) const {
        const float rs = rstd_of(p.s, DM); f32x4 a, b;
#pragma unroll
        for (int i = 0; i < 4; ++i) { a[i] = silu_f(g0[i] * rs) * (u0[i] * rs); b[i] = silu_f(g1[i] * rs) * (u1[i] * rs); }
        *(v4u*)(U + (size_t)row * DFF + col0) = pack8(a, b);
    }
};

__device__ __forceinline__ void transpose_item(const float* W, int ldw, int src_col0, int k0, bf16* WT, int K, int dst_row0, const float* gk, LAS float* scr, int lane) {
    float tv[32];
#pragma unroll
    for (int i = 0; i < 32; ++i) tv[i] = W[(size_t)(k0 + 2 * i + (lane >> 5)) * ldw + src_col0 + (lane & 31)];
    if (gk) {
#pragma unroll
        for (int i = 0; i < 32; ++i) tv[i] *= gk[k0 + 2 * i + (lane >> 5)];
    }
#pragma unroll
    for (int i = 0; i < 32; ++i) scr[(2 * i + (lane >> 5)) * 33 + (lane & 31)] = tv[i];
    LDS_WAIT(); asm volatile("" ::: "memory");
    const int c = lane & 7;
#pragma unroll
    for (int j = 0; j < 4; ++j) { const int n = (lane >> 3) + 8 * j; const LAS float* s = scr + (8 * c) * 33 + n;
        v4u o; o.x = pk2(s[0 * 33], s[1 * 33]); o.y = pk2(s[2 * 33], s[3 * 33]); o.z = pk2(s[4 * 33], s[5 * 33]); o.w = pk2(s[6 * 33], s[7 * 33]);
        *(v4u*)(WT + (size_t)(dst_row0 + n) * K + k0 + 8 * c) = o; }
    LDS_WAIT(); asm volatile("" ::: "memory");
}
__device__ __forceinline__ float softplus_f(float x) { return fmaxf(x, 0.f) + log1pf(__expf(-fabsf(x))); }

__device__ __forceinline__ void wconv(const Args& A, LAS float* scr, int kind, int worker, int nworkers, int lane) {
    unsigned char* ws = A.ws;
    const int nblk = kind == 0 ? 96 : kind == 4 ? 64 : kind == 5 ? 176 : 32, nkb = kind == 6 ? 44 : 16;
    for (int r = worker; r < nblk * nkb; r += nworkers) {
        const int kb = r / nblk, n0 = 32 * (r % nblk);
        if (kind == 0) transpose_item((const float*)A.in[12], INCOLS, n0 < 1536 ? n0 : n0 + 8, 64 * kb, (bf16*)(ws + WS_WIN), DM, n0, (const float*)A.in[11], scr, lane);
        else if (kind == 1) transpose_item((const float*)A.in[20], DM, n0, 64 * kb, (bf16*)(ws + WS_WOUT), DM, n0, nullptr, scr, lane);
        else if (kind == 2) transpose_item((const float*)A.in[23], DM, n0, 64 * kb, (bf16*)(ws + WS_WCQ), DM, n0, (const float*)A.in[21], scr, lane);
        else if (kind == 3) transpose_item((const float*)A.in[26], DM, n0, 64 * kb, (bf16*)(ws + WS_WCO), DM, n0, nullptr, scr, lane);
        else if (kind == 4) transpose_item((const float*)A.in[n0 < 1024 ? 24 : 25], DM, n0 & 1023, 64 * kb, (bf16*)(ws + WS_WCKV), DM, n0, (const float*)A.in[22], scr, lane);
        else if (kind == 5) { const int pn = n0 >> 8, half = (n0 >> 7) & 1, j0 = n0 & 127; transpose_item((const float*)A.in[half ? 29 : 28], DFF, pn * 128 + j0, 64 * kb, (bf16*)(ws + WS_WGU), DM, n0, (const float*)A.in[27], scr, lane); }
        else transpose_item((const float*)A.in[30], DM, n0, 64 * kb, (bf16*)(ws + WS_WD), DFF, n0, nullptr, scr, lane);
    }
}

__device__ __forceinline__ void p0_prologue(const Args& A, LAS unsigned char* lds, int tid, int lane, int wave, int wg, int nwg) {
    unsigned char* ws = A.ws;
    const float* w_in = (const float*)A.in[12];
    LAS float* scr = (LAS float*)(lds + wave * 8448);
    const int gw = wg * NWAVES + wave, NGW = nwg * NWAVES;
    wconv(A, scr, 0, gw, NGW, lane); wconv(A, scr, 4, gw, NGW, lane);
    if (nwg != 256) { wconv(A, scr, 1, gw, NGW, lane); wconv(A, scr, 2, gw, NGW, lane); wconv(A, scr, 3, gw, NGW, lane); wconv(A, scr, 5, gw, NGW, lane); wconv(A, scr, 6, gw, NGW, lane); }
    __syncthreads();
    LAS float* wfd = (LAS float*)lds;
    { const float* g = (const float*)A.in[11];
#pragma unroll
      for (int j = 0; j < 2; ++j) { const int k = tid + NTHREADS * j; const float* wr = w_in + (size_t)k * INCOLS; const float gk = g[k];
          const f32x4 a0 = *(const f32x4*)(wr + 1536), a1 = *(const f32x4*)(wr + 1540), b0 = *(const f32x4*)(wr + 3080), b1 = *(const f32x4*)(wr + 3084);
#pragma unroll
          for (int c = 0; c < 4; ++c) { wfd[c * DM + k] = a0[c] * gk; wfd[(4 + c) * DM + k] = a1[c] * gk; wfd[(8 + c) * DM + k] = b0[c] * gk; wfd[(12 + c) * DM + k] = b1[c] * gk; } } }
    __syncthreads();
    bf16* XB = (bf16*)(ws + WS_XB); bf16* MB = (bf16*)(ws + WS_MB);
    float* SS0 = (float*)(ws + WS_SS0); float* SSM = (float*)(ws + WS_SSM); float* LOGF = (float*)(ws + WS_LOGF); float* DT = (float*)(ws + WS_DT); float* AA = (float*)(ws + WS_AA);
    const float* b_forget = (const float*)A.in[13]; const float* dt_bias = (const float*)A.in[16]; const float* a_log = (const float*)A.in[17];
    f32x4 nxt[4];
    if (gw < MT + MMEM) { const float* s0 = gw < MP ? (const float*)A.in[0] + (size_t)gw * DM : gw < MT ? (const float*)A.in[1] + (size_t)(gw - MP) * DM : (const float*)A.in[2] + (size_t)(gw - MT) * DM;
#pragma unroll
        for (int j = 0; j < 4; ++j) nxt[j] = *((const f32x4*)s0 + lane + 64 * j); }
    for (int m = gw; m < MT + MMEM; m += NGW) {
        const float* src; bf16* dst;
        if (m < MP) { src = (const float*)A.in[0] + (size_t)m * DM; dst = XB + (size_t)m * DM; }
        else if (m < MT) { src = (const float*)A.in[1] + (size_t)(m - MP) * DM; dst = XB + (size_t)m * DM; }
        else { src = (const float*)A.in[2] + (size_t)(m - MT) * DM; dst = MB + (size_t)(m - MT) * DM; }
        f32x4 v[4]; float s = 0.f;
#pragma unroll
        for (int j = 0; j < 4; ++j) { v[j] = nxt[j]; s += (v[j][0] * v[j][0] + v[j][1] * v[j][1]) + (v[j][2] * v[j][2] + v[j][3] * v[j][3]); }
        { const int mn = m + NGW; if (mn < MT + MMEM) { const float* sn = mn < MP ? (const float*)A.in[0] + (size_t)mn * DM : mn < MT ? (const float*)A.in[1] + (size_t)(mn - MP) * DM : (const float*)A.in[2] + (size_t)(mn - MT) * DM;
#pragma unroll
            for (int j = 0; j < 4; ++j) nxt[j] = *((const f32x4*)sn + lane + 64 * j); } }
        s = wave_sum(s);
#pragma unroll
        for (int j = 0; j < 4; ++j) { unsigned long long w = (unsigned long long)pk2(v[j][0], v[j][1]) | ((unsigned long long)pk2(v[j][2], v[j][3]) << 32); *((unsigned long long*)dst + lane + 64 * j) = w; }
        if (m >= MT) { if (lane == 0) SSM[m - MT] = s; continue; }
        if (lane == 0) SS0[m] = s;
        const float rs = rstd_of(s, DM);
        float mine = 0.f;
#pragma unroll
        for (int c = 0; c < 16; ++c) { float d = 0.f;
#pragma unroll
            for (int j = 0; j < 4; ++j) { const f32x4 w = *((const LAS f32x4*)(wfd + c * DM) + lane + 64 * j); d += (v[j][0] * w[0] + v[j][1] * w[1]) + (v[j][2] * w[2] + v[j][3] * w[3]); }
            d = wave_sum(d); if (lane == c) mine = d; }
        if (lane < 8) { const float x = mine * rs + b_forget[lane]; const float lf = fminf(x, 0.f) - log1pf(__expf(-fabsf(x)));
            LOGF[(size_t)m * 8 + lane] = lf; if (m < MP) A.out[OFF_FP + (size_t)m * 8 + lane] = lf; else A.out[OFF_FS + (size_t)(m - MP) * 8 + lane] = lf; }
        else if (lane < 16) { const int h = lane - 8; const float dt = softplus_f(mine * rs + dt_bias[h]); DT[(size_t)m * 8 + h] = dt; AA[(size_t)m * 8 + h] = -__expf(a_log[h]) * dt; }
    }
}

__device__ __forceinline__ float block_excl_scan(float v, LAS float* sh, int lane, int wave) {
    float inc = v;
#pragma unroll
    for (int o = 1; o < 64; o <<= 1) { const float t = __shfl_up(inc, o); if (lane >= o) inc += t; }
    __syncthreads();
    if (lane == 63) sh[wave] = inc;
    __syncthreads();
    float base = 0.f;
    for (int w = 0; w < wave; ++w) base += sh[w];
    return base + inc - v;
}
__device__ __forceinline__ void p1_cumsum(const Args& A, LAS unsigned char* lds, int tid, int lane, int wave, int bh) {
    const float* LOGF = (const float*)(A.ws + WS_LOGF); float* CUM = (float*)(A.ws + WS_CUM);
    const int b = bh >> 3, h = bh & 7, t0 = tid * 16;
    float v[16]; float run = 0.f;
#pragma unroll
    for (int j = 0; j < 16; ++j) { run += LOGF[((size_t)b * SEQ + t0 + j) * 8 + h]; v[j] = run; }
    const float ex = block_excl_scan(run, (LAS float*)lds, lane, wave);
#pragma unroll
    for (int j = 0; j < 16; ++j) CUM[(size_t)bh * SEQ + t0 + j] = ex + v[j];
    __syncthreads();
}

constexpr size_t WS_ACTB = WS_ACT;
__device__ __forceinline__ void unpack8(v4u w, float (&x)[8]) { x[0] = __uint_as_float(w.x << 16); x[1] = __uint_as_float(w.x & 0xffff0000u); x[2] = __uint_as_float(w.y << 16); x[3] = __uint_as_float(w.y & 0xffff0000u);
    x[4] = __uint_as_float(w.z << 16); x[5] = __uint_as_float(w.z & 0xffff0000u); x[6] = __uint_as_float(w.w << 16); x[7] = __uint_as_float(w.w & 0xffff0000u); }
__device__ __forceinline__ void conv_pass(const Args& A, int tid, int wg, int nwg) {
    const bf16* XBC = (const bf16*)(A.ws + WS_XBC); bf16* ACTB = (bf16*)(A.ws + WS_ACTB);
    const float* state_conv = (const float*)A.in[9]; const float* conv_w = (const float*)A.in[14]; const float* conv_b = (const float*)A.in[15];
    constexpr int NPI = (MP / 16) * 128, NSI = DB * 128;
    for (int idx = wg * NTHREADS + tid; idx < NPI + NSI; idx += nwg * NTHREADS) {
        const bool prm = idx < NPI; const int j = prm ? idx : idx - NPI; const int c8 = (j & 127) * 8, rg = j >> 7;
        float w[4][8], bs[8], xw[3][8];
#pragma unroll
        for (int t = 0; t < 4; ++t) { const f32x4 a = *(const f32x4*)(conv_w + t * CONVCH + c8), b = *(const f32x4*)(conv_w + t * CONVCH + c8 + 4);
#pragma unroll
            for (int i = 0; i < 4; ++i) { w[t][i] = a[i]; w[t][4 + i] = b[i]; } }
        { const f32x4 a = *(const f32x4*)(conv_b + c8), b = *(const f32x4*)(conv_b + c8 + 4);
#pragma unroll
          for (int i = 0; i < 4; ++i) { bs[i] = a[i]; bs[4 + i] = b[i]; } }
        const int r0 = prm ? rg * 16 : MP + rg * 4, nrows = prm ? 16 : 4;
        if (prm) {
            if ((r0 & (SEQ - 1)) == 0) {
#pragma unroll
                for (int t = 0; t < 3; ++t)
#pragma unroll
                    for (int i = 0; i < 8; ++i) xw[t][i] = 0.f;
            } else {
#pragma unroll
                for (int t = 0; t < 3; ++t) unpack8(*(const v4u*)(XBC + (size_t)(r0 - 3 + t) * CONVCH + c8), xw[t]);
            }
        } else {
#pragma unroll
            for (int t = 0; t < 3; ++t) { const float* sp = state_conv + ((size_t)rg * 3 + t) * CONVCH + c8; const f32x4 a = *(const f32x4*)sp, b = *(const f32x4*)(sp + 4);
#pragma unroll
                for (int i = 0; i < 4; ++i) { xw[t][i] = a[i]; xw[t][4 + i] = b[i]; } }
        }
#pragma unroll 4
        for (int i = 0; i < nrows; ++i) {
            float xi[8]; unpack8(*(const v4u*)(XBC + (size_t)(r0 + i) * CONVCH + c8), xi);
            f32x4 o0, o1;
#pragma unroll
            for (int k = 0; k < 8; ++k) { const float a = bs[k] + ((w[0][k] * xw[0][k] + w[1][k] * xw[1][k]) + (w[2][k] * xw[2][k] + w[3][k] * xi[k])); const float sv = silu_f(a); if (k < 4) o0[k] = sv; else o1[k - 4] = sv;
                xw[0][k] = xw[1][k]; xw[1][k] = xw[2][k]; xw[2][k] = xi[k]; }
            *(v4u*)(ACTB + (size_t)(r0 + i) * CONVCH + c8) = pack8(o0, o1);
        }
    }
}

__device__ __forceinline__ void p3_ssd_naive(const Args& A, LAS unsigned char* lds, int lane, int wave, int wg, int nwg, int it_lo) {
    const bf16* ACT = (const bf16*)(A.ws + WS_ACTB); const float* DT = (const float*)(A.ws + WS_DT); const float* AA = (const float*)(A.ws + WS_AA); float* Y = (float*)(A.ws + WS_Y);
    const float* state_ssm = (const float*)A.in[10]; const float* d_skip = (const float*)A.in[18];
    LAS float* bc = (LAS float*)(lds + wave * 4096);
    const int gwt = wave * nwg + wg, NGW = nwg * NWAVES;
    const int pl = lane & 15, nq = lane >> 4, n0 = nq * 32;
    for (int it = it_lo + gwt; it < (NBATCH * HSSM + DB * HSSM) * 4; it += NGW) {
        const int sh = it >> 2, p = (it & 3) * 16 + pl;
        int L, row0, h; float* sout; float hs[32];
        if (sh < NBATCH * HSSM) { const int b = sh >> 3; h = sh & 7; L = SEQ; row0 = b * SEQ; sout = A.out + OFF_SP + ((size_t)sh * PS + p) * NST + n0;
#pragma unroll
            for (int n = 0; n < 32; ++n) hs[n] = 0.f; }
        else { const int s = sh - NBATCH * HSSM, b = s >> 3; h = s & 7; L = DSQ; row0 = MP + b * DSQ; sout = A.out + OFF_SS + ((size_t)s * PS + p) * NST + n0;
            const float* h0 = state_ssm + ((size_t)s * PS + p) * NST + n0;
#pragma unroll
            for (int n = 0; n < 32; n += 4) { const f32x4 t = *(const f32x4*)(h0 + n); hs[n] = t[0]; hs[n + 1] = t[1]; hs[n + 2] = t[2]; hs[n + 3] = t[3]; } }
        const int g = h >> 2; const float dsk = d_skip[h];
        float nx[4], ndt[4], na[4]; f32x2 nb[4], nc[4];
#define SSD_LOAD(t_, i_) do { const size_t r_ = (size_t)row0 + (t_); nx[i_] = bf2f(ACT[r_ * CONVCH + h * PS + p]); ndt[i_] = DT[r_ * 8 + h]; na[i_] = AA[r_ * 8 + h]; \
            { const unsigned ub_ = *(const unsigned*)(ACT + r_ * CONVCH + 512 + g * NST + 2 * lane), uc_ = *(const unsigned*)(ACT + r_ * CONVCH + 768 + g * NST + 2 * lane); \
              nb[i_] = (f32x2){__uint_as_float(ub_ << 16), __uint_as_float(ub_ & 0xffff0000u)}; nc[i_] = (f32x2){__uint_as_float(uc_ << 16), __uint_as_float(uc_ & 0xffff0000u)}; } } while (0)
#pragma unroll
        for (int i = 0; i < 4; ++i) SSD_LOAD(i, i);
        for (int t0 = 0; t0 < L; t0 += 4) {
            float cx[4], cdt[4], ca[4];
#pragma unroll
            for (int i = 0; i < 4; ++i) { cx[i] = nx[i]; cdt[i] = ndt[i]; ca[i] = na[i]; *(LAS f32x2*)(bc + i * 256 + 2 * lane) = nb[i]; *(LAS f32x2*)(bc + i * 256 + 128 + 2 * lane) = nc[i]; }
            if (t0 + 4 < L) {
#pragma unroll
                for (int i = 0; i < 4; ++i) SSD_LOAD(t0 + 4 + i, i);
            }
            asm volatile("s_waitcnt lgkmcnt(0)" ::: "memory");
#pragma unroll
            for (int i = 0; i < 4; ++i) {
                const float dA = __expf(ca[i]), xdt = cx[i] * cdt[i]; float y = 0.f;
#pragma unroll
                for (int n = 0; n < 32; n += 4) {
                    const f32x4 bn = *(const LAS f32x4*)(bc + i * 256 + n0 + n), cn = *(const LAS f32x4*)(bc + i * 256 + 128 + n0 + n);
                    hs[n] = dA * hs[n] + bn[0] * xdt; y += cn[0] * hs[n];
                    hs[n + 1] = dA * hs[n + 1] + bn[1] * xdt; y += cn[1] * hs[n + 1];
                    hs[n + 2] = dA * hs[n + 2] + bn[2] * xdt; y += cn[2] * hs[n + 2];
                    hs[n + 3] = dA * hs[n + 3] + bn[3] * xdt; y += cn[3] * hs[n + 3];
                }
                y += __shfl_xor(y, 16); y += __shfl_xor(y, 32);
                if (nq == 0) Y[((size_t)row0 + t0 + i) * DSSM + h * PS + p] = y + dsk * cx[i];
            }
            asm volatile("s_waitcnt lgkmcnt(0)" ::: "memory");
        }
#undef SSD_LOAD
#pragma unroll
        for (int n = 0; n < 32; n += 4) *(f32x4*)(sout + n) = (f32x4){hs[n], hs[n + 1], hs[n + 2], hs[n + 3]};
    }
}

__device__ __forceinline__ void p4_gate_norm(const Args& A, int lane, int wave, int wg, int nwg, int row_lo) {
    const float* Y = (const float*)(A.ws + WS_Y); const bf16* Zb = (const bf16*)(A.ws + WS_Z); bf16* MIX = (bf16*)(A.ws + WS_MIX); const float* g = (const float*)A.in[19];
    const int gw = wg * NWAVES + wave, NGW = nwg * NWAVES;
    for (int row = row_lo + gw; row < MT; row += NGW) {
        const f32x4 y0 = *(const f32x4*)(Y + (size_t)row * DSSM + 8 * lane), y1 = *(const f32x4*)(Y + (size_t)row * DSSM + 8 * lane + 4);
        const v4u zw = *(const v4u*)(Zb + (size_t)row * DSSM + 8 * lane);
        float z[8] = {bf2f((unsigned short)zw.x), bf2f((unsigned short)(zw.x >> 16)), bf2f((unsigned short)zw.y), bf2f((unsigned short)(zw.y >> 16)), bf2f((unsigned short)zw.z), bf2f((unsigned short)(zw.z >> 16)), bf2f((unsigned short)zw.w), bf2f((unsigned short)(zw.w >> 16))};
        float v[8]; float s = 0.f;
#pragma unroll
        for (int i = 0; i < 8; ++i) { v[i] = (i < 4 ? y0[i] : y1[i - 4]) * silu_f(z[i]); s += v[i] * v[i]; }
        const float rs = rstd_of(wave_sum(s), DSSM);
        const f32x4 g0 = *(const f32x4*)(g + 8 * lane), g1 = *(const f32x4*)(g + 8 * lane + 4);
        f32x4 a = {v[0] * rs * g0[0], v[1] * rs * g0[1], v[2] * rs * g0[2], v[3] * rs * g0[3]}, c = {v[4] * rs * g1[0], v[5] * rs * g1[1], v[6] * rs * g1[2], v[7] * rs * g1[3]};
        *(v4u*)(MIX + (size_t)row * DM + DATT + 8 * lane) = pack8(a, c);
    }
}

__device__ __forceinline__ void p11_final_norm(const Args& A, int lane, int wave, int wg, int nwg) {
    const bf16* XBf = (const bf16*)(A.ws + WS_XB); const float* g = (const float*)A.in[31];
    const int gw = wg * NWAVES + wave, NGW = nwg * NWAVES;
    for (int row = gw; row < MT; row += NGW) {
        float v[16]; float s = 0.f;
#pragma unroll
        for (int j = 0; j < 2; ++j) { const v4u w = *((const v4u*)(XBf + (size_t)row * DM) + lane + 64 * j);
            v[8 * j] = __uint_as_float(w.x << 16); v[8 * j + 1] = __uint_as_float(w.x & 0xffff0000u); v[8 * j + 2] = __uint_as_float(w.y << 16); v[8 * j + 3] = __uint_as_float(w.y & 0xffff0000u);
            v[8 * j + 4] = __uint_as_float(w.z << 16); v[8 * j + 5] = __uint_as_float(w.z & 0xffff0000u); v[8 * j + 6] = __uint_as_float(w.w << 16); v[8 * j + 7] = __uint_as_float(w.w & 0xffff0000u); }
#pragma unroll
        for (int i = 0; i < 16; ++i) s += v[i] * v[i];
        const float rs = rstd_of(wave_sum(s), DM);
        float* o = A.out + (row < MP ? OFF_YP + (size_t)row * DM : OFF_YS + (size_t)(row - MP) * DM);
#pragma unroll
        for (int j = 0; j < 2; ++j) { const int c = 8 * (lane + 64 * j); const f32x4 g0 = *(const f32x4*)(g + c), g1 = *(const f32x4*)(g + c + 4);
            *(f32x4*)(o + c) = (f32x4){v[8 * j] * rs * g0[0], v[8 * j + 1] * rs * g0[1], v[8 * j + 2] * rs * g0[2], v[8 * j + 3] * rs * g0[3]};
            *(f32x4*)(o + c + 4) = (f32x4){v[8 * j + 4] * rs * g1[0], v[8 * j + 5] * rs * g1[1], v[8 * j + 6] * rs * g1[2], v[8 * j + 7] * rs * g1[3]}; }
    }
}

constexpr size_t WS_KN = WS_CUM + 512 * 1024, WS_QN = WS_KN + 8192;
__device__ __forceinline__ void attn_norms(const Args& A, int lane, int wave, int wg, int nwg) {
    const int gw = wg * NWAVES + wave, NGW = nwg * NWAVES;
    for (int it = gw; it < 2 * NBATCH * HATT * (SEQ / 64); it += NGW) {
        const int which = it >> 11, bh = (it >> 7) & 15, tile = it & 127;
        const bf16* src = (const bf16*)(A.ws + (which ? WS_Q : WS_K)) + ((size_t)(bh >> 3) * SEQ + tile * 64 + lane) * DATT + (bh & 7) * HD;
        float s = 0.f;
#pragma unroll
        for (int i = 0; i < 8; ++i) { float x[8]; unpack8(*(const v4u*)(src + 8 * i), x);
#pragma unroll
            for (int k = 0; k < 8; ++k) s += x[k] * x[k]; }
        const float nmax = wave_max(sqrtf(s));
        if (lane == 0) ((float*)(A.ws + (which ? WS_QN : WS_KN)))[bh * (SEQ / 64) + tile] = nmax;
    }
}

constexpr size_t WS_SCH = 544 * MiB;
constexpr size_t WS_DEC = 580 * MiB;
constexpr size_t WS_HST = 582 * MiB;
constexpr size_t WS_END2 = 616 * MiB;
constexpr int SSD_Q = 128, NCH = SEQ / SSD_Q, LP = 136;
__device__ __forceinline__ f32x4 mfma16(bf16x8 a, bf16x8 b, f32x4 c) { return __builtin_amdgcn_mfma_f32_16x16x32_bf16(a, b, c, 0, 0, 0); }
__device__ __forceinline__ bf16x8 ldfrag(const LAS bf16* base, int pitch, int r0, int k0, int lane) { return *(const LAS bf16x8*)(base + (r0 + (lane & 15)) * pitch + k0 + 8 * (lane >> 4)); }
__device__ __forceinline__ void conv8x2(const bf16* __restrict__ XBC, int grow0, int seq0, int s0, int ch, const float* __restrict__ conv_w, const float* __restrict__ conv_b, float (&o0)[8], float (&o1)[8]) {
    float x0[11], x1[11];
#pragma unroll
    for (int k = 0; k < 11; ++k) { const int r = grow0 + s0 - 3 + k; unsigned u = 0u; if (r >= seq0) u = *(const unsigned*)(XBC + (size_t)r * CONVCH + ch); x0[k] = __uint_as_float(u << 16); x1[k] = __uint_as_float(u & 0xffff0000u); }
    float w0[4], w1[4];
#pragma unroll
    for (int j = 0; j < 4; ++j) { const f32x2 w = *(const f32x2*)(conv_w + j * CONVCH + ch); w0[j] = w[0]; w1[j] = w[1]; }
    const f32x2 bb = *(const f32x2*)(conv_b + ch);
#pragma unroll
    for (int i = 0; i < 8; ++i) { float a0 = bb[0], a1 = bb[1];
#pragma unroll
        for (int j = 0; j < 4; ++j) { a0 += w0[j] * x0[i + j]; a1 += w1[j] * x1[i + j]; }
        o0[i] = silu_f(a0); o1[i] = silu_f(a1); }
}
__device__ __forceinline__ void ssd_scalars(const float* __restrict__ AA, const float* __restrict__ DT, int grow0, int g, LAS float* acs, LAS float* dtl, LAS float* tmp, int tid, int lane, int wave) {
    const int hl = tid >> 7, s = tid & 127; const size_t idx = (size_t)(grow0 + s) * 8 + 4 * g + hl;
    float inc = AA[idx]; dtl[hl * 128 + s] = DT[idx];
#pragma unroll
    for (int o = 1; o < 64; o <<= 1) { const float t = __shfl_up(inc, o); if (lane >= o) inc += t; }
    if (lane == 63) tmp[wave] = inc;
    __syncthreads();
    if (wave & 1) inc += tmp[wave - 1];
    acs[hl * 128 + s] = inc;
    __syncthreads();
}
__device__ __forceinline__ unsigned short f2bf16(float f) { return (unsigned short)f2bf(f); }

__device__ __forceinline__ void ssd_phase_a(const Args& A, LAS unsigned char* lds, int tid, int lane, int wave, int wg, int nwg) {
    const bf16* XBC = (const bf16*)(A.ws + WS_XBC); const float* AA = (const float*)(A.ws + WS_AA); const float* DT = (const float*)(A.ws + WS_DT);
    float* SCH = (float*)(A.ws + WS_SCH); float* DEC = (float*)(A.ws + WS_DEC);
    const float* conv_w = (const float*)A.in[14]; const float* conv_b = (const float*)A.in[15];
    LAS bf16* XT = (LAS bf16*)lds;
    LAS bf16* BT = XT + 256 * LP;
    LAS float* acs = (LAS float*)(BT + 128 * LP); LAS float* dtl = acs + 512; LAS float* wl = dtl + 512; LAS float* tmp = wl + 512;
    for (int u = wg; u < NBATCH * NCH * 2; u += nwg) {
        const int g = u & 1, bc = u >> 1, b = bc / NCH, c = bc % NCH, grow0 = b * SEQ + c * SSD_Q, seq0 = b * SEQ;
        __syncthreads();
        ssd_scalars(AA, DT, grow0, g, acs, dtl, tmp, tid, lane, wave);
        { const int hl = tid >> 7, s = tid & 127; const float aend = acs[hl * 128 + 127]; wl[hl * 128 + s] = dtl[hl * 128 + s] * __expf(aend - acs[hl * 128 + s]);
          if (s == 127) DEC[(size_t)bc * 8 + 4 * g + hl] = __expf(aend); }
        __syncthreads();
        for (int it = tid; it < 192 * 16; it += NTHREADS) {
            const int cp = it % 192, s0 = (it / 192) * 8; float o0[8], o1[8];
            if (cp < 128) { const int j = 2 * cp; conv8x2(XBC, grow0, seq0, s0, 256 * g + j, conv_w, conv_b, o0, o1);
                const int hl = j >> 6; v4u w0, w1; float e[8];
#pragma unroll
                for (int i = 0; i < 8; ++i) e[i] = wl[hl * 128 + s0 + i];
                w0.x = pk2(o0[0] * e[0], o0[1] * e[1]); w0.y = pk2(o0[2] * e[2], o0[3] * e[3]); w0.z = pk2(o0[4] * e[4], o0[5] * e[5]); w0.w = pk2(o0[6] * e[6], o0[7] * e[7]);
                w1.x = pk2(o1[0] * e[0], o1[1] * e[1]); w1.y = pk2(o1[2] * e[2], o1[3] * e[3]); w1.z = pk2(o1[4] * e[4], o1[5] * e[5]); w1.w = pk2(o1[6] * e[6], o1[7] * e[7]);
                *(LAS v4u*)(XT + j * LP + s0) = w0; *(LAS v4u*)(XT + (j + 1) * LP + s0) = w1; }
            else { const int n = 2 * (cp - 128); conv8x2(XBC, grow0, seq0, s0, 512 + 128 * g + n, conv_w, conv_b, o0, o1);
                v4u w0, w1;
                w0.x = pk2(o0[0], o0[1]); w0.y = pk2(o0[2], o0[3]); w0.z = pk2(o0[4], o0[5]); w0.w = pk2(o0[6], o0[7]);
                w1.x = pk2(o1[0], o1[1]); w1.y = pk2(o1[2], o1[3]); w1.z = pk2(o1[4], o1[5]); w1.w = pk2(o1[6], o1[7]);
                *(LAS v4u*)(BT + n * LP + s0) = w0; *(LAS v4u*)(BT + (n + 1) * LP + s0) = w1; }
        }
        __syncthreads();
        const int hl = wave >> 1, nh = wave & 1;
        f32x4 acc[4][4];
#pragma unroll
        for (int mt = 0; mt < 4; ++mt)
#pragma unroll
            for (int nt = 0; nt < 4; ++nt) acc[mt][nt] = (f32x4){0.f, 0.f, 0.f, 0.f};
#pragma unroll
        for (int k = 0; k < 4; ++k) { bf16x8 af[4], bfr[4];
#pragma unroll
            for (int mt = 0; mt < 4; ++mt) af[mt] = ldfrag(XT, LP, 64 * hl + 16 * mt, 32 * k, lane);
#pragma unroll
            for (int nt = 0; nt < 4; ++nt) bfr[nt] = ldfrag(BT, LP, 64 * nh + 16 * nt, 32 * k, lane);
#pragma unroll
            for (int mt = 0; mt < 4; ++mt)
#pragma unroll
                for (int nt = 0; nt < 4; ++nt) acc[mt][nt] = mfma16(af[mt], bfr[nt], acc[mt][nt]); }
        float* dst = SCH + ((size_t)bc * 8 + 4 * g + hl) * (PS * NST);
        const int r = lane & 15, q = lane >> 4;
#pragma unroll
        for (int mt = 0; mt < 4; ++mt)
#pragma unroll
            for (int nt = 0; nt < 4; ++nt)
#pragma unroll
                for (int i = 0; i < 4; ++i) dst[(size_t)(16 * mt + 4 * q + i) * NST + 64 * nh + 16 * nt + r] = acc[mt][nt][i];
    }
    __syncthreads();
}

__device__ __forceinline__ void ssd_phase_b(const Args& A, int tid, int wg, int nwg) {
    const float* SCH = (const float*)(A.ws + WS_SCH); bf16* HSTo = (bf16*)(A.ws + WS_HST); const float* DEC = (const float*)(A.ws + WS_DEC);
    constexpr int PER = HSSM * PS * NST;
    for (int e = wg * NTHREADS + tid; e < NBATCH * PER; e += nwg * NTHREADS) {
        const int b = e / PER, r = e % PER, h = r / (PS * NST);
        const float* p = SCH + (size_t)b * NCH * PER + r; bf16* po = HSTo + (size_t)b * NCH * PER + r; const float* dc = DEC + (size_t)b * NCH * 8 + h;
        float hcur = 0.f;
        for (int c0 = 0; c0 < NCH; c0 += 8) { float sv[8], dv[8];
#pragma unroll
            for (int j = 0; j < 8; ++j) { sv[j] = p[(size_t)(c0 + j) * PER]; dv[j] = dc[(c0 + j) * 8]; }
#pragma unroll
            for (int j = 0; j < 8; ++j) { po[(size_t)(c0 + j) * PER] = f2bf16(hcur); hcur = dv[j] * hcur + sv[j]; } }
        A.out[OFF_SP + e] = hcur;
    }
}

constexpr int YP = 520;
__device__ __forceinline__ void ssd_phase_c(const Args& A, LAS unsigned char* lds, int tid_in, int lane_in, int wave, int wg, int nwg) {
    const bf16* ACTB = (const bf16*)(A.ws + WS_ACTB); const float* AA = (const float*)(A.ws + WS_AA); const float* DT = (const float*)(A.ws + WS_DT);
    const bf16* HST = (const bf16*)(A.ws + WS_HST); const bf16* Zb = (const bf16*)(A.ws + WS_Z); bf16* MIX = (bf16*)(A.ws + WS_MIX);
    const float* d_skip = (const float*)A.in[18]; const float* gain = (const float*)A.in[19];
    LAS bf16* Bn = (LAS bf16*)lds;
    LAS bf16* Cn = Bn + 128 * LP;
    LAS bf16* XT = Cn + 64 * LP;
    LAS bf16* GL = XT + 64 * LP;
    LAS bf16* YL = GL + 64 * LP;
    LAS float* acs = (LAS float*)(YL + 64 * YP); LAS float* dtl = acs + 512; LAS float* tmp = dtl + 512;
    const int tt = wave >> 1, hf = wave & 1;
    for (int u = wg; u < NBATCH * NCH * 2; u += nwg) {
        int tid_o = tid_in; asm volatile("" : "+v"(tid_o));
        const int tid = tid_o, lane = tid & 63, r = lane & 15, q = lane >> 4;
        const int th = u & 1, bc = u >> 1, b = bc / NCH, c = bc % NCH, grow0 = b * SEQ + c * SSD_Q;
        v4u xa, xb, hfr[2][4];
#define SC_LOAD(h_) do { const bf16* xp_ = ACTB + (size_t)(grow0 + (tid & 127)) * CONVCH + 64 * (h_) + 16 * (tid >> 7); xa = *(const v4u*)xp_; xb = *(const v4u*)(xp_ + 8); \
            const bf16* hp_ = HST + ((size_t)bc * 8 + (h_)) * (PS * NST) + (size_t)(32 * hf + r) * NST + 8 * q; \
            _Pragma("unroll") for (int pt_ = 0; pt_ < 2; ++pt_) _Pragma("unroll") for (int k_ = 0; k_ < 4; ++k_) hfr[pt_][k_] = *(const v4u*)(hp_ + (size_t)(16 * pt_) * NST + 32 * k_); } while (0)
        SC_LOAD(0);
#pragma unroll 1
        for (int g = 0; g < 2; ++g) {
            __syncthreads();
            if (tid < 8) tmp[8 + tid] = d_skip[tid];
            ssd_scalars(AA, DT, grow0, g, acs, dtl, tmp, tid, lane, wave);
            { const int row = tid >> 2, part = tid & 3; const bf16* src = ACTB + (size_t)(grow0 + row) * CONVCH + 512 + 128 * g + 32 * part;
#pragma unroll
              for (int i = 0; i < 4; ++i) *(LAS v4u*)(Bn + row * LP + 32 * part + 8 * i) = *(const v4u*)(src + 8 * i); }
            { const int row = tid >> 3, part = tid & 7; const bf16* src = ACTB + (size_t)(grow0 + 64 * th + row) * CONVCH + 768 + 128 * g + 16 * part;
#pragma unroll
              for (int i = 0; i < 2; ++i) *(LAS v4u*)(Cn + row * LP + 16 * part + 8 * i) = *(const v4u*)(src + 8 * i); }
            __syncthreads();
            f32x4 G[4];
#pragma unroll
            for (int nt = 0; nt < 4; ++nt) G[nt] = (f32x4){0.f, 0.f, 0.f, 0.f};
#pragma unroll
            for (int k = 0; k < 4; ++k) { const bf16x8 af = ldfrag(Cn, LP, 16 * tt, 32 * k, lane);
#pragma unroll
                for (int nt = 0; nt < 4; ++nt) G[nt] = mfma16(af, ldfrag(Bn, LP, 64 * hf + 16 * nt, 32 * k, lane), G[nt]); }
#pragma unroll 1
            for (int hl = 0; hl < 4; ++hl) {
                const int h = 4 * g + hl;
                __syncthreads();
                const float dsk = tmp[8 + h];
                { const int s = tid & 127, p0 = 16 * (tid >> 7); const float dts = dtl[hl * 128 + s]; float xv[8];
                  unpack8(xa, xv);
#pragma unroll
                  for (int i = 0; i < 8; ++i) XT[(p0 + i) * LP + s] = f2bf16(xv[i] * dts);
                  unpack8(xb, xv);
#pragma unroll
                  for (int i = 0; i < 8; ++i) XT[(p0 + 8 + i) * LP + s] = f2bf16(xv[i] * dts); }
                bf16x8 hcur[2][4];
#pragma unroll
                for (int pt = 0; pt < 2; ++pt)
#pragma unroll
                    for (int k = 0; k < 4; ++k) hcur[pt][k] = __builtin_bit_cast(bf16x8, hfr[pt][k]);
                __builtin_amdgcn_sched_barrier(0);
                if (h < 7) SC_LOAD(h + 1);
                __builtin_amdgcn_sched_barrier(0);
#pragma unroll
                for (int i = 0; i < 4; ++i) { const int tl = 16 * tt + 4 * q + i, ta = 64 * th + tl; const float at = acs[hl * 128 + ta], dinv = dsk / dtl[hl * 128 + ta];
#pragma unroll
                    for (int nt = 0; nt < 4; ++nt) { const int s = 64 * hf + 16 * nt + r;
                        float e = __builtin_amdgcn_exp2f(fminf(at - acs[hl * 128 + s], 0.f) * LOG2E); asm volatile("" : "+v"(e));
                        float v = G[nt][i] * e * ((s <= ta) ? 1.f : 0.f); v += (s == ta) ? dinv : 0.f;
                        GL[tl * LP + s] = f2bf16(v); } }
                __syncthreads();
                f32x4 ya[2] = {(f32x4){0.f, 0.f, 0.f, 0.f}, (f32x4){0.f, 0.f, 0.f, 0.f}};
#pragma unroll
                for (int k = 0; k < 4; ++k) { const bf16x8 af = ldfrag(Cn, LP, 16 * tt, 32 * k, lane);
#pragma unroll
                    for (int pt = 0; pt < 2; ++pt) ya[pt] = mfma16(af, hcur[pt][k], ya[pt]); }
#pragma unroll
                for (int i = 0; i < 4; ++i) { const float ea = __expf(acs[hl * 128 + 64 * th + 16 * tt + 4 * q + i]); ya[0][i] *= ea; ya[1][i] *= ea; }
#pragma unroll
                for (int k = 0; k < 4; ++k) { const bf16x8 af = ldfrag(GL, LP, 16 * tt, 32 * k, lane);
#pragma unroll
                    for (int pt = 0; pt < 2; ++pt) ya[pt] = mfma16(af, ldfrag(XT, LP, 32 * hf + 16 * pt, 32 * k, lane), ya[pt]); }
#pragma unroll
                for (int pt = 0; pt < 2; ++pt)
#pragma unroll
                    for (int i = 0; i < 4; ++i) YL[(16 * tt + 4 * q + i) * YP + 64 * h + 32 * hf + 16 * pt + r] = f2bf16(ya[pt][i]);
            }
        }
#undef SC_LOAD
        __syncthreads();
        { const int tl = tid >> 3, c0 = (tid & 7) * 64; const size_t row = (size_t)grow0 + 64 * th + tl; float v[64]; float ss = 0.f;
#pragma unroll
          for (int k = 0; k < 8; ++k) { float yv[8], zv[8]; unpack8(*(const LAS v4u*)(YL + tl * YP + c0 + 8 * k), yv); unpack8(*(const v4u*)(Zb + row * DSSM + c0 + 8 * k), zv);
#pragma unroll
              for (int i = 0; i < 8; ++i) { const float gv = yv[i] * silu_f(zv[i]); v[8 * k + i] = gv; ss += gv * gv; } }
          ss += __shfl_xor(ss, 1); ss += __shfl_xor(ss, 2); ss += __shfl_xor(ss, 4);
          const float rs = rstd_of(ss, DSSM);
#pragma unroll
          for (int k = 0; k < 8; ++k) { const f32x4 g0 = *(const f32x4*)(gain + c0 + 8 * k), g1 = *(const f32x4*)(gain + c0 + 8 * k + 4);
              const f32x4 a = {v[8 * k] * rs * g0[0], v[8 * k + 1] * rs * g0[1], v[8 * k + 2] * rs * g0[2], v[8 * k + 3] * rs * g0[3]}, bq = {v[8 * k + 4] * rs * g1[0], v[8 * k + 5] * rs * g1[1], v[8 * k + 6] * rs * g1[2], v[8 * k + 7] * rs * g1[3]};
              *(v4u*)(MIX + row * DM + DATT + c0 + 8 * k) = pack8(a, bq); } }
    }
    __syncthreads();
}

#define ROR_ADD(v, n) ((v) + __builtin_bit_cast(float, __builtin_amdgcn_update_dpp(0, __builtin_bit_cast(int, (v)), 0x120 + (n), 0xf, 0xf, false)))
template <bool FOX> __device__ __forceinline__ float slice_sum(float v) {
    v = ROR_ADD(v, 8); v = ROR_ADD(v, 4); v = ROR_ADD(v, 2); v = ROR_ADD(v, 1);
    if (!FOX) { v += __shfl_xor(v, 16); v += __shfl_xor(v, 32); }
    return v;
}
constexpr size_t WS_RC = WS_Y + 8 * MiB;
constexpr size_t WS_PART = WS_Y;
template <bool FOX> __device__ __forceinline__ void decode_unit(const Args& A, LAS unsigned char* lds, int tid_in, int lane_in, int wave, int b, int sl, int part) {
    int tid_o = tid_in; asm volatile("" : "+v"(tid_o));
    const int tid = tid_o, lane = tid & 63;
    constexpr int KPW = FOX ? 64 : 32, NG = KPW / 4;
    const int hl = FOX ? (lane >> 4) : 0;
    LAS float* Rb = (LAS float*)lds;
    LAS float* om = (LAS float*)(lds + 32768);
    LAS float* mlb = (LAS float*)(lds + 65536);
    LAS float* tmp = (LAS float*)(lds + 65536 + 1024);
    const size_t qrow = (size_t)MP + b * DSQ;
    float q[4][4];
    { const bf16* qs = FOX ? (const bf16*)(A.ws + WS_Q) + qrow * DATT + sl * 256 + 4 * lane : (const bf16*)(A.ws + WS_QC) + qrow * DM + sl * 256 + 4 * lane;
#pragma unroll
      for (int t = 0; t < 4; ++t) { const unsigned long long w = *(const unsigned long long*)(qs + (size_t)t * (FOX ? DATT : DM));
          q[t][0] = bf2f((unsigned short)w); q[t][1] = bf2f((unsigned short)(w >> 16)); q[t][2] = bf2f((unsigned short)(w >> 32)); q[t][3] = bf2f((unsigned short)(w >> 48)); } }
    const int* page_table = (const int*)A.in[6];
    __syncthreads();
    if (FOX && part > 0) {
        const float* rc = (const float*)(A.ws + WS_RC) + (size_t)(b * 2 + sl) * (4 * PAST);
        { const int h4 = tid >> 7, k4 = (tid & 127) * 4; *(LAS f32x4*)(Rb + h4 * PAST + 512 * part + k4) = *(const f32x4*)(rc + h4 * PAST + 512 * part + k4); }
        __syncthreads();
    } else if (FOX) {
        const float* cache_logf = (const float*)A.in[5];
        const int h4 = tid >> 7, seg = tid & 127; const int phys = page_table[b * NPAGES + (seg >> 3)]; const size_t base = ((size_t)phys * PAGE + ((16 * seg) & (PAGE - 1))) * HATT + 4 * sl + h4;
        float lp[16]; float tot = 0.f;
#pragma unroll
        for (int i = 0; i < 16; ++i) { lp[i] = cache_logf[base + (size_t)i * HATT] * LOG2E; tot += lp[i]; }
        float inc = tot;
#pragma unroll
        for (int o = 1; o < 64; o <<= 1) { const float t = __shfl_down(inc, o); if (lane + o < 64) inc += t; }
        if (lane == 0) tmp[wave] = inc;
        __syncthreads();
        float after = inc - tot; if (!(wave & 1)) after += tmp[wave + 1];
        float run = after;
#pragma unroll
        for (int i = 15; i >= 0; --i) { Rb[h4 * PAST + 16 * seg + i] = run; run += lp[i]; }
        __syncthreads();
        { float* rc = (float*)(A.ws + WS_RC) + (size_t)(b * 2 + sl) * (4 * PAST);
#pragma unroll
          for (int j = 0; j < 4; ++j) { const int e4 = (tid + NTHREADS * j) * 4; *(f32x4*)(rc + e4) = *(const LAS f32x4*)(Rb + e4); } }
    }
    const float* ck = (const float*)A.in[FOX ? 3 : 7]; const float* cv = (const float*)A.in[FOX ? 4 : 8];
    size_t koff0;
    if (FOX) { const int p0 = page_table[b * NPAGES + 4 * part + (wave >> 1)]; koff0 = (((size_t)p0 * PAGE + 64 * (wave & 1)) * HATT + 4 * sl) * HD + 4 * lane; }
    else koff0 = (((size_t)b * NMEM + 32 * wave) * HX + sl) * HDX + 4 * lane;
    constexpr size_t KSTRIDE = FOX ? (size_t)HATT * HD : (size_t)HX * HDX;
    float m[4], l[4], o[4][4];
#pragma unroll
    for (int t = 0; t < 4; ++t) { m[t] = -1e30f; l[t] = 0.f; o[t][0] = 0.f; o[t][1] = 0.f; o[t][2] = 0.f; o[t][3] = 0.f; }
    f32x4 kf[4], vf[4], nk[4], nv[4];
#define DEC_LOAD(g_, K_, V_) do { const size_t off_ = koff0 + (size_t)(4 * (g_)) * KSTRIDE; \
        _Pragma("unroll") for (int k_ = 0; k_ < 4; ++k_) { K_[k_] = __builtin_nontemporal_load((const f32x4*)(ck + off_ + k_ * KSTRIDE)); V_[k_] = __builtin_nontemporal_load((const f32x4*)(cv + off_ + k_ * KSTRIDE)); } } while (0)
#define DEC_GROUP(K_, V_, B4_, MASKED_) do { float s_[4][4]; \
        _Pragma("unroll") for (int k_ = 0; k_ < 4; ++k_) _Pragma("unroll") for (int t_ = 0; t_ < 4; ++t_) \
            s_[k_][t_] = (q[t_][0] * K_[k_][0] + q[t_][1] * K_[k_][1]) + (q[t_][2] * K_[k_][2] + q[t_][3] * K_[k_][3]); \
          \
        _Pragma("unroll") for (int k_ = 0; k_ < 4; ++k_) _Pragma("unroll") for (int t_ = 0; t_ < 4; ++t_) s_[k_][t_] = ROR_ADD(s_[k_][t_], 8); \
        _Pragma("unroll") for (int k_ = 0; k_ < 4; ++k_) _Pragma("unroll") for (int t_ = 0; t_ < 4; ++t_) s_[k_][t_] = ROR_ADD(s_[k_][t_], 4); \
        _Pragma("unroll") for (int k_ = 0; k_ < 4; ++k_) _Pragma("unroll") for (int t_ = 0; t_ < 4; ++t_) s_[k_][t_] = ROR_ADD(s_[k_][t_], 2); \
        _Pragma("unroll") for (int k_ = 0; k_ < 4; ++k_) _Pragma("unroll") for (int t_ = 0; t_ < 4; ++t_) s_[k_][t_] = ROR_ADD(s_[k_][t_], 1); \
        if (!FOX) { _Pragma("unroll") for (int k_ = 0; k_ < 4; ++k_) _Pragma("unroll") for (int t_ = 0; t_ < 4; ++t_) { float d_ = s_[k_][t_]; d_ += __shfl_xor(d_, 16); d_ += __shfl_xor(d_, 32); s_[k_][t_] = d_; } } \
        _Pragma("unroll") for (int k_ = 0; k_ < 4; ++k_) _Pragma("unroll") for (int t_ = 0; t_ < 4; ++t_) { float d_ = s_[k_][t_] + B4_[k_]; if (MASKED_ && k_ > t_) d_ = -1e30f; s_[k_][t_] = d_; } \
        _Pragma("unroll") for (int t_ = 0; t_ < 4; ++t_) { const float mg_ = __builtin_fmaxf(__builtin_fmaxf(s_[0][t_], s_[1][t_]), __builtin_fmaxf(s_[2][t_], s_[3][t_])); const float mn_ = __builtin_fmaxf(m[t_], mg_); const float f_ = __builtin_amdgcn_exp2f(m[t_] - mn_); \
            const float p0_ = __builtin_amdgcn_exp2f(s_[0][t_] - mn_), p1_ = __builtin_amdgcn_exp2f(s_[1][t_] - mn_), p2_ = __builtin_amdgcn_exp2f(s_[2][t_] - mn_), p3_ = __builtin_amdgcn_exp2f(s_[3][t_] - mn_); \
            l[t_] = l[t_] * f_ + ((p0_ + p1_) + (p2_ + p3_)); m[t_] = mn_; \
            _Pragma("unroll") for (int d_ = 0; d_ < 4; ++d_) o[t_][d_] = o[t_][d_] * f_ + ((p0_ * V_[0][d_] + p1_ * V_[1][d_]) + (p2_ * V_[2][d_] + p3_ * V_[3][d_])); } } while (0)
    DEC_LOAD(0, kf, vf);
    for (int g = 0; g < NG; ++g) {
        if (g + 1 < NG) DEC_LOAD(g + 1, nk, nv);
        f32x4 b4 = {0.f, 0.f, 0.f, 0.f};
        if (FOX) b4 = *(const LAS f32x4*)(Rb + hl * PAST + 512 * part + KPW * wave + 4 * g);
        DEC_GROUP(kf, vf, b4, false);
#pragma unroll
        for (int k = 0; k < 4; ++k) { kf[k] = nk[k]; vf[k] = nv[k]; }
    }
    if (FOX && wave == 0 && part == 3) {
        const bf16* Kb = (const bf16*)(A.ws + WS_K) + qrow * DATT + sl * 256 + 4 * lane; const bf16* Vb = (const bf16*)(A.ws + WS_V) + qrow * DATT + sl * 256 + 4 * lane;
        const float* LOGF = (const float*)(A.ws + WS_LOGF) + qrow * 8 + 4 * sl + hl;
        f32x4 b4; float cn = 0.f;
#pragma unroll
        for (int k = 0; k < 4; ++k) { cn += LOGF[k * 8]; b4[k] = -cn * LOG2E;
            const unsigned long long kw = *(const unsigned long long*)(Kb + (size_t)k * DATT), vw = *(const unsigned long long*)(Vb + (size_t)k * DATT);
            kf[k] = (f32x4){bf2f((unsigned short)kw), bf2f((unsigned short)(kw >> 16)), bf2f((unsigned short)(kw >> 32)), bf2f((unsigned short)(kw >> 48))};
            vf[k] = (f32x4){bf2f((unsigned short)vw), bf2f((unsigned short)(vw >> 16)), bf2f((unsigned short)(vw >> 32)), bf2f((unsigned short)(vw >> 48))}; }
        DEC_GROUP(kf, vf, b4, true);
    }
#undef DEC_LOAD
#undef DEC_GROUP
#pragma unroll
    for (int t = 0; t < 4; ++t) { *(LAS f32x4*)(om + (wave * 4 + t) * 256 + 4 * lane) = (f32x4){o[t][0], o[t][1], o[t][2], o[t][3]};
        if ((lane & 15) == 0) { mlb[((wave * 4 + t) * 4 + (lane >> 4)) * 2] = m[t]; mlb[((wave * 4 + t) * 4 + (lane >> 4)) * 2 + 1] = l[t]; } }
    __syncthreads();
    { const int t = tid >> 7, idx = (tid & 127) * 2, h4 = idx >> 6;
      float M = -1e30f;
#pragma unroll
      for (int w = 0; w < 8; ++w) M = fmaxf(M, mlb[((w * 4 + t) * 4 + h4) * 2]);
      float L = 0.f, o0 = 0.f, o1 = 0.f;
#pragma unroll
      for (int w = 0; w < 8; ++w) { const float f = exp2f(mlb[((w * 4 + t) * 4 + h4) * 2] - M); L += f * mlb[((w * 4 + t) * 4 + h4) * 2 + 1]; const f32x2 ov = *(const LAS f32x2*)(om + (w * 4 + t) * 256 + idx); o0 += f * ov[0]; o1 += f * ov[1]; }
      if (FOX) { float* pb = (float*)(A.ws + WS_PART) + ((size_t)((b * 2 + sl) * 4) * 4 + t) * 272;
          if (part < 3) { *(f32x2*)(pb + (size_t)part * 4 * 272 + idx) = (f32x2){o0, o1}; if ((idx & 63) == 0) { pb[(size_t)part * 4 * 272 + 256 + h4] = M; pb[(size_t)part * 4 * 272 + 260 + h4] = L; } return; }
          float Mp[3], Lp[3]; f32x2 op[3]; float Mt = M;
#pragma unroll
          for (int pp = 0; pp < 3; ++pp) { Mp[pp] = pb[(size_t)pp * 4 * 272 + 256 + h4]; Lp[pp] = pb[(size_t)pp * 4 * 272 + 260 + h4]; op[pp] = *(const f32x2*)(pb + (size_t)pp * 4 * 272 + idx); Mt = fmaxf(Mt, Mp[pp]); }
          const float f3 = exp2f(M - Mt); L *= f3; o0 *= f3; o1 *= f3;
#pragma unroll
          for (int pp = 0; pp < 3; ++pp) { const float f = exp2f(Mp[pp] - Mt); L += f * Lp[pp]; o0 += f * op[pp][0]; o1 += f * op[pp][1]; } }
      const float il = 1.0f / L;
      bf16* dst = FOX ? (bf16*)(A.ws + WS_MIX) : (bf16*)(A.ws + WS_OC);
      *(unsigned*)(dst + (qrow + t) * DM + sl * 256 + idx) = pk2(o0 * il, o1 * il); }
}
template <bool FOX> __device__ __forceinline__ void decode_phase(const Args& A, LAS unsigned char* lds, int tid, int lane, int wave, int wg, int nwg, int part = 0) {
    constexpr int NU = FOX ? DB * 2 : DB * HX;
    for (int u = wg; u < NU; u += nwg) { if (FOX) decode_unit<true>(A, lds, tid, lane, wave, u >> 1, u & 1, part); else decode_unit<false>(A, lds, tid, lane, wave, u >> 2, u & 3, 0); }
    __syncthreads();
}

constexpr int XKP = 264, XVP = 136, XBUF = 69632;
__device__ __forceinline__ void cross_prompt_phase(const Args& A, LAS unsigned char* lds, int tid_in, int lane_in, int wave, int wg, int nwg) {
    const bf16* QC = (const bf16*)(A.ws + WS_QC); const bf16* MKb = (const bf16*)(A.ws + WS_MK); const bf16* MVT = (const bf16*)(A.ws + WS_MV); bf16* OC = (bf16*)(A.ws + WS_OC);
    for (int u = wg; u < NBATCH * HX * (SEQ / 256); u += nwg) {
        int tid_o = tid_in; asm volatile("" : "+v"(tid_o));
        const int tid = tid_o, lane = tid & 63, r = lane & 15, qd = lane >> 4;
        const int qt = u & 31, bh = u >> 5, b = bh >> 2, head = bh & 3; const size_t row0 = (size_t)b * SEQ + 256 * qt + 32 * wave + r;
        __syncthreads();
#pragma unroll
        for (int half = 0; half < 2; ++half) { const int key = tid >> 2, part = tid & 3; const bf16* src = MKb + ((size_t)b * NMEM + half * 128 + key) * DM + head * HDX + part * 64;
            LAS bf16* dst = (LAS bf16*)(lds + half * XBUF) + key * XKP + part * 64;
#pragma unroll
            for (int i = 0; i < 8; ++i) *(LAS v4u*)(dst + 8 * i) = *(const v4u*)(src + 8 * i); }
        __syncthreads();
        bf16x8 pb[2][8]; float il[2];
#pragma unroll
        for (int rt = 0; rt < 2; ++rt) {
            bf16x8 qf[8];
#pragma unroll
            for (int k = 0; k < 8; ++k) qf[k] = *(const bf16x8*)(QC + (row0 + 16 * rt) * DM + head * HDX + 32 * k + 8 * qd);
#pragma unroll
            for (int k = 0; k < 8; ++k) asm volatile("" : "+v"(qf[k]));
            f32x4 ST[16];
#pragma unroll
            for (int half = 0; half < 2; ++half)
#pragma unroll
                for (int kt = 0; kt < 8; ++kt) { f32x4 acc = {0.f, 0.f, 0.f, 0.f};
#pragma unroll
                    for (int k = 0; k < 8; ++k) acc = mfma16(ldfrag((const LAS bf16*)(lds + half * XBUF), XKP, 16 * kt, 32 * k, lane), qf[k], acc);
                    ST[half * 8 + kt] = acc; }
            float mx = -1e30f;
#pragma unroll
            for (int j = 0; j < 16; ++j) mx = fmaxf(mx, fmaxf(fmaxf(ST[j][0], ST[j][1]), fmaxf(ST[j][2], ST[j][3])));
            mx = fmaxf(mx, __shfl_xor(mx, 16)); mx = fmaxf(mx, __shfl_xor(mx, 32));
            float l = 0.f;
#pragma unroll
            for (int j = 0; j < 16; ++j)
#pragma unroll
                for (int i = 0; i < 4; ++i) { ST[j][i] = exp2f(ST[j][i] - mx); l += ST[j][i]; }
            l += __shfl_xor(l, 16); l += __shfl_xor(l, 32); il[rt] = 1.0f / l;
#pragma unroll
            for (int uu = 0; uu < 8; ++uu) { pb[rt][uu] = __builtin_bit_cast(bf16x8, pack8(ST[2 * uu], ST[2 * uu + 1])); asm volatile("" : "+v"(pb[rt][uu])); }
            __builtin_amdgcn_sched_barrier(0);
        }
        __syncthreads();
#pragma unroll
        for (int half = 0; half < 2; ++half) { const bf16* src = MVT + ((size_t)bh * HDX) * NMEM + half * 128; LAS bf16* dst = (LAS bf16*)(lds + half * XBUF);
#pragma unroll
            for (int j = 0; j < 8; ++j) { const int id = tid + NTHREADS * j, d = id >> 4, c = id & 15; *(LAS v4u*)(dst + d * XVP + 8 * c) = *(const v4u*)(src + (size_t)d * NMEM + 8 * c); } }
        __syncthreads();
#pragma unroll
        for (int rt = 0; rt < 2; ++rt) {
            f32x4 OT[16];
#pragma unroll
            for (int dt = 0; dt < 16; ++dt) OT[dt] = (f32x4){0.f, 0.f, 0.f, 0.f};
#pragma unroll
            for (int half = 0; half < 2; ++half)
#pragma unroll
                for (int u4 = 0; u4 < 4; ++u4)
#pragma unroll
                    for (int dt = 0; dt < 16; ++dt) { const LAS bf16* vp = (const LAS bf16*)(lds + half * XBUF) + (16 * dt + r) * XVP + 32 * u4 + 4 * qd;
                        const unsigned long long lo = *(const LAS unsigned long long*)vp, hi = *(const LAS unsigned long long*)(vp + 16);
                        v4u w; w.x = (unsigned)lo; w.y = (unsigned)(lo >> 32); w.z = (unsigned)hi; w.w = (unsigned)(hi >> 32);
                        OT[dt] = mfma16(__builtin_bit_cast(bf16x8, w), pb[rt][half * 4 + u4], OT[dt]); }
            const float ilv = il[rt];
#pragma unroll
            for (int dt = 0; dt < 16; ++dt) *(unsigned long long*)(OC + (row0 + 16 * rt) * DM + head * HDX + 16 * dt + 4 * qd) = (unsigned long long)pk2(OT[dt][0] * ilv, OT[dt][1] * ilv) | ((unsigned long long)pk2(OT[dt][2] * ilv, OT[dt][3] * ilv) << 32);
            __builtin_amdgcn_sched_barrier(0);
        }
    }
    __syncthreads();
}

template <class F> __device__ __forceinline__ void small_gemm(LAS unsigned char* lds, const bf16* __restrict__ Am, int row_base, int M, const bf16* __restrict__ Bt, int N, int K, const F& f, int tid_in, int wave, int wg, int nwg) {
    const int tiles_m = M / 32, ntiles = tiles_m * (N / 128), kw = K / 8;
    LAS float* part = (LAS float*)lds;
    for (int tile = wg; tile < ntiles; tile += nwg) {
        int tid_o = tid_in; asm volatile("" : "+v"(tid_o));
        const int lane = tid_o & 63, r = lane & 15, qd = lane >> 4;
        const int tm = tile % tiles_m, tn = tile / tiles_m;
        const bf16* ap = Am + (size_t)(32 * tm + r) * K + wave * kw + 8 * qd; const bf16* bp = Bt + (size_t)(128 * tn + r) * K + wave * kw + 8 * qd;
        f32x4 acc[2][8];
#pragma unroll
        for (int mt = 0; mt < 2; ++mt)
#pragma unroll
            for (int nt = 0; nt < 8; ++nt) acc[mt][nt] = (f32x4){0.f, 0.f, 0.f, 0.f};
#pragma unroll 2
        for (int ks = 0; ks < kw / 32; ++ks) { bf16x8 af[2], bfr[8];
#pragma unroll
            for (int mt = 0; mt < 2; ++mt) af[mt] = *(const bf16x8*)(ap + (size_t)(16 * mt) * K + 32 * ks);
#pragma unroll
            for (int nt = 0; nt < 8; ++nt) bfr[nt] = *(const bf16x8*)(bp + (size_t)(16 * nt) * K + 32 * ks);
#pragma unroll
            for (int mt = 0; mt < 2; ++mt)
#pragma unroll
                for (int nt = 0; nt < 8; ++nt) acc[mt][nt] = mfma16(af[mt], bfr[nt], acc[mt][nt]); }
#pragma unroll
        for (int mt = 0; mt < 2; ++mt)
#pragma unroll
            for (int nt = 0; nt < 8; ++nt)
#pragma unroll
                for (int i = 0; i < 4; ++i) part[(wave * 32 + 16 * mt + 4 * qd + i) * 128 + 16 * nt + r] = acc[mt][nt][i];
        __syncthreads();
        { const int row = (wave & 1) * 16 + r, col0 = ((wave >> 1) * 4 + qd) * 8; f32x4 v0 = {0.f, 0.f, 0.f, 0.f}, v1 = {0.f, 0.f, 0.f, 0.f};
#pragma unroll
          for (int w = 0; w < 8; ++w) { v0 = v0 + *(const LAS f32x4*)(part + (w * 32 + row) * 128 + col0); v1 = v1 + *(const LAS f32x4*)(part + (w * 32 + row) * 128 + col0 + 4); }
          f(row_base + 32 * tm + row, 128 * tn + col0, v0, v1); }
        __syncthreads();
    }
}

template <class Epi> __device__ __forceinline__ void run_gemm(LAS unsigned char* lds, const bf16* Am, const bf16* Bt, int M, int N, int K, int nwg, int wg, const Epi& E) {
    pg8::Gemm g{Am, Bt, M, N, K}; pg8::StaticOrder S; S.init(M, N, nwg, wg);
    pg8::gemm_phase<Epi, pg8::StaticOrder, true, true>((PG8_LAS unsigned char*)lds, g, S, E);
}

__global__ void __launch_bounds__(NTHREADS, 2) mk_fwd(Args A) {
    extern __shared__ __attribute__((aligned(16))) unsigned char lds_raw[];
    LAS unsigned char* lds = (LAS unsigned char*)lds_raw;
    const int tid = threadIdx.x, lane = tid & 63, wave = __builtin_amdgcn_readfirstlane(tid >> 6);
#define LANE() lane
#define TID() tid
    const int wg = blockIdx.x, nwg = gridDim.x;
    unsigned char* ws = A.ws;
    for (int u = TID(); u < (LDS_BYTES - LDSCTL_OFF) / 4; u += NTHREADS) ((LAS unsigned*)(lds + LDSCTL_OFF))[u] = 0u;
    __syncthreads();
    volatile LAS unsigned* MISC = (volatile LAS unsigned*)(lds + MISC_OFF);
    XcdBarrier bar; bar.bar = (unsigned*)(ws + WS_CTL) + CW_BAR; bar.x = 0; bar.st = nullptr;
    if (MK_ONE_LAUNCH) bar = xcd_barrier_post((unsigned*)(ws + WS_CTL) + CW_BAR, MISC + 8);
    const int lo = A.ph_lo, hi = A.ph_hi;
#define IN(k) (lo <= (k) && (k) < hi)
#define SEAM(k) do { if (MK_ONE_LAUNCH && IN(k) && IN((k) + 1)) xcd_barrier(bar); } while (0)
#ifndef REP_PHASE
#define REP_PHASE -1
#endif
#define REP(k, body) do { body; if (REP_PHASE == (k)) { body; } } while (0)
    bf16* XB = (bf16*)(ws + WS_XB);

    if (IN(0)) { REP(0, p0_prologue(A, lds, TID(), LANE(), wave, wg, nwg)); } SEAM(0);
    if (IN(1)) {
        if (wg < NBATCH * HATT) p1_cumsum(A, lds, TID(), LANE(), wave, wg);
        { const FMemKV Fm{(const float*)(ws + WS_SSM), (bf16*)(ws + WS_MK), (bf16*)(ws + WS_MV), A.out};
          small_gemm(lds, (const bf16*)(ws + WS_MB), 0, MMEM, (const bf16*)(ws + WS_WCKV), 2048, DM, Fm, TID(), wave, wg, nwg); }
        { const FInproj Fi{(const float*)(ws + WS_SS0), (bf16*)(ws + WS_Q), (bf16*)(ws + WS_K), (bf16*)(ws + WS_V), (bf16*)(ws + WS_Z), (bf16*)(ws + WS_XBC), A.out};
          small_gemm(lds, XB + (size_t)MP * DM, MP, MS, (const bf16*)(ws + WS_WIN), 3072, DM, Fi, TID(), wave, wg, nwg);
          pg8::Epi8<FInproj> E{Fi}; REP(1, run_gemm(lds, XB, (const bf16*)(ws + WS_WIN), MP, 3072, DM, nwg, wg, E)); }
    } SEAM(1);
    if (IN(2)) { if (wg & 1) decode_phase<true>(A, lds, TID(), LANE(), wave, wg, nwg, 0);
        if (nwg == 256) wconv(A, (LAS float*)(lds + wave * 8448), 1, wg * NWAVES + wave, nwg * NWAVES, LANE()); __syncthreads(); attn_norms(A, LANE(), wave, wg, nwg); REP(21, conv_pass(A, TID(), wg, nwg)); REP(2, ssd_phase_a(A, lds, TID(), LANE(), wave, wg, nwg));
        if (!(wg & 1)) decode_phase<true>(A, lds, TID(), LANE(), wave, wg, nwg, 0); } SEAM(2);
    if (IN(3)) { for (int rep3 = 0; rep3 < (REP_PHASE == 3 ? 2 : 1); ++rep3) {
        REP(30, ssd_phase_b(A, TID(), wg, nwg)); REP(33, (p3_ssd_naive(A, lds, LANE(), wave, wg, nwg, NBATCH * HSSM * 4), __syncthreads()));
        { const attn_body::AttnTensors AT{(const attn_body::bf16*)(ws + WS_Q), (const attn_body::bf16*)(ws + WS_K), (const attn_body::bf16*)(ws + WS_V), (attn_body::bf16*)(ws + WS_MIX), (const float*)(ws + WS_CUM), (const float*)(ws + WS_KN), (const float*)(ws + WS_QN)};
          const int grp = wg & 1; int dp = 0;
          gu32* aq = (gu32*)(ws + WS_CTL) + CW_AQ;
          for (;;) {
              int zo_; asm volatile("s_mov_b32 %0, 0" : "=s"(zo_));
              if (grp == 0 && dp < 2) { decode_phase<true>(A, lds + zo_, TID(), LANE(), wave, wg, nwg, 1 + dp); ++dp; }
              if (TID() == 0) MISC[0] = __hip_atomic_fetch_add(aq, 1u, __ATOMIC_RELAXED, __HIP_MEMORY_SCOPE_AGENT);
              __syncthreads();
              const int uq = (int)MISC[0];
              __syncthreads();
              if (uq < NBATCH * HATT * (SEQ / 256)) attn_body::attn_unit<64>((uq & 15) >> 3, uq & 7, (SEQ / 256 - 1) - (uq >> 4), AT.Q, AT.K, AT.V, AT.O, AT.CUM, AT.KN, AT.QN, (char*)lds_raw);
              if (grp == 1 && dp < 2) { decode_phase<true>(A, lds + zo_, TID(), LANE(), wave, wg, nwg, 1 + dp); ++dp; }
              if (uq >= NBATCH * HATT * (SEQ / 256) && dp == 2) break;
          } } } } SEAM(3);
    if (IN(4)) { p4_gate_norm(A, LANE(), wave, wg, nwg, MP); for (int slot = 0; slot < 2; ++slot) { int zo_; asm volatile("s_mov_b32 %0, 0" : "=s"(zo_)); if ((slot ^ (wg & 1)) == 0) decode_phase<true>(A, lds + zo_, TID(), LANE(), wave, wg, nwg, 3); else { REP(4, ssd_phase_c(A, lds + zo_, TID(), LANE(), wave, wg, nwg)); } } } SEAM(4);
    if (IN(5)) { const FRes Fr{(const float*)A.in[0], (const float*)A.in[1], XB, (float*)(ws + WS_SS1)};
        small_gemm(lds, (const bf16*)(ws + WS_MIX) + (size_t)MP * DM, MP, MS, (const bf16*)(ws + WS_WOUT), DM, DM, Fr, TID(), wave, wg, nwg);
        if (nwg == 256 && wg >= 128) { wconv(A, (LAS float*)(lds + wave * 8448), 2, (wg - 128) * NWAVES + wave, (nwg - 128) * NWAVES, LANE()); __syncthreads(); }
        pg8::Epi8<FRes> E{Fr}; run_gemm(lds, (const bf16*)(ws + WS_MIX), (const bf16*)(ws + WS_WOUT), MP, DM, DM, nwg, wg, E); } SEAM(5);
    if (IN(6)) { const FScaleBf16 Fs{(const float*)(ws + WS_SS1), (bf16*)(ws + WS_QC), XC2};
        small_gemm(lds, XB + (size_t)MP * DM, MP, MS, (const bf16*)(ws + WS_WCQ), DM, DM, Fs, TID(), wave, wg, nwg);
        if (nwg == 256 && wg >= 128) { wconv(A, (LAS float*)(lds + wave * 8448), 3, (wg - 128) * NWAVES + wave, (nwg - 128) * NWAVES, LANE()); __syncthreads(); }
        pg8::Epi8<FScaleBf16> E{Fs}; REP(6, run_gemm(lds, XB, (const bf16*)(ws + WS_WCQ), MP, DM, DM, nwg, wg, E)); } SEAM(6);
    if (IN(7)) {
        if (wg & 1) { REP(71, decode_phase<false>(A, lds, TID(), LANE(), wave, wg, nwg)); REP(72, cross_prompt_phase(A, lds, TID(), LANE(), wave, wg, nwg)); }
        else { REP(72, cross_prompt_phase(A, lds, TID(), LANE(), wave, wg, nwg)); REP(71, decode_phase<false>(A, lds, TID(), LANE(), wave, wg, nwg)); } } SEAM(7);
    if (IN(8)) { const FRes Fr{nullptr, nullptr, XB, (float*)(ws + WS_SS2)};
        small_gemm(lds, (const bf16*)(ws + WS_OC) + (size_t)MP * DM, MP, MS, (const bf16*)(ws + WS_WCO), DM, DM, Fr, TID(), wave, wg, nwg);
        if (nwg == 256 && wg >= 128) { wconv(A, (LAS float*)(lds + wave * 8448), 5, (wg - 128) * NWAVES + wave, (nwg - 128) * NWAVES, LANE()); __syncthreads(); }
        pg8::Epi8<FRes> E{Fr}; run_gemm(lds, (const bf16*)(ws + WS_OC), (const bf16*)(ws + WS_WCO), MP, DM, DM, nwg, wg, E); } SEAM(8);
    if (IN(9)) { pg8::EpiGU<FGateUp> E{{(const float*)(ws + WS_SS2), (bf16*)(ws + WS_U)}};
        REP(9, run_gemm(lds, XB, (const bf16*)(ws + WS_WGU), MT, 2 * DFF, DM, nwg, wg, E));
        if (nwg == 256 && wg >= 172) { wconv(A, (LAS float*)(lds + wave * 8448), 6, (wg - 172) * NWAVES + wave, (nwg - 172) * NWAVES, LANE()); } } SEAM(9);
    if (IN(10)) { const FRes Fr{nullptr, nullptr, XB, (float*)(ws + WS_SS3)};
        small_gemm(lds, (const bf16*)(ws + WS_U) + (size_t)MP * DFF, MP, MS, (const bf16*)(ws + WS_WD), DM, DFF, Fr, TID(), wave, wg, nwg);
        pg8::Epi8<FRes> E{Fr}; run_gemm(lds, (const bf16*)(ws + WS_U), (const bf16*)(ws + WS_WD), MP, DM, DFF, nwg, wg, E); } SEAM(10);
    if (IN(11)) { REP(11, p11_final_norm(A, LANE(), wave, wg, nwg)); }
#undef IN
#undef SEAM
#undef LANE
#undef TID
}

extern "C" void kernel_launch(void* const* d_in, const int* in_sizes, int n_in, void* d_out, int out_size, void* d_ws, size_t ws_size, hipStream_t stream) {
    static int grid = 0;
    if (grid == 0) {
        if (n_in != 32 || out_size != (int)OUT_TOTAL || ws_size < WS_END2) { fprintf(stderr, "kernel_launch: unexpected shapes (n_in %d out %d ws %zu)\n", n_in, out_size, ws_size); grid = -1; return; }
        int dev = 0, cus = 0, per_cu = 0;
        if (hipGetDevice(&dev) != hipSuccess || hipDeviceGetAttribute(&cus, hipDeviceAttributeMultiprocessorCount, dev) != hipSuccess) { grid = -1; return; }
        if (hipFuncSetAttribute((const void*)mk_fwd, hipFuncAttributeMaxDynamicSharedMemorySize, LDS_BYTES) != hipSuccess) { fprintf(stderr, "kernel_launch: hipFuncSetAttribute failed\n"); grid = -1; return; }
        if (hipOccupancyMaxActiveBlocksPerMultiprocessor(&per_cu, (const void*)mk_fwd, NTHREADS, LDS_BYTES) != hipSuccess || per_cu < 1) fprintf(stderr, "kernel_launch: occupancy query reports %d\n", per_cu);
        (void)hipGetLastError();
        grid = cus;
    }
    if (grid < 0) return;
    (void)hipMemsetAsync((char*)d_ws + WS_CTL, 0, CTL_ZERO_BYTES, stream);
    Args a{};
    for (int i = 0; i < 32; ++i) a.in[i] = d_in[i];
    a.out = (float*)d_out; a.ws = (unsigned char*)d_ws;
    if (MK_ONE_LAUNCH) { a.ph_lo = 0; a.ph_hi = NPH; hipLaunchKernelGGL(mk_fwd, dim3(grid), dim3(NTHREADS), LDS_BYTES, stream, a); }
    else for (int p = 0; p < NPH; ++p) { a.ph_lo = p; a.ph_hi = p + 1; hipLaunchKernelGGL(mk_fwd, dim3(grid), dim3(NTHREADS), LDS_BYTES, stream, a); }
}
```

```cpp
#include <hip/hip_runtime.h>
#include <cstdio>
#include <cstdint>
#include <cmath>
#define GAS __attribute__((address_space(1)))
#define LAS __attribute__((address_space(3)))
typedef unsigned short bf16;
typedef unsigned v4u __attribute__((ext_vector_type(4)));
typedef float f32x4 __attribute__((ext_vector_type(4)));
typedef short bf16x8 __attribute__((ext_vector_type(8)));
typedef GAS unsigned gu32;
typedef GAS unsigned long long gu64;
#define RLX_AGENT __ATOMIC_RELAXED, __HIP_MEMORY_SCOPE_AGENT
#define LDS_WAIT() asm volatile("s_waitcnt lgkmcnt(0)" ::: "memory")
#define VM_WAIT() asm volatile("s_waitcnt vmcnt(0)" ::: "memory")
__device__ __forceinline__ unsigned long long rt() { return __builtin_amdgcn_s_memrealtime(); }
__device__ __forceinline__ unsigned f2bf(float f) { unsigned u = __builtin_bit_cast(unsigned, f); return (u + 0x7fffu + ((u >> 16) & 1u)) >> 16; }
__device__ __forceinline__ unsigned pk2(float lo, float hi) { return f2bf(lo) | (f2bf(hi) << 16); }
typedef float f32x2 __attribute__((ext_vector_type(2)));
namespace pg8 {
#define PG8_LAS __attribute__((address_space(3)))
typedef unsigned short bf16_t;
typedef short bf16x8 __attribute__((ext_vector_type(8)));
typedef float f32x4 __attribute__((ext_vector_type(4)));
typedef unsigned u32x4 __attribute__((ext_vector_type(4)));
constexpr int BM = 256, BK = 64, HALF = 128, HTB = HALF * BK * 2  , STAGE_BYTES = 8 * HTB, NXCD = 8, WGM = 8;

__host__ __device__ __forceinline__ int lds_byte(int r, int c) { const int st = (r >> 4) * 2 + (c >> 5), rr = r & 15, cc = c & 31, ob = rr * 64 + cc * 2; return st * 1024 + (ob ^ (((ob >> 9) & 1) << 5)); }
__host__ __device__ __forceinline__ void stage_rc(int b, int& R, int& C) { const int st = b / 1024, sb = b % 1024, swz = sb ^ (((sb >> 9) & 1) << 5); R = (st >> 1) * 16 + swz / 64; C = (st & 1) * 32 + (swz % 64) / 2; }
__host__ __device__ __forceinline__ int perm32(int rho) { const int n = rho >> 4, i = rho & 15; return 8 * (i >> 2) + 4 * n + (i & 3); }

struct Unit { int pm, pn; };
struct Gemm { const bf16_t* A; const bf16_t* Bt; int M, N, K; };

struct StaticOrder {
    int nM, nN, nwg, G, c;
    __host__ __device__ void init(int M, int N, int G_, int c_) { nM = M / BM; nN = N / BM; nwg = nM * nN; G = G_; c = c_; }
    __host__ __device__ bool next(int i, Unit& u) const {
        const long L = (long)i * G + c; if (L >= nwg) return false;
        int wgid = (int)L; { const int q = nwg / NXCD, r = nwg % NXCD, xcd = wgid % NXCD, off = wgid / NXCD; wgid = (xcd < r ? xcd * (q + 1) : r * (q + 1) + (xcd - r) * q) + off; }
        const int nig = WGM * nN, gid = wgid / nig, fm = gid * WGM, gsz = (nM - fm) < WGM ? (nM - fm) : WGM;
        u.pm = fm + ((wgid % nig) % gsz); u.pn = (wgid % nig) / gsz; return true;
    }
    __device__ __forceinline__ void a_ready(const Unit&) const {}
    __device__ __forceinline__ void done(const Unit&) const {}
};

__device__ __forceinline__ unsigned cvt_pk_bf16(float lo, float hi) { unsigned r; asm volatile("v_cvt_pk_bf16_f32 %0, %1, %2" : "=v"(r) : "v"(lo), "v"(hi)); return r; }
typedef float f32x2 __attribute__((ext_vector_type(2)));
template <class F> struct Epi8 {
    static constexpr bool PERM = true, AFTER_DRAIN = false;
    F f;
    __device__ __forceinline__ void operator()(const f32x4 (&acc)[2][2][4][2], const Unit& u, int wr, int wc, int fr, int fq) const {
        const int row0 = u.pm * BM + wr * 64 + fr, col0 = u.pn * BM + wc * 32 + 8 * fq;
#pragma unroll
        for (int ai = 0; ai < 2; ++ai) { typename F::Pre pre[4][2];
#pragma unroll
            for (int m = 0; m < 4; ++m)
#pragma unroll
                for (int bj = 0; bj < 2; ++bj) f.prefetch(row0 + ai * HALF + m * 16, col0 + bj * HALF, pre[m][bj]);
#pragma unroll
            for (int m = 0; m < 4; ++m)
#pragma unroll
                for (int bj = 0; bj < 2; ++bj) f.apply(row0 + ai * HALF + m * 16, col0 + bj * HALF, acc[ai][bj][m][0], acc[ai][bj][m][1], pre[m][bj]); }
    }
};
template <class F> struct EpiGU {
    static constexpr bool PERM = true, AFTER_DRAIN = false;
    F f;
    __device__ __forceinline__ void operator()(const f32x4 (&acc)[2][2][4][2], const Unit& u, int wr, int wc, int fr, int fq) const {
        const int row0 = u.pm * BM + wr * 64 + fr, col0 = u.pn * HALF + wc * 32 + 8 * fq;
        typename F::Pre pre[2][4];
#pragma unroll
        for (int ai = 0; ai < 2; ++ai)
#pragma unroll
            for (int m = 0; m < 4; ++m) f.prefetch(row0 + ai * HALF + m * 16, col0, pre[ai][m]);
#pragma unroll
        for (int ai = 0; ai < 2; ++ai)
#pragma unroll
            for (int m = 0; m < 4; ++m) f.apply(row0 + ai * HALF + m * 16, col0, acc[ai][0][m][0], acc[ai][0][m][1], acc[ai][1][m][0], acc[ai][1][m][1], pre[ai][m]);
    }
};
template <class Epi, class Sched, bool ALIGN_EPI = false, bool SP2 = false>
__device__ __forceinline__ void gemm_phase(PG8_LAS unsigned char* lds, const Gemm g, const Sched& S, const Epi& E) {
    const int tid = threadIdx.x, wid = __builtin_amdgcn_readfirstlane(tid >> 6), lane = tid & 63, wr = wid >> 2, wc = wid & 3, fr = lane & 15, fq = lane >> 4;
    const int K = g.K, nt = K / BK;
    unsigned voffA[2], voffB[2];
#pragma unroll
    for (int i = 0; i < 2; ++i) { int R, C; stage_rc(tid * 16 + i * 8192, R, C); const int Rb = Epi::PERM ? ((R & ~31) + perm32(R & 31)) : R;
        voffA[i] = (unsigned)(R * K + C) * 2u; voffB[i] = (unsigned)(Rb * K + C) * 2u; }
    const size_t kstep = (size_t)(BK * 2);
    const size_t hstep = (size_t)HALF * K * 2;
    const size_t tstep = 2 * hstep;
    const unsigned ldsw = (unsigned)wid * 1024u;
    const int aoff = lds_byte(wr * 64 + fr, fq * 8), boff = lds_byte(wc * 32 + fr, fq * 8);
#define PG8_SA(b, h) (((b) * 2 + (h)) * HTB)
#define PG8_SB(b, h) ((4 + (b) * 2 + (h)) * HTB)
#define PG8_STAGE(bufoff, gbase, voff) do { _Pragma("unroll") for (int _i = 0; _i < 2; ++_i) \
        __builtin_amdgcn_global_load_lds((const unsigned*)((const char*)(gbase) + (voff)[_i]), (PG8_LAS unsigned*)(lds + (bufoff) + ldsw + _i * 8192), 16, 0, 0); } while (0)
#define PG8_LDA(dst, b, h) do { _Pragma("unroll") for (int m = 0; m < 4; ++m) _Pragma("unroll") for (int k = 0; k < 2; ++k) dst[m][k] = *(const PG8_LAS bf16x8*)(lds + PG8_SA(b, h) + aoff + m * 2048 + k * 1024); } while (0)
#define PG8_LDB(dst, b, h) do { _Pragma("unroll") for (int n = 0; n < 2; ++n) _Pragma("unroll") for (int k = 0; k < 2; ++k) dst[n][k] = *(const PG8_LAS bf16x8*)(lds + PG8_SB(b, h) + boff + n * 2048 + k * 1024); } while (0)
#define PG8_MMA(ai, bj, At, Bt) do { __builtin_amdgcn_s_setprio(1); _Pragma("unroll") for (int m = 0; m < 4; ++m) _Pragma("unroll") for (int n = 0; n < 2; ++n) _Pragma("unroll") for (int k = 0; k < 2; ++k) \
        acc[ai][bj][m][n] = __builtin_amdgcn_mfma_f32_16x16x32_bf16(Bt[n][k], At[m][k], acc[ai][bj][m][n], 0, 0, 0); __builtin_amdgcn_s_setprio(0); } while (0)
#define PG8_WAIT_V(n) asm volatile("s_waitcnt vmcnt(" #n ")" ::: "memory")
#define PG8_WAIT_L(n) asm volatile("s_waitcnt lgkmcnt(" #n ")" ::: "memory")
#define PG8_BAR __builtin_amdgcn_s_barrier()
#define PG8_SCHED __builtin_amdgcn_sched_barrier(0)
    Unit cur, nxt; int ui = 0;
    if (!S.next(0, cur)) return;
    f32x4 acc[2][2][4][2];
#pragma unroll
    for (int a = 0; a < 2; ++a)
#pragma unroll
        for (int b = 0; b < 2; ++b)
#pragma unroll
            for (int m = 0; m < 4; ++m)
#pragma unroll
                for (int n = 0; n < 2; ++n) acc[a][b][m][n] = (f32x4){0.f, 0.f, 0.f, 0.f};
    bf16x8 At[4][2], B0[2][2], B1[2][2];
    const char* cA = (const char*)g.A + (size_t)cur.pm * tstep; const char* cB = (const char*)g.Bt + (size_t)cur.pn * tstep;
    S.a_ready(cur);
    if constexpr (SP2) {
        PG8_STAGE(PG8_SB(0, 0), cB, voffB); PG8_STAGE(PG8_SB(0, 1), cB + hstep, voffB); PG8_STAGE(PG8_SA(0, 0), cA, voffA); PG8_STAGE(PG8_SA(0, 1), cA + hstep, voffA);
        if (wr == 1) PG8_BAR;
        PG8_WAIT_V(2); PG8_BAR;
        PG8_STAGE(PG8_SB(1, 0), cB + kstep, voffB); PG8_STAGE(PG8_SA(1, 0), cA + kstep, voffA); PG8_STAGE(PG8_SB(1, 1), cB + hstep + kstep, voffB);
        PG8_WAIT_V(6); PG8_BAR;
    } else {
        PG8_STAGE(PG8_SB(0, 0), cB, voffB); PG8_STAGE(PG8_SA(0, 0), cA, voffA); PG8_STAGE(PG8_SB(0, 1), cB + hstep, voffB); PG8_STAGE(PG8_SA(0, 1), cA + hstep, voffA);
        if (wr == 1) PG8_BAR;
        PG8_WAIT_V(4); PG8_BAR;
        PG8_STAGE(PG8_SB(1, 0), cB + kstep, voffB); PG8_STAGE(PG8_SA(1, 0), cA + kstep, voffA); PG8_STAGE(PG8_SB(1, 1), cB + hstep + kstep, voffB);
        PG8_WAIT_V(6); PG8_BAR;
    }
    for (;;) {
        const bool has_next = S.next(ui + 1, nxt);
        const char* nA = has_next ? (const char*)g.A + (size_t)nxt.pm * tstep : cA; const char* nB = has_next ? (const char*)g.Bt + (size_t)nxt.pn * tstep : cB;
        for (int t = 0; t < nt; t += 2) {
            const bool last = (t == nt - 2);
            const char* a1 = cA + (size_t)(t + 1) * kstep;
            const char* a2 = last ? nA : cA + (size_t)(t + 2) * kstep; const char* b2 = last ? nB : cB + (size_t)(t + 2) * kstep;
            const char* a3 = a2 + kstep; const char* b3 = b2 + kstep;
            if (last && has_next) S.a_ready(nxt);
            if constexpr (SP2) {
            PG8_LDB(B0, 0, 0); PG8_LDB(B1, 0, 1); PG8_SCHED; PG8_LDA(At, 0, 0); PG8_STAGE(PG8_SA(1, 1), a1 + hstep, voffA);
            PG8_WAIT_V(8); PG8_WAIT_L(0); PG8_BAR; PG8_MMA(0, 0, At, B0); PG8_MMA(0, 1, At, B1); PG8_BAR; PG8_SCHED;
            PG8_LDA(At, 0, 1); PG8_STAGE(PG8_SB(0, 0), b2, voffB); PG8_STAGE(PG8_SB(0, 1), b2 + hstep, voffB); PG8_STAGE(PG8_SA(0, 0), a2, voffA);
            PG8_WAIT_V(8); PG8_WAIT_L(0); PG8_BAR; PG8_MMA(1, 0, At, B0); PG8_MMA(1, 1, At, B1); PG8_BAR; PG8_SCHED;
            PG8_LDB(B0, 1, 0); PG8_LDB(B1, 1, 1); PG8_SCHED; PG8_LDA(At, 1, 0); PG8_STAGE(PG8_SA(0, 1), a2 + hstep, voffA);
            PG8_WAIT_V(8); PG8_WAIT_L(0); PG8_BAR; PG8_MMA(0, 0, At, B0); PG8_MMA(0, 1, At, B1); PG8_BAR; PG8_SCHED;
            PG8_LDA(At, 1, 1); PG8_STAGE(PG8_SB(1, 0), b3, voffB); PG8_STAGE(PG8_SB(1, 1), b3 + hstep, voffB); PG8_STAGE(PG8_SA(1, 0), a3, voffA);
            PG8_WAIT_V(8); PG8_WAIT_L(0); PG8_BAR; PG8_MMA(1, 0, At, B0); PG8_MMA(1, 1, At, B1); PG8_BAR; PG8_SCHED;
            } else {
            PG8_LDB(B0, 0, 0); PG8_SCHED; PG8_LDA(At, 0, 0); PG8_STAGE(PG8_SA(1, 1), a1 + hstep, voffA);
            PG8_WAIT_L(8); PG8_BAR; PG8_WAIT_L(0); PG8_MMA(0, 0, At, B0); PG8_BAR; PG8_SCHED;
            PG8_LDB(B1, 0, 1); PG8_STAGE(PG8_SB(0, 0), b2, voffB);
            PG8_BAR; PG8_WAIT_L(0); PG8_MMA(0, 1, At, B1); PG8_BAR;
            PG8_LDA(At, 0, 1); PG8_STAGE(PG8_SA(0, 0), a2, voffA);
            PG8_BAR; PG8_WAIT_L(0); PG8_MMA(1, 0, At, B0); PG8_BAR; PG8_SCHED;
            PG8_STAGE(PG8_SB(0, 1), b2 + hstep, voffB);
            PG8_WAIT_V(6); PG8_BAR; PG8_MMA(1, 1, At, B1); PG8_BAR;
            PG8_LDB(B0, 1, 0); PG8_SCHED; PG8_LDA(At, 1, 0); PG8_STAGE(PG8_SA(0, 1), a2 + hstep, voffA);
            PG8_WAIT_L(8); PG8_BAR; PG8_WAIT_L(0); PG8_MMA(0, 0, At, B0); PG8_BAR; PG8_SCHED;
            PG8_LDB(B1, 1, 1); PG8_STAGE(PG8_SB(1, 0), b3, voffB);
            PG8_BAR; PG8_WAIT_L(0); PG8_MMA(0, 1, At, B1); PG8_BAR;
            PG8_LDA(At, 1, 1); PG8_STAGE(PG8_SA(1, 0), a3, voffA);
            PG8_BAR; PG8_WAIT_L(0); PG8_MMA(1, 0, At, B0); PG8_BAR; PG8_SCHED;
            PG8_STAGE(PG8_SB(1, 1), b3 + hstep, voffB);
            PG8_WAIT_V(6); PG8_BAR; PG8_MMA(1, 1, At, B1); PG8_BAR;
            }
        }
        if constexpr (ALIGN_EPI) { if (wr == 0) PG8_BAR; }
        if constexpr (!Epi::AFTER_DRAIN) { E(acc, cur, wr, wc, fr, fq); S.done(cur); }
        if (!has_next) break;
#pragma unroll
        for (int a = 0; a < 2; ++a)
#pragma unroll
            for (int b = 0; b < 2; ++b)
#pragma unroll
                for (int m = 0; m < 4; ++m)
#pragma unroll
                    for (int n = 0; n < 2; ++n) acc[a][b][m][n] = (f32x4){0.f, 0.f, 0.f, 0.f};
        cur = nxt; cA = nA; cB = nB; ++ui;
        if constexpr (ALIGN_EPI) { if (wr == 1) PG8_BAR; }
    }
    PG8_WAIT_V(0);
    if constexpr (!ALIGN_EPI) { if (wr == 0) PG8_BAR; }
    PG8_BAR;
    if constexpr (Epi::AFTER_DRAIN) { E.fused(acc, cur, wr, wc, fr, fq, lds, wid, lane); S.done(cur); }
#undef PG8_SA
#undef PG8_SB
#undef PG8_STAGE
#undef PG8_LDA
#undef PG8_LDB
#undef PG8_MMA
#undef PG8_WAIT_V
#undef PG8_WAIT_L
#undef PG8_BAR
#undef PG8_SCHED
}
}
#define XB_TMO      128
#define XB_XCNT(j)  (256  + 64 * (j))
#define XB_XSUB(j)  (1280 + 64 * (j))
#define XB_XGEN(j)  (2304 + 64 * (j))
#define XB_TOP      3328
#define XB_TOPGEN   3392
#define XCD_BAR_WORDS 3456
#define XB_SPIN_CAP (1u << 18)

__device__ __forceinline__ unsigned xb_ld(unsigned* p)              { return __hip_atomic_load(p, __ATOMIC_RELAXED, __HIP_MEMORY_SCOPE_AGENT); }
__device__ __forceinline__ unsigned xb_add(unsigned* p, unsigned v) { return __hip_atomic_fetch_add(p, v, __ATOMIC_RELAXED, __HIP_MEMORY_SCOPE_AGENT); }
__device__ __forceinline__ unsigned xb_xcc_id() { return (unsigned)__builtin_amdgcn_s_getreg((3 << 11) | 20) & 0xFu; }
#define XB_SPIN(cond, bar) do { unsigned _sp = 0; while (cond) { __builtin_amdgcn_s_sleep(1); \
    if ((++_sp & 255u) == 0u) { if (xb_ld(&(bar)[XB_TMO])) break; if (_sp > XB_SPIN_CAP) { atomicAdd(&(bar)[XB_TMO], 1u); break; } } } } while (0)

struct XcdBarrier {
    unsigned* bar; unsigned x;
    volatile LAS unsigned* st;
};

__device__ __forceinline__ XcdBarrier xcd_barrier_post(unsigned* bar, volatile LAS unsigned* st) {
    XcdBarrier b; b.bar = bar; b.x = xb_xcc_id(); b.st = st;
    if (threadIdx.x == 0) (void)xb_add(&bar[XB_XCNT(b.x)], 1u);
    return b;
}
__device__ __forceinline__ void xcd_barrier_complete(unsigned* bar, unsigned x, unsigned& nloc, unsigned& nx) {
    const unsigned G = gridDim.x * gridDim.y * gridDim.z;
    unsigned sum, cnt, mine, sp = 0u;
    for (;;) {
        sum = 0u; cnt = 0u; mine = 0u;
#pragma unroll
        for (unsigned j = 0; j < 16; ++j) { const unsigned c = xb_ld(&bar[XB_XCNT(j)]); sum += c; cnt += (c > 0u) ? 1u : 0u; mine = (j == x) ? c : mine; }
        if (sum == G) break;
        __builtin_amdgcn_s_sleep(1);
        if ((++sp & 255u) == 0u) { if (xb_ld(&bar[XB_TMO])) break; if (sp > XB_SPIN_CAP) { atomicAdd(&bar[XB_TMO], 1u); break; } }
    }
    nloc = mine > 0u ? mine : 1u; nx = cnt > 0u ? cnt : 1u;
}

__device__ __forceinline__ void xcd_barrier(const XcdBarrier& b) {
    asm volatile("s_waitcnt vmcnt(0)" ::: "memory");
    __syncthreads();
    if (threadIdx.x == 0) {
        unsigned* bar = b.bar;
        __builtin_amdgcn_s_waitcnt(0);
        unsigned nloc = b.st[0], nx = b.st[1];
        if (nloc == 0u) { xcd_barrier_complete(bar, b.x, nloc, nx); b.st[0] = nloc; b.st[1] = nx; }
        const unsigned old = xb_add(&bar[XB_XSUB(b.x)], 1u);
        const unsigned gen = old / nloc;
        if (old + 1u == (gen + 1u) * nloc) {
            __builtin_amdgcn_fence(__ATOMIC_RELEASE, "agent");
            asm volatile("s_waitcnt vmcnt(0)" ::: "memory");
            const unsigned og = xb_add(&bar[XB_TOP], 1u);
            const unsigned tg = og / nx;
            if (og + 1u == (tg + 1u) * nx) xb_add(&bar[XB_TOPGEN], 1u);
            else XB_SPIN(xb_ld(&bar[XB_TOPGEN]) == tg, bar);
            __builtin_amdgcn_fence(__ATOMIC_ACQUIRE, "agent");
            xb_add(&bar[XB_XGEN(b.x)], 1u);
            asm volatile("s_waitcnt vmcnt(0)" ::: "memory");
        } else {
            XB_SPIN(xb_ld(&bar[XB_XGEN(b.x)]) == gen, bar);
            __builtin_amdgcn_fence(__ATOMIC_ACQUIRE, "agent");
            asm volatile("s_waitcnt vmcnt(0)" ::: "memory");
        }
    }
    __syncthreads();
}
#include <hip/hip_bf16.h>
#include <cmath>
namespace attn_body {
using bf16=__hip_bfloat16;
using bf16x8=__attribute__((ext_vector_type(8)))short;
using s16x4=__attribute__((ext_vector_type(4)))short;
using f32x16=__attribute__((ext_vector_type(16)))float;
using u32x4=__attribute__((ext_vector_type(4)))unsigned;
constexpr int BATCH=2,NHEAD=8,SEQ=8192,D=64,DM=NHEAD*D,ODM=1024;
constexpr int NW=8,QBLK=32,QB=QBLK*NW,KVBLK=64,NQB=SEQ/QB;
constexpr int ATTN_PITCH=DM, ATTN_UNIT_ROWS=QB;
__device__ __forceinline__ int crow(int r,int hi){return (r&3)+8*(r>>2)+4*hi;}
#define SBAR() __builtin_amdgcn_sched_barrier(0)
__device__ __forceinline__ void cmask(f32x16&p0,f32x16&p1,int jb,int qrel,int hi){
  const float NEG=-INFINITY; int kb=64*jb+4*hi;
  #pragma unroll
  for(int r=0;r<16;++r){int kv=kb+(r&3)+8*(r>>2); if(kv>qrel)p0[r]=NEG; if(kv+32>qrel)p1[r]=NEG;}
}

constexpr int NSLOT=3, SLOTB=8192;
constexpr int LDS_K=0, LDS_V=NSLOT*SLOTB, LDS_WS=2*NSLOT*SLOTB, LDS_OST=LDS_WS+NW*64*4, LDS_BYTES=LDS_OST+NW*4096; constexpr int LDS_KBIAS=LDS_BYTES, LDS_KZERO=LDS_KBIAS+SEQ*8;
constexpr float C2=0.125f*1.4426950408889634f;
__device__ __forceinline__ void glds16(const void*gsrc,unsigned lds_dst){unsigned keep;
  asm volatile("s_mov_b32 %0, m0\n\ts_mov_b32 m0, %2\n\ts_nop 0\n\tglobal_load_lds_dwordx4 %1, off\n\ts_mov_b32 m0, %0":"=&s"(keep):"v"(gsrc),"s"(lds_dst):"memory");}
__device__ __forceinline__ float max3f(float a,float b,float c){float r;asm("v_max3_f32 %0, %1, %2, %3":"=v"(r):"v"(a),"v"(b),"v"(c));return r;}
__device__ __forceinline__ float max2f(float a,float b){float r;asm("v_max_f32_e32 %0, %1, %2":"=v"(r):"v"(a),"v"(b));return r;}
__device__ __forceinline__ float fadd_s(float a,float b){float r;asm("v_add_f32_e32 %0, %1, %2":"=v"(r):"v"(a),"v"(b));return r;}
__device__ __forceinline__ float fsub_s(float a,float b){float r;asm("v_sub_f32_e32 %0, %1, %2":"=v"(r):"v"(a),"v"(b));return r;}
typedef float f32x2_t __attribute__((ext_vector_type(2))); typedef float f32x4_t __attribute__((ext_vector_type(4))); typedef __bf16 bf16x2_t __attribute__((ext_vector_type(2)));
__device__ __forceinline__ unsigned cvtpk_s(float lo,float hi){f32x2_t v={lo,hi};bf16x2_t b=__builtin_convertvector(v,bf16x2_t);return __builtin_bit_cast(unsigned,b);}
#define WAIT_BAR(N) asm volatile("s_waitcnt vmcnt(" #N ") lgkmcnt(0)\n\ts_barrier":::"memory")

__device__ __forceinline__ void qkt(f32x16&p0,f32x16&p1,const char*Kslot,const bf16x8*qr,const f32x16&negm,int r32,int hi){
  const char*kb=Kslot+hi*1024+r32*16;
  #pragma unroll
  for(int d0=0;d0<4;++d0){
    const bf16x8 b0=*reinterpret_cast<const bf16x8*>(kb+d0*2048);
    const bf16x8 b1=*reinterpret_cast<const bf16x8*>(kb+d0*2048+512);
    if(d0==0){p0=__builtin_amdgcn_mfma_f32_32x32x16_bf16(b0,qr[0],negm,0,0,0);p1=__builtin_amdgcn_mfma_f32_32x32x16_bf16(b1,qr[0],negm,0,0,0);}
    else{p0=__builtin_amdgcn_mfma_f32_32x32x16_bf16(b0,qr[d0],p0,0,0,0);p1=__builtin_amdgcn_mfma_f32_32x32x16_bf16(b1,qr[d0],p1,0,0,0);}}
}
typedef __attribute__((address_space(3))) const char* lds_cptr;
typedef short v4i16_t __attribute__((ext_vector_type(4)));
__device__ __forceinline__ void kload8(bf16x8*kf,lds_cptr kp){
  kf[0]=*(const __attribute__((address_space(3))) bf16x8*)(kp);      kf[1]=*(const __attribute__((address_space(3))) bf16x8*)(kp+512);
  kf[2]=*(const __attribute__((address_space(3))) bf16x8*)(kp+2048); kf[3]=*(const __attribute__((address_space(3))) bf16x8*)(kp+2560);
  kf[4]=*(const __attribute__((address_space(3))) bf16x8*)(kp+4096); kf[5]=*(const __attribute__((address_space(3))) bf16x8*)(kp+4608);
  kf[6]=*(const __attribute__((address_space(3))) bf16x8*)(kp+6144); kf[7]=*(const __attribute__((address_space(3))) bf16x8*)(kp+6656);
}
__device__ __forceinline__ void kload2(bf16x8*kf,lds_cptr kp,int j){ kf[2*j]=*(const __attribute__((address_space(3))) bf16x8*)(kp+j*2048); kf[2*j+1]=*(const __attribute__((address_space(3))) bf16x8*)(kp+j*2048+512); }
__device__ __forceinline__ s16x4 vtr(lds_cptr p){ return __builtin_bit_cast(s16x4,__builtin_amdgcn_ds_read_tr16_b64_v4i16((__attribute__((address_space(3))) v4i16_t*)p)); }
__device__ __forceinline__ float rowmax(const f32x16&p0,const f32x16&p1){
  float a=max3f(p0[0],p0[1],p1[0]),b=max3f(p0[2],p0[3],p1[1]);a=max3f(a,p1[2],p1[3]);
  #pragma unroll
  for(int r=4;r<16;r+=4){a=max3f(a,p0[r],p0[r+1]);b=max3f(b,p0[r+2],p0[r+3]);a=max3f(a,p1[r],p1[r+1]);b=max3f(b,p1[r+2],p1[r+3]);}
  const float m=max2f(a,b);
  auto rr=__builtin_amdgcn_permlane32_swap(__float_as_uint(m),__float_as_uint(m),false,false);
  return max2f(__uint_as_float(rr[0]),__uint_as_float(rr[1]));
}
__device__ __forceinline__ void pv(f32x16*o,int vb,bf16x8 pa0,bf16x8 pa1,bf16x8 pa2,bf16x8 pa3){
  #pragma unroll
  for(int d0=0;d0<2;++d0){s16x4 lo[4],hi[4];
    #pragma unroll
    for(int ks=0;ks<4;++ks){
      asm volatile("ds_read_b64_tr_b16 %0,%1 offset:%c2":"=&v"(lo[ks]):"v"(vb),"i"(d0*4096+ks*1024):"memory");
      asm volatile("ds_read_b64_tr_b16 %0,%1 offset:%c2":"=&v"(hi[ks]):"v"(vb),"i"(d0*4096+ks*1024+512):"memory");}
    asm volatile("s_waitcnt lgkmcnt(0)":::"memory");SBAR();
    #define PK(k) (bf16x8){lo[k][0],lo[k][1],lo[k][2],lo[k][3],hi[k][0],hi[k][1],hi[k][2],hi[k][3]}
    o[d0]=__builtin_amdgcn_mfma_f32_32x32x16_bf16(pa0,PK(0),o[d0],0,0,0);
    o[d0]=__builtin_amdgcn_mfma_f32_32x32x16_bf16(pa1,PK(1),o[d0],0,0,0);
    o[d0]=__builtin_amdgcn_mfma_f32_32x32x16_bf16(pa2,PK(2),o[d0],0,0,0);
    o[d0]=__builtin_amdgcn_mfma_f32_32x32x16_bf16(pa3,PK(3),o[d0],0,0,0);
    #undef PK
  }
}

#ifndef ATTN_STORE16
#define ATTN_STORE16(p,v) (*(u32x4*)(p)=(v))
#endif
template<int THRL> __device__ __forceinline__ void attn_unit(int b,int h,int qb,const bf16*Q,const bf16*__restrict__ K,const bf16*__restrict__ V,bf16*O,const float*__restrict__ CUM,const float*__restrict__ KN,const float*__restrict__ QN,char*shm){
  int tid_=threadIdx.x; asm volatile("":"+v"(tid_));
  const int tid=tid_,lane=tid&63,r32=lane&31,hi=lane>>5; const int wid=__builtin_amdgcn_readfirstlane(tid>>6);
  const long rowbase=(long)b*SEQ; const int q0=qb*QB;
  const bf16*Qw=Q+(rowbase+q0+wid*QBLK)*DM+h*D;
  const int NTF=(q0+QB)/KVBLK; int t0;
  { const float*cb=CUM+(long)(b*NHEAD+h)*SEQ; const float*kn=KN+(b*NHEAD+h)*(SEQ/KVBLK); const float*qn=QN+(b*NHEAD+h)*(SEQ/KVBLK); const float cref=cb[q0];
    const float kd=fmaxf(fmaxf(kn[NTF-4],kn[NTF-3]),fmaxf(kn[NTF-2],kn[NTF-1])), qm=1.01f*fmaxf(fmaxf(qn[NTF-4],qn[NTF-3]),fmaxf(qn[NTF-2],qn[NTF-1]));
    const int nb_=NTF-4, j0=lane, j1=lane+64; bool ok0=false, ok1=false;
    if(j0<nb_) ok0=((cref-cb[64*j0+63])*1.4426950408889634f+qm*(kn[j0]+kd)+1.0f<=-64.0f);
    if(j1<nb_) ok1=((cref-cb[64*j1+63])*1.4426950408889634f+qm*(kn[j1]+kd)+1.0f<=-64.0f);
    const unsigned long long m0=__ballot(!ok0), m1=__ballot(!ok1);
    const int f_=m0?__builtin_ctzll(m0):(m1?64+__builtin_ctzll(m1):128);
    t0=__builtin_amdgcn_readfirstlane((f_<nb_?f_:nb_)&~1); }
  const bf16*Kh=K+(rowbase+(long)t0*KVBLK)*DM+h*D,*Vh=V+(rowbase+(long)t0*KVBLK)*DM+h*D;
  const unsigned lds0=(unsigned)(uintptr_t)shm;
  float*wsf=(float*)(shm+LDS_WS)+wid*64;
  const bf16*ksrc=Kh+(long)lane*DM+wid*8;
  const bf16*vsrc=Vh+(long)(16*(wid&3)+(lane>>2))*DM+(wid>>2)*32+(lane&3)*8;
  const unsigned kdst=lds0+LDS_K+wid*1024, vdst=lds0+LDS_V+wid*1024;
  #define DMA_K(t,slot) glds16(ksrc+(long)(t)*KVBLK*DM,(unsigned)__builtin_amdgcn_readfirstlane(kdst+(slot)))
  #define DMA_V(t,slot) glds16(vsrc+(long)(t)*KVBLK*DM,(unsigned)__builtin_amdgcn_readfirstlane(vdst+(slot)))
  const int vb0=(int)(lds0+LDS_V)+((lane>>4)&1)*32+(lane&3)*8+(4*hi+((lane&15)>>2))*64;
  const char*Kbase=shm+LDS_K; bf16x8 kf[8];
  const lds_cptr shm3=(lds_cptr)shm; const lds_cptr kp0=shm3+LDS_K+hi*1024+r32*16; const lds_cptr vp0=shm3+LDS_V+((lane>>4)&1)*32+(lane&3)*8+(4*hi+((lane&15)>>2))*64;
  const int NT=NTF-t0;
  { const float*cb=CUM+(long)(b*NHEAD+h)*SEQ; const float cref=cb[q0];
    __attribute__((address_space(3))) unsigned long long*kbw=(__attribute__((address_space(3))) unsigned long long*)((__attribute__((address_space(3))) char*)shm+LDS_KBIAS);
    float cv_[16];
    _Pragma("unroll") for(int j=0;j<16;++j){ const int i=tid+NW*64*j; cv_[j]=(i<NT*KVBLK)?cb[i+t0*KVBLK]:cref; }
    _Pragma("unroll") for(int j=0;j<16;++j){ const int i=tid+NW*64*j; if(i<NT*KVBLK){ const float bv=(cref-cv_[j])*1.4426950408889634f;
      const unsigned hb=__float_as_uint(bv)&0xffff0000u; const float r1=bv-__uint_as_float(hb); const unsigned mb=__float_as_uint(r1)&0xffff0000u; const float r2=r1-__uint_as_float(mb);
      const unsigned lb=__float_as_uint(r2)>>16; kbw[i]=(unsigned long long)((hb>>16)|mb)|((unsigned long long)lb<<32); } }
    if(tid==0)kbw[SEQ]=0ull; }
  const __attribute__((address_space(3))) unsigned long long* kaug_p=(const __attribute__((address_space(3))) unsigned long long*)((lds_cptr)shm+(hi?LDS_KZERO:LDS_KBIAS+r32*8));
  const int kaug_s=hi?0:KVBLK, kaug_h=hi?0:32;
  bf16x8 qaug; { u32x4 qa_={0x3f803f80u,0x00003f80u,0u,0u}; asm volatile("":"+v"(qa_)); qaug=__builtin_bit_cast(bf16x8,qa_); }
  #define KAUG(t,half) __builtin_bit_cast(bf16x8,(u32x4){(unsigned)kaug_p[(t)*kaug_s+(half)*kaug_h],(unsigned)(kaug_p[(t)*kaug_s+(half)*kaug_h]>>32),0u,0u})
  DMA_K(0,0);DMA_V(0,0);DMA_K(1,SLOTB);
  bf16x8 qr[4];
  #pragma unroll
  for(int d0=0;d0<4;++d0)qr[d0]=*reinterpret_cast<const bf16x8*>(&Qw[(long)r32*DM+d0*16+hi*8]);
  float zz_; asm volatile("v_mov_b32 %0, 0":"=v"(zz_));
  float mhat=0.f,l_reg=0.f;f32x16 o[2],negm;
  _Pragma("unroll") for(int r=0;r<16;++r){o[0][r]=zz_;o[1][r]=zz_;negm[r]=zz_;} asm volatile("":"+v"(negm));
  const int qrel=wid*QBLK+r32;
  #define CMASK(P0,P1,t) do{int jb_=(t)-(NT-4); if(jb_>=0)cmask(P0,P1,jb_,qrel,hi);}while(0)
  bool resc=false;
  #define START(P0,P1) do{ const float rm=rowmax(P0,P1); resc=false; \
    { const float dl=rm; mhat=fadd_s(mhat,dl); \
      _Pragma("unroll") for(int r=0;r<16;++r){P0[r]=fsub_s(P0[r],dl);P1[r]=fsub_s(P1[r],dl);} \
      _Pragma("unroll") for(int r=0;r<16;++r)negm[r]=-mhat; asm volatile("":"+v"(negm)); } \
    _Pragma("unroll") for(int r=0;r<16;++r)P0[r]=__builtin_amdgcn_exp2f(P0[r]); }while(0)
  #define RESC() do{ if(resc){ asm volatile("s_waitcnt lgkmcnt(0)":::"memory"); \
      _Pragma("unroll") for(int d_=0;d_<2;++d_) _Pragma("unroll") for(int r=0;r<16;++r)o[d_][r]*=wsf[crow(r,hi)]; } }while(0)
  f32x16 pA0,pA1,pB0,pB1;
  int sl_prev=0,sl_cur=0,sl_next=SLOTB;
  #define ROT() do{sl_prev=sl_cur;sl_cur=sl_next;sl_next=(sl_next==(NSLOT-1)*SLOTB)?0:sl_next+SLOTB;}while(0)
  DMA_K(2,2*SLOTB);
  WAIT_BAR(3);
  qkt(pA0,pA1,Kbase,qr,negm,r32,hi);{const bf16x8 ka0_=KAUG(0,0),ka1_=KAUG(0,1);pA0=__builtin_amdgcn_mfma_f32_32x32x16_bf16(ka0_,qaug,pA0,0,0,0);pA1=__builtin_amdgcn_mfma_f32_32x32x16_bf16(ka1_,qaug,pA1,0,0,0);}asm volatile("s_nop 15\n\ts_nop 7":"+v"(pA0),"+v"(pA1));CMASK(pA0,pA1,0);
  START(pA0,pA1);
  _Pragma("unroll") for(int r=0;r<16;++r)pA1[r]=__builtin_amdgcn_exp2f(pA1[r]);
  WAIT_BAR(0);
  DMA_K(3,0);DMA_V(1,SLOTB);
  ROT();
  kload8(kf,kp0+sl_cur);
  WAIT_BAR(2);
  s16x4 vlo[8],vhi[8]; u32x4 pw0,pw1,pw2,pw3;
  #define PKW(P,B) cvtpk_s(P[B],P[B+1])
  #define PAF(k) __builtin_bit_cast(bf16x8,pw##k)
  #define VFR(i) (bf16x8){vlo[i][0],vlo[i][1],vlo[i][2],vlo[i][3],vhi[i][0],vhi[i][1],vhi[i][2],vhi[i][3]}
  #define PIN(x) asm volatile("":"+v"(x))
  #define MX3(a,b,c) __builtin_fmaxf(__builtin_fmaxf((a),(b)),(c))
  #define GAPA(MF,A0,A1,A2,A3,W0,W1,PW) do{ MF; sacc+=A0; sacc+=A1; sacc+=A2; sacc+=A3; PIN(sacc); W0; W1; PIN(PW); SBAR(); }while(0)
  #define EX(v) __builtin_amdgcn_exp2f(v)
  #define GAPB(MF,X,B) do{ MF; X[B]=EX(X[B]); X[B+1]=EX(X[B+1]); X[B+2]=EX(X[B+2]); X[B+3]=EX(X[B+3]); PIN(X); SBAR(); }while(0)
  #define VRD(i) do{ vlo[i]=vtr(vp_+(((i)>>2)*4096+((i)&3)*1024)); vhi[i]=vtr(vp_+(((i)>>2)*4096+((i)&3)*1024+512)); }while(0)
  #define KRD(G,j) do{ if(G){ kload2(kf,kp0+sl_next,j); SBAR(); } }while(0)
  #define STEP(C0,C1,P0,P1,t,GK,GV,GL) do{ SBAR(); \
    const lds_cptr vp_=vp0+sl_prev; \
    const bf16x8 ka0_=KAUG(t,0),ka1_=KAUG(t,1); VRD(0); SBAR(); float sacc=(P0[0]+P0[1]); \
    GAPA(C0=__builtin_amdgcn_mfma_f32_32x32x16_bf16(kf[0],qr[0],negm,0,0,0), P0[2],P0[3],P0[4],P0[5],     pw0[0]=PKW(P0,0), pw0[1]=PKW(P0,2), pw0); \
    VRD(4); SBAR(); GAPA(C1=__builtin_amdgcn_mfma_f32_32x32x16_bf16(kf[1],qr[0],negm,0,0,0), P0[6],P0[7],P0[8],P0[9],     pw0[2]=PKW(P0,4), pw0[3]=PKW(P0,6), pw0); \
    VRD(1); SBAR(); GAPA(C0=__builtin_amdgcn_mfma_f32_32x32x16_bf16(kf[2],qr[1],C0,0,0,0),   P0[10],P0[11],P0[12],P0[13], pw1[0]=PKW(P0,8), pw1[1]=PKW(P0,10), pw1); \
    VRD(5); SBAR(); GAPA(C1=__builtin_amdgcn_mfma_f32_32x32x16_bf16(kf[3],qr[1],C1,0,0,0),   P0[14],P0[15],P1[0],P1[1],   pw1[2]=PKW(P0,12),pw1[3]=PKW(P0,14), pw1); \
    VRD(2); SBAR(); GAPA(C0=__builtin_amdgcn_mfma_f32_32x32x16_bf16(kf[4],qr[2],C0,0,0,0),   P1[2],P1[3],P1[4],P1[5],     pw2[0]=PKW(P1,0), pw2[1]=PKW(P1,2), pw2); \
    VRD(6); SBAR(); GAPA(C1=__builtin_amdgcn_mfma_f32_32x32x16_bf16(kf[5],qr[2],C1,0,0,0),   P1[6],P1[7],P1[8],P1[9],     pw2[2]=PKW(P1,4), pw2[3]=PKW(P1,6), pw2); \
    VRD(3); SBAR(); GAPA(C0=__builtin_amdgcn_mfma_f32_32x32x16_bf16(kf[6],qr[3],C0,0,0,0),   P1[10],P1[11],P1[12],P1[13], pw3[0]=PKW(P1,8), pw3[1]=PKW(P1,10), pw3); \
    VRD(7); SBAR(); GAPA(C1=__builtin_amdgcn_mfma_f32_32x32x16_bf16(kf[7],qr[3],C1,0,0,0),   P1[14],P1[15],0.f,0.f,       pw3[2]=PKW(P1,12),pw3[3]=PKW(P1,14), pw3); \
    C0=__builtin_amdgcn_mfma_f32_32x32x16_bf16(ka0_,qaug,C0,0,0,0); C1=__builtin_amdgcn_mfma_f32_32x32x16_bf16(ka1_,qaug,C1,0,0,0); SBAR(); \
    l_reg+=sacc; \
    if(GK){DMA_K((t)+3,sl_cur);} if(GV){DMA_V((t)+1,sl_next);} \
    CMASK(C0,C1,t); \
    { float a=MX3(C0[0],C0[1],C1[0]),b=MX3(C0[2],C0[3],C1[1]); a=MX3(a,C1[2],C1[3]); \
      _Pragma("unroll") for(int r=4;r<16;r+=4){a=MX3(a,C0[r],C0[r+1]);b=MX3(b,C0[r+2],C0[r+3]);a=MX3(a,C1[r],C1[r+1]);b=MX3(b,C1[r+2],C1[r+3]);} \
      float rm=__builtin_fmaxf(a,b); { auto rr=__builtin_amdgcn_permlane32_swap(__float_as_uint(rm),__float_as_uint(rm),false,false); rm=__builtin_fmaxf(__uint_as_float(rr[0]),__uint_as_float(rr[1])); } \
      resc=false; \
      if(__builtin_expect(__any(rm>(float)THRL),0)){ const float dl=__builtin_fmaxf(rm,0.f); mhat+=dl; \
        _Pragma("unroll") for(int r=0;r<16;++r){C0[r]-=dl;C1[r]-=dl;} \
        _Pragma("unroll") for(int r=0;r<16;++r)negm[r]=-mhat; asm volatile("":"+v"(negm)); \
        const float f=__builtin_amdgcn_exp2f(-dl); l_reg*=f; if(hi==0)wsf[r32]=f; resc=true; } } \
    SBAR(); \
    GAPB(o[0]=__builtin_amdgcn_mfma_f32_32x32x16_bf16(PAF(0),VFR(0),o[0],0,0,0), C0,0); \
    GAPB(o[1]=__builtin_amdgcn_mfma_f32_32x32x16_bf16(PAF(0),VFR(4),o[1],0,0,0), C0,4); \
    KRD(GL,0); GAPB(o[0]=__builtin_amdgcn_mfma_f32_32x32x16_bf16(PAF(1),VFR(1),o[0],0,0,0), C0,8); \
    KRD(GL,1); GAPB(o[1]=__builtin_amdgcn_mfma_f32_32x32x16_bf16(PAF(1),VFR(5),o[1],0,0,0), C0,12); \
    KRD(GL,2); GAPB(o[0]=__builtin_amdgcn_mfma_f32_32x32x16_bf16(PAF(2),VFR(2),o[0],0,0,0), C1,0); \
    KRD(GL,3); GAPB(o[1]=__builtin_amdgcn_mfma_f32_32x32x16_bf16(PAF(2),VFR(6),o[1],0,0,0), C1,4); \
    GAPB(o[0]=__builtin_amdgcn_mfma_f32_32x32x16_bf16(PAF(3),VFR(3),o[0],0,0,0), C1,8); \
    GAPB(o[1]=__builtin_amdgcn_mfma_f32_32x32x16_bf16(PAF(3),VFR(7),o[1],0,0,0), C1,12); \
    }while(0)
  int t=1;
  #undef CMASK
  #define CMASK(P0,P1,t) do{}while(0)
  for(;t+5<NT;t+=2){
    STEP(pB0,pB1,pA0,pA1,t,true,true,true);     WAIT_BAR(2); RESC(); ROT();
    STEP(pA0,pA1,pB0,pB1,t+1,true,true,true);   WAIT_BAR(2); RESC(); ROT();
  }
  #undef CMASK
  #define CMASK(P0,P1,t) do{int jb_=(t)-(NT-4); if(jb_>=0)cmask(P0,P1,jb_,qrel,hi);}while(0)
  #define ENDW(tt) do{ if((tt)+3<NT){WAIT_BAR(2);} else if((tt)+2<NT){WAIT_BAR(1);} else {WAIT_BAR(0);} }while(0)
  for(;t+1<NT;t+=2){
    STEP(pB0,pB1,pA0,pA1,t,(t+3<NT),(t+1<NT),(t+1<NT));       ENDW(t);   RESC(); ROT();
    STEP(pA0,pA1,pB0,pB1,t+1,(t+4<NT),(t+2<NT),(t+2<NT));     ENDW(t+1); RESC(); ROT();
  }
  STEP(pB0,pB1,pA0,pA1,NT-1,false,false,false); RESC();
  { float sacc=pB0[0]+pB0[1]; _Pragma("unroll") for(int r=2;r<16;++r)sacc+=pB0[r]; _Pragma("unroll") for(int r=0;r<16;++r)sacc+=pB1[r]; l_reg+=sacc;
    pw0=(u32x4){PKW(pB0,0),PKW(pB0,2),PKW(pB0,4),PKW(pB0,6)};pw1=(u32x4){PKW(pB0,8),PKW(pB0,10),PKW(pB0,12),PKW(pB0,14)};pw2=(u32x4){PKW(pB1,0),PKW(pB1,2),PKW(pB1,4),PKW(pB1,6)};pw3=(u32x4){PKW(pB1,8),PKW(pB1,10),PKW(pB1,12),PKW(pB1,14)};
    SBAR(); pv(o,vb0+sl_cur,PAF(0),PAF(1),PAF(2),PAF(3)); }
  #undef PKW
  #undef PAF
  #undef VFR
  #undef PIN
  #undef MX3
  #undef GAPA
  #undef GAPB
  #undef EX
  #undef VRD
  #undef KRD
  #undef STEP
  #undef ENDW
  {auto rr=__builtin_amdgcn_permlane32_swap(__float_as_uint(l_reg),__float_as_uint(l_reg),false,false);l_reg=__uint_as_float(rr[0])+__uint_as_float(rr[1]);}
  if(hi==0)wsf[32+r32]=l_reg;asm volatile("s_waitcnt lgkmcnt(0)":::"memory");
  float rli[16];
  #pragma unroll
  for(int r=0;r<16;++r)rli[r]=__builtin_amdgcn_rcpf(wsf[32+crow(r,hi)]);
  bf16*Ow=O+(rowbase+q0+wid*QBLK)*ODM+h*D;
  { bf16*stg=(bf16*)(shm+LDS_OST)+wid*2048;
    #pragma unroll
    for(int r=0;r<16;++r){const int orow=crow(r,hi);
      #pragma unroll
      for(int d0=0;d0<2;++d0)stg[orow*64+d0*32+r32]=__float2bfloat16(o[d0][r]*rli[r]);}
    asm volatile("s_waitcnt lgkmcnt(0)":::"memory");
    #pragma unroll
    for(int i=0;i<4;++i){const int row=i*8+(lane>>3),ch=lane&7; const u32x4 v=*(const u32x4*)(stg+row*64+ch*8); ATTN_STORE16(Ow+(long)row*ODM+ch*8,v);} }
  asm volatile("s_waitcnt lgkmcnt(0)\n\ts_barrier":::"memory");
  #undef DMA_K
  #undef DMA_V
  #undef CMASK
  #undef KAUG
  #undef START
  #undef RESC
  #undef ROT
}
constexpr int ATTN_LDS_BYTES=LDS_BYTES+SEQ*8+16;
struct AttnTensors { const bf16* Q; const bf16* K; const bf16* V; bf16* O; const float* CUM; const float* KN; const float* QN; };
struct AttnUnit { int bh; int qb; };
struct StaticOrder {
  int vcu, G;
  __device__ __forceinline__ explicit StaticOrder(int grid,int block):vcu((grid%8==0)?(block%8)*(grid/8)+block/8:block),G(grid){}
  __device__ __forceinline__ bool next(int i,AttnUnit&u)const{ const int pair=vcu+(i>>1)*G; if(pair>=BATCH*NHEAD*(NQB/2))return false; const int s=pair&15; u.bh=pair>>4; u.qb=(i&1)?(NQB-1-s):s; return true; }
  __device__ __forceinline__ void a_ready(const AttnUnit&)const{}
  __device__ __forceinline__ void done(const AttnUnit&)const{}
};
template<class Sched,int THRL=8> __device__ __forceinline__ void attn_phase(char*lds,const AttnTensors&T,const Sched&S){
  AttnUnit u;
  for(int i=0;S.next(i,u);++i){ S.a_ready(u); attn_unit<THRL>(u.bh/NHEAD,u.bh%NHEAD,u.qb,T.Q,T.K,T.V,T.O,T.CUM,T.KN,T.QN,lds); S.done(u); }
}
#undef SBAR
#undef WAIT_BAR
}
constexpr int DM = 1024, SEQ = 8192, NBATCH = 2, MP = NBATCH * SEQ, DB = 128, DSQ = 4, MS = DB * DSQ, MT = MP + MS;
constexpr int NMEM = 256, MMEM = NBATCH * NMEM;
constexpr int HATT = 8, HD = 64, DATT = 512, HSSM = 8, PS = 64, NST = 128, DSSM = 512, CONVCH = 1024, DFF = 2816, INCOLS = 3088, HX = 4, HDX = 256;
constexpr int NPAGES = 16, PAGE = 128, PAST = 2048;
constexpr float EPS = 1e-6f, LOG2E = 1.4426950408889634f;
constexpr float C2 = 0.125f * LOG2E;
constexpr float XC2 = 0.0625f * LOG2E;
constexpr size_t OFF_YP = 0, OFF_YS = OFF_YP + (size_t)MP * DM, OFF_KP = OFF_YS + (size_t)MS * DM, OFF_VP = OFF_KP + (size_t)MP * DATT, OFF_FP = OFF_VP + (size_t)MP * DATT,
                 OFF_MKP = OFF_FP + (size_t)MP * HATT, OFF_MVP = OFF_MKP + (size_t)MMEM * DM, OFF_CP = OFF_MVP + (size_t)MMEM * DM, OFF_SP = OFF_CP + (size_t)NBATCH * 3 * CONVCH,
                 OFF_KS = OFF_SP + (size_t)NBATCH * HSSM * PS * NST, OFF_VS = OFF_KS + (size_t)MS * DATT, OFF_FS = OFF_VS + (size_t)MS * DATT, OFF_CS = OFF_FS + (size_t)MS * HATT,
                 OFF_SS = OFF_CS + (size_t)DB * 3 * CONVCH, OUT_TOTAL = OFF_SS + (size_t)DB * HSSM * PS * NST;
static_assert(OUT_TOTAL == 44705792, "output size");
constexpr size_t MiB = 1u << 20;
constexpr size_t WS_CTL = 0, CTL_ZERO_BYTES = 1 * MiB;
constexpr int CW_BAR = 4096;
constexpr int CW_AQ = 8192;
constexpr size_t WS_SS1 = 256 * 1024, WS_SS2 = 384 * 1024, WS_SS3 = 512 * 1024;
constexpr size_t WS_WIN = 2 * MiB, WS_WOUT = 8 * MiB, WS_WCQ = 10 * MiB, WS_WCO = 12 * MiB, WS_WCKV = 14 * MiB, WS_WGU = 18 * MiB, WS_WD = 29 * MiB;
constexpr size_t WS_SS0 = 35 * MiB, WS_SSM = 35 * MiB + 128 * 1024, WS_LOGF = 36 * MiB, WS_DT = 37 * MiB, WS_AA = 38 * MiB, WS_CUM = 39 * MiB;
constexpr size_t WS_XB = 40 * MiB, WS_MB = 74 * MiB, WS_Q = 76 * MiB, WS_K = 93 * MiB, WS_V = 110 * MiB, WS_Z = 127 * MiB, WS_XBC = 144 * MiB, WS_ACT = 178 * MiB, WS_Y = 244 * MiB;
constexpr size_t WS_MIX = 278 * MiB, WS_X = 312 * MiB, WS_QC = 378 * MiB, WS_OC = 412 * MiB, WS_U = 446 * MiB, WS_MK = 538 * MiB, WS_MV = 539 * MiB, WS_END = 540 * MiB;
static_assert(WS_SS3 + (size_t)MT * 4 <= CTL_ZERO_BYTES && (CW_BAR + 3456) * 4 <= (int)WS_SS1, "ctl map");
static_assert(WS_XB + (size_t)MT * DM * 2 <= WS_MB && WS_Q + (size_t)MT * DATT * 2 <= WS_K && WS_XBC + (size_t)MT * DM * 2 <= WS_ACT && WS_ACT + (size_t)MT * DM * 4 <= WS_Y && WS_Y + (size_t)MT * DSSM * 4 <= WS_MIX, "ws map 1");
static_assert(WS_MIX + (size_t)MT * DM * 2 <= WS_X && WS_X + (size_t)MT * DM * 4 <= WS_QC && WS_QC + (size_t)MT * DM * 2 <= WS_OC && WS_OC + (size_t)MT * DM * 2 <= WS_U && WS_U + (size_t)MT * DFF * 2 <= WS_MK, "ws map 2");
static_assert(WS_WGU + (size_t)2 * DFF * DM * 2 <= WS_WD && WS_WD + (size_t)DM * DFF * 2 <= WS_SS0 && WS_WIN + (size_t)3072 * DM * 2 <= WS_WOUT && WS_WCKV + (size_t)2048 * DM * 2 <= WS_WGU, "ws map 3");
constexpr int LDS_BYTES = 163840, LDSCTL_OFF = LDS_BYTES - 512, MISC_OFF = LDSCTL_OFF + 320;
constexpr int NWAVES = 8, NTHREADS = 512;
#ifndef MK_ONE_LAUNCH
#define MK_ONE_LAUNCH 1
#endif
constexpr int NPH = 12;

struct Args { const void* in[32]; float* out; unsigned char* ws; int ph_lo, ph_hi; };

__device__ __forceinline__ float bf2f(unsigned short h) { return __uint_as_float((unsigned)h << 16); }
__device__ __forceinline__ float wave_sum(float v) {
#pragma unroll
    for (int o = 1; o < 64; o <<= 1) v += __shfl_xor(v, o);
    return v;
}
__device__ __forceinline__ float wave_max(float v) {
#pragma unroll
    for (int o = 1; o < 64; o <<= 1) v = fmaxf(v, __shfl_xor(v, o));
    return v;
}
__device__ __forceinline__ v4u pack8(f32x4 a, f32x4 b) { v4u w; w.x = pk2(a[0], a[1]); w.y = pk2(a[2], a[3]); w.z = pk2(b[0], b[1]); w.w = pk2(b[2], b[3]); return w; }
__device__ __forceinline__ float rstd_of(float ss, int n) { return rsqrtf(ss * (1.0f / (float)n) + EPS); }

struct FInproj {
    const float* ss0; bf16 *Qb, *Kb, *Vb, *Zb, *XBCb; float* out;
    struct Pre { float s; };
    __device__ __forceinline__ void prefetch(int row, int, Pre& p) const { p.s = ss0[row]; }
    __device__ __forceinline__ void operator()(int row, int col0, f32x4 v0, f32x4 v1) const { Pre p; prefetch(row, col0, p); apply(row, col0, v0, v1, p); }
    __device__ __forceinline__ void apply(int row, int col0, f32x4 v0, f32x4 v1, const Pre& p) const {
        const float rs = rstd_of(p.s, DM); v0 = v0 * rs; v1 = v1 * rs;
        if (col0 < 512) { *(v4u*)(Qb + (size_t)row * DATT + col0) = pack8(v0 * C2, v1 * C2); }
        else if (col0 < 1536) {
            const bool isk = col0 < 1024; const int c = col0 - (isk ? 512 : 1024);
            *(v4u*)((isk ? Kb : Vb) + (size_t)row * DATT + c) = pack8(v0, v1);
            float* o = out + (row < MP ? (isk ? OFF_KP : OFF_VP) + (size_t)row * DATT : (isk ? OFF_KS : OFF_VS) + (size_t)(row - MP) * DATT) + c;
            *(f32x4*)o = v0; *(f32x4*)(o + 4) = v1;
        } else if (col0 < 2048) { *(v4u*)(Zb + (size_t)row * DSSM + (col0 - 1536)) = pack8(v0, v1); }
        else {
            const int c = col0 - 2048; *(v4u*)(XBCb + (size_t)row * CONVCH + c) = pack8(v0, v1);
            float* o = nullptr;
            if (row < MP) { const int t = row & (SEQ - 1); if (t >= SEQ - 3) o = out + OFF_CP + ((size_t)(row >> 13) * 3 + (t - (SEQ - 3))) * CONVCH + c; }
            else { const int s = row - MP, t = s & 3; if (t >= 1) o = out + OFF_CS + ((size_t)(s >> 2) * 3 + (t - 1)) * CONVCH + c; }
            if (o) { *(f32x4*)o = v0; *(f32x4*)(o + 4) = v1; }
        }
    }
};
struct FMemKV {
    const float* ssm; bf16 *MKb, *MVb; float* out;
    __device__ __forceinline__ void operator()(int row, int col0, f32x4 v0, f32x4 v1) const {
        const float rs = rstd_of(ssm[row], DM); v0 = v0 * rs; v1 = v1 * rs;
        const bool isk = col0 < 1024; const int c = isk ? col0 : col0 - 1024;
        if (isk) *(v4u*)(MKb + (size_t)row * DM + c) = pack8(v0, v1);
        else { bf16* vt = MVb + (((size_t)(row >> 8) * HX + (c >> 8)) * HDX + (c & 255)) * NMEM + (row & 255);
#pragma unroll
            for (int i = 0; i < 4; ++i) { vt[(size_t)i * NMEM] = (bf16)f2bf(v0[i]); vt[(size_t)(i + 4) * NMEM] = (bf16)f2bf(v1[i]); } }
        float* o = out + (isk ? OFF_MKP : OFF_MVP) + (size_t)row * DM + c; *(f32x4*)o = v0; *(f32x4*)(o + 4) = v1;
    }
};
struct FRes {
    const float* xin_p; const float* xin_s; bf16* XB; float* SS;
    struct Pre { f32x4 a, b; };
    __device__ __forceinline__ void prefetch(int row, int col0, Pre& p) const {
        if (xin_p) { const float* src = (row < MP ? xin_p + (size_t)row * DM : xin_s + (size_t)(row - MP) * DM) + col0; p.a = *(const f32x4*)src; p.b = *(const f32x4*)(src + 4); }
        else { const v4u w = *(const v4u*)(XB + (size_t)row * DM + col0);
            p.a = (f32x4){__uint_as_float(w.x << 16), __uint_as_float(w.x & 0xffff0000u), __uint_as_float(w.y << 16), __uint_as_float(w.y & 0xffff0000u)};
            p.b = (f32x4){__uint_as_float(w.z << 16), __uint_as_float(w.z & 0xffff0000u), __uint_as_float(w.w << 16), __uint_as_float(w.w & 0xffff0000u)}; } }
    __device__ __forceinline__ void operator()(int row, int col0, f32x4 v0, f32x4 v1) const { Pre p; prefetch(row, col0, p); apply(row, col0, v0, v1, p); }
    __device__ __forceinline__ void apply(int row, int col0, f32x4 v0, f32x4 v1, const Pre& p) const {
        const f32x4 x0 = p.a + v0, x1 = p.b + v1;
        *(v4u*)(XB + (size_t)row * DM + col0) = pack8(x0, x1);
        float q = (x0[0] * x0[0] + x0[1] * x0[1]) + (x0[2] * x0[2] + x0[3] * x0[3]) + (x1[0] * x1[0] + x1[1] * x1[1]) + (x1[2] * x1[2] + x1[3] * x1[3]);
        q += __shfl_xor(q, 16); q += __shfl_xor(q, 32);
        if (((threadIdx.x & 63) >> 4) == 0) __hip_atomic_fetch_add(SS + row, q, __ATOMIC_RELAXED, __HIP_MEMORY_SCOPE_AGENT);
    }
};
struct FScaleBf16 {
    const float* ss; bf16* dst; float scale;
    struct Pre { float s; };
    __device__ __forceinline__ void prefetch(int row, int, Pre& p) const { p.s = ss[row]; }
    __device__ __forceinline__ void operator()(int row, int col0, f32x4 v0, f32x4 v1) const { Pre p; prefetch(row, col0, p); apply(row, col0, v0, v1, p); }
    __device__ __forceinline__ void apply(int row, int col0, f32x4 v0, f32x4 v1, const Pre& p) const {
        const float rs = rstd_of(p.s, DM) * scale; *(v4u*)(dst + (size_t)row * DM + col0) = pack8(v0 * rs, v1 * rs);
    }
};
__device__ __forceinline__ float silu_f(float x) { return x / (1.0f + __expf(-x)); }
struct FGateUp {
    const float* ss; bf16* U;
    struct Pre { float s; };
    __device__ __forceinline__ void prefetch(int row, int, Pre& p) const { p.s = ss[row]; }
    __device__ __forceinline__ void apply(int row, int col0, f32x4 g0, f32x4 g1, f32x4 u0, f32x4 u1, const Pre& p) const {
        const float rs = rstd_of(p.s, DM); f32x4 a, b;
#pragma unroll
        for (int i = 0; i < 4; ++i) { a[i] = silu_f(g0[i] * rs) * (u0[i] * rs); b[i] = silu_f(g1[i] * rs) * (u1[i] * rs); }
        *(v4u*)(U + (size_t)row * DFF + col0) = pack8(a, b);
    }
};

__device__ __forceinline__ void transpose_item(const float* W, int ldw, int src_col0, int k0, bf16* WT, int K, int dst_row0, const float* gk, LAS float* scr, int lane) {
    float tv[32];
#pragma unroll
    for (int i = 0; i < 32; ++i) tv[i] = W[(size_t)(k0 + 2 * i + (lane >> 5)) * ldw + src_col0 + (lane & 31)];
    if (gk) {
#pragma unroll
        for (int i = 0; i < 32; ++i) tv[i] *= gk[k0 + 2 * i + (lane >> 5)];
    }
#pragma unroll
    for (int i = 0; i < 32; ++i) scr[(2 * i + (lane >> 5)) * 33 + (lane & 31)] = tv[i];
    LDS_WAIT(); asm volatile("" ::: "memory");
    const int c = lane & 7;
#pragma unroll
    for (int j = 0; j < 4; ++j) { const int n = (lane >> 3) + 8 * j; const LAS float* s = scr + (8 * c) * 33 + n;
        v4u o; o.x = pk2(s[0 * 33], s[1 * 33]); o.y = pk2(s[2 * 33], s[3 * 33]); o.z = pk2(s[4 * 33], s[5 * 33]); o.w = pk2(s[6 * 33], s[7 * 33]);
        *(v4u*)(WT + (size_t)(dst_row0 + n) * K + k0 + 8 * c) = o; }
    LDS_WAIT(); asm volatile("" ::: "memory");
}
__device__ __forceinline__ float softplus_f(float x) { return fmaxf(x, 0.f) + log1pf(__expf(-fabsf(x))); }

__device__ __forceinline__ void wconv(const Args& A, LAS float* scr, int kind, int worker, int nworkers, int lane) {
    unsigned char* ws = A.ws;
    const int nblk = kind == 0 ? 96 : kind == 4 ? 64 : kind == 5 ? 176 : 32, nkb = kind == 6 ? 44 : 16;
    for (int r = worker; r < nblk * nkb; r += nworkers) {
        const int kb = r / nblk, n0 = 32 * (r % nblk);
        if (kind == 0) transpose_item((const float*)A.in[12], INCOLS, n0 < 1536 ? n0 : n0 + 8, 64 * kb, (bf16*)(ws + WS_WIN), DM, n0, (const float*)A.in[11], scr, lane);
        else if (kind == 1) transpose_item((const float*)A.in[20], DM, n0, 64 * kb, (bf16*)(ws + WS_WOUT), DM, n0, nullptr, scr, lane);
        else if (kind == 2) transpose_item((const float*)A.in[23], DM, n0, 64 * kb, (bf16*)(ws + WS_WCQ), DM, n0, (const float*)A.in[21], scr, lane);
        else if (kind == 3) transpose_item((const float*)A.in[26], DM, n0, 64 * kb, (bf16*)(ws + WS_WCO), DM, n0, nullptr, scr, lane);
        else if (kind == 4) transpose_item((const float*)A.in[n0 < 1024 ? 24 : 25], DM, n0 & 1023, 64 * kb, (bf16*)(ws + WS_WCKV), DM, n0, (const float*)A.in[22], scr, lane);
        else if (kind == 5) { const int pn = n0 >> 8, half = (n0 >> 7) & 1, j0 = n0 & 127; transpose_item((const float*)A.in[half ? 29 : 28], DFF, pn * 128 + j0, 64 * kb, (bf16*)(ws + WS_WGU), DM, n0, (const float*)A.in[27], scr, lane); }
        else transpose_item((const float*)A.in[30], DM, n0, 64 * kb, (bf16*)(ws + WS_WD), DFF, n0, nullptr, scr, lane);
    }
}

__device__ __forceinline__ void p0_prologue(const Args& A, LAS unsigned char* lds, int tid, int lane, int wave, int wg, int nwg) {
    unsigned char* ws = A.ws;
    const float* w_in = (const float*)A.in[12];
    LAS float* scr = (LAS float*)(lds + wave * 8448);
    const int gw = wg * NWAVES + wave, NGW = nwg * NWAVES;
    wconv(A, scr, 0, gw, NGW, lane); wconv(A, scr, 4, gw, NGW, lane);
    if (nwg != 256) { wconv(A, scr, 1, gw, NGW, lane); wconv(A, scr, 2, gw, NGW, lane); wconv(A, scr, 3, gw, NGW, lane); wconv(A, scr, 5, gw, NGW, lane); wconv(A, scr, 6, gw, NGW, lane); }
    __syncthreads();
    LAS float* wfd = (LAS float*)lds;
    { const float* g = (const float*)A.in[11];
#pragma unroll
      for (int j = 0; j < 2; ++j) { const int k = tid + NTHREADS * j; const float* wr = w_in + (size_t)k * INCOLS; const float gk = g[k];
          const f32x4 a0 = *(const f32x4*)(wr + 1536), a1 = *(const f32x4*)(wr + 1540), b0 = *(const f32x4*)(wr + 3080), b1 = *(const f32x4*)(wr + 3084);
#pragma unroll
          for (int c = 0; c < 4; ++c) { wfd[c * DM + k] = a0[c] * gk; wfd[(4 + c) * DM + k] = a1[c] * gk; wfd[(8 + c) * DM + k] = b0[c] * gk; wfd[(12 + c) * DM + k] = b1[c] * gk; } } }
    __syncthreads();
    bf16* XB = (bf16*)(ws + WS_XB); bf16* MB = (bf16*)(ws + WS_MB);
    float* SS0 = (float*)(ws + WS_SS0); float* SSM = (float*)(ws + WS_SSM); float* LOGF = (float*)(ws + WS_LOGF); float* DT = (float*)(ws + WS_DT); float* AA = (float*)(ws + WS_AA);
    const float* b_forget = (const float*)A.in[13]; const float* dt_bias = (const float*)A.in[16]; const float* a_log = (const float*)A.in[17];
    f32x4 nxt[4];
    if (gw < MT + MMEM) { const float* s0 = gw < MP ? (const float*)A.in[0] + (size_t)gw * DM : gw < MT ? (const float*)A.in[1] + (size_t)(gw - MP) * DM : (const float*)A.in[2] + (size_t)(gw - MT) * DM;
#pragma unroll
        for (int j = 0; j < 4; ++j) nxt[j] = *((const f32x4*)s0 + lane + 64 * j); }
    for (int m = gw; m < MT + MMEM; m += NGW) {
        const float* src; bf16* dst;
        if (m < MP) { src = (const float*)A.in[0] + (size_t)m * DM; dst = XB + (size_t)m * DM; }
        else if (m < MT) { src = (const float*)A.in[1] + (size_t)(m - MP) * DM; dst = XB + (size_t)m * DM; }
        else { src = (const float*)A.in[2] + (size_t)(m - MT) * DM; dst = MB + (size_t)(m - MT) * DM; }
        f32x4 v[4]; float s = 0.f;
#pragma unroll
        for (int j = 0; j < 4; ++j) { v[j] = nxt[j]; s += (v[j][0] * v[j][0] + v[j][1] * v[j][1]) + (v[j][2] * v[j][2] + v[j][3] * v[j][3]); }
        { const int mn = m + NGW; if (mn < MT + MMEM) { const float* sn = mn < MP ? (const float*)A.in[0] + (size_t)mn * DM : mn < MT ? (const float*)A.in[1] + (size_t)(mn - MP) * DM : (const float*)A.in[2] + (size_t)(mn - MT) * DM;
#pragma unroll
            for (int j = 0; j < 4; ++j) nxt[j] = *((const f32x4*)sn + lane + 64 * j); } }
        s = wave_sum(s);
#pragma unroll
        for (int j = 0; j < 4; ++j) { unsigned long long w = (unsigned long long)pk2(v[j][0], v[j][1]) | ((unsigned long long)pk2(v[j][2], v[j][3]) << 32); *((unsigned long long*)dst + lane + 64 * j) = w; }
        if (m >= MT) { if (lane == 0) SSM[m - MT] = s; continue; }
        if (lane == 0) SS0[m] = s;
        const float rs = rstd_of(s, DM);
        float mine = 0.f;
#pragma unroll
        for (int c = 0; c < 16; ++c) { float d = 0.f;
#pragma unroll
            for (int j = 0; j < 4; ++j) { const f32x4 w = *((const LAS f32x4*)(wfd + c * DM) + lane + 64 * j); d += (v[j][0] * w[0] + v[j][1] * w[1]) + (v[j][2] * w[2] + v[j][3] * w[3]); }
            d = wave_sum(d); if (lane == c) mine = d; }
        if (lane < 8) { const float x = mine * rs + b_forget[lane]; const float lf = fminf(x, 0.f) - log1pf(__expf(-fabsf(x)));
            LOGF[(size_t)m * 8 + lane] = lf; if (m < MP) A.out[OFF_FP + (size_t)m * 8 + lane] = lf; else A.out[OFF_FS + (size_t)(m - MP) * 8 + lane] = lf; }
        else if (lane < 16) { const int h = lane - 8; const float dt = softplus_f(mine * rs + dt_bias[h]); DT[(size_t)m * 8 + h] = dt; AA[(size_t)m * 8 + h] = -__expf(a_log[h]) * dt; }
    }
}

__device__ __forceinline__ float block_excl_scan(float v, LAS float* sh, int lane, int wave) {
    float inc = v;
#pragma unroll
    for (int o = 1; o < 64; o <<= 1) { const float t = __shfl_up(inc, o); if (lane >= o) inc += t; }
    __syncthreads();
    if (lane == 63) sh[wave] = inc;
    __syncthreads();
    float base = 0.f;
    for (int w = 0; w < wave; ++w) base += sh[w];
    return base + inc - v;
}
__device__ __forceinline__ void p1_cumsum(const Args& A, LAS unsigned char* lds, int tid, int lane, int wave, int bh) {
    const float* LOGF = (const float*)(A.ws + WS_LOGF); float* CUM = (float*)(A.ws + WS_CUM);
    const int b = bh >> 3, h = bh & 7, t0 = tid * 16;
    float v[16]; float run = 0.f;
#pragma unroll
    for (int j = 0; j < 16; ++j) { run += LOGF[((size_t)b * SEQ + t0 + j) * 8 + h]; v[j] = run; }
    const float ex = block_excl_scan(run, (LAS float*)lds, lane, wave);
#pragma unroll
    for (int j = 0; j < 16; ++j) CUM[(size_t)bh * SEQ + t0 + j] = ex + v[j];
    __syncthreads();
}

constexpr size_t WS_ACTB = WS_ACT;
__device__ __forceinline__ void unpack8(v4u w, float (&x)[8]) { x[0] = __uint_as_float(w.x << 16); x[1] = __uint_as_float(w.x & 0xffff0000u); x[2] = __uint_as_float(w.y << 16); x[3] = __uint_as_float(w.y & 0xffff0000u);
    x[4] = __uint_as_float(w.z << 16); x[5] = __uint_as_float(w.z & 0xffff0000u); x[6] = __uint_as_float(w.w << 16); x[7] = __uint_as_float(w.w & 0xffff0000u); }
__device__ __forceinline__ void conv_pass(const Args& A, int tid, int wg, int nwg) {
    const bf16* XBC = (const bf16*)(A.ws + WS_XBC); bf16* ACTB = (bf16*)(A.ws + WS_ACTB);
    const float* state_conv = (const float*)A.in[9]; const float* conv_w = (const float*)A.in[14]; const float* conv_b = (const float*)A.in[15];
    constexpr int NPI = (MP / 16) * 128, NSI = DB * 128;
    for (int idx = wg * NTHREADS + tid; idx < NPI + NSI; idx += nwg * NTHREADS) {
        const bool prm = idx < NPI; const int j = prm ? idx : idx - NPI; const int c8 = (j & 127) * 8, rg = j >> 7;
        float w[4][8], bs[8], xw[3][8];
#pragma unroll
        for (int t = 0; t < 4; ++t) { const f32x4 a = *(const f32x4*)(conv_w + t * CONVCH + c8), b = *(const f32x4*)(conv_w + t * CONVCH + c8 + 4);
#pragma unroll
            for (int i = 0; i < 4; ++i) { w[t][i] = a[i]; w[t][4 + i] = b[i]; } }
        { const f32x4 a = *(const f32x4*)(conv_b + c8), b = *(const f32x4*)(conv_b + c8 + 4);
#pragma unroll
          for (int i = 0; i < 4; ++i) { bs[i] = a[i]; bs[4 + i] = b[i]; } }
        const int r0 = prm ? rg * 16 : MP + rg * 4, nrows = prm ? 16 : 4;
        if (prm) {
            if ((r0 & (SEQ - 1)) == 0) {
#pragma unroll
                for (int t = 0; t < 3; ++t)
#pragma unroll
                    for (int i = 0; i < 8; ++i) xw[t][i] = 0.f;
            } else {
#pragma unroll
                for (int t = 0; t < 3; ++t) unpack8(*(const v4u*)(XBC + (size_t)(r0 - 3 + t) * CONVCH + c8), xw[t]);
            }
        } else {
#pragma unroll
            for (int t = 0; t < 3; ++t) { const float* sp = state_conv + ((size_t)rg * 3 + t) * CONVCH + c8; const f32x4 a = *(const f32x4*)sp, b = *(const f32x4*)(sp + 4);
#pragma unroll
                for (int i = 0; i < 4; ++i) { xw[t][i] = a[i]; xw[t][4 + i] = b[i]; } }
        }
#pragma unroll 4
        for (int i = 0; i < nrows; ++i) {
            float xi[8]; unpack8(*(const v4u*)(XBC + (size_t)(r0 + i) * CONVCH + c8), xi);
            f32x4 o0, o1;
#pragma unroll
            for (int k = 0; k < 8; ++k) { const float a = bs[k] + ((w[0][k] * xw[0][k] + w[1][k] * xw[1][k]) + (w[2][k] * xw[2][k] + w[3][k] * xi[k])); const float sv = silu_f(a); if (k < 4) o0[k] = sv; else o1[k - 4] = sv;
                xw[0][k] = xw[1][k]; xw[1][k] = xw[2][k]; xw[2][k] = xi[k]; }
            *(v4u*)(ACTB + (size_t)(r0 + i) * CONVCH + c8) = pack8(o0, o1);
        }
    }
}

__device__ __forceinline__ void p3_ssd_naive(const Args& A, LAS unsigned char* lds, int lane, int wave, int wg, int nwg, int it_lo, int wsub, int nws) {
    const bf16* ACT = (const bf16*)(A.ws + WS_ACTB); const float* DT = (const float*)(A.ws + WS_DT); const float* AA = (const float*)(A.ws + WS_AA); float* Y = (float*)(A.ws + WS_Y);
    const float* state_ssm = (const float*)A.in[10]; const float* d_skip = (const float*)A.in[18];
    LAS float* bc = (LAS float*)(lds + wave * 4096);
    const int gwt = wsub * nwg + wg, NGW = nwg * nws;
    const int pl = lane & 15, nq = lane >> 4, n0 = nq * 32;
    for (int it = it_lo + gwt; it < (NBATCH * HSSM + DB * HSSM) * 4; it += NGW) {
        const int sh = it >> 2, p = (it & 3) * 16 + pl;
        int L, row0, h; float* sout; float hs[32];
        if (sh < NBATCH * HSSM) { const int b = sh >> 3; h = sh & 7; L = SEQ; row0 = b * SEQ; sout = A.out + OFF_SP + ((size_t)sh * PS + p) * NST + n0;
#pragma unroll
            for (int n = 0; n < 32; ++n) hs[n] = 0.f; }
        else { const int s = sh - NBATCH * HSSM, b = s >> 3; h = s & 7; L = DSQ; row0 = MP + b * DSQ; sout = A.out + OFF_SS + ((size_t)s * PS + p) * NST + n0;
            const float* h0 = state_ssm + ((size_t)s * PS + p) * NST + n0;
#pragma unroll
            for (int n = 0; n < 32; n += 4) { const f32x4 t = *(const f32x4*)(h0 + n); hs[n] = t[0]; hs[n + 1] = t[1]; hs[n + 2] = t[2]; hs[n + 3] = t[3]; } }
        const int g = h >> 2; const float dsk = d_skip[h];
        float nx[4], ndt[4], na[4]; f32x2 nb[4], nc[4];
#define SSD_LOAD(t_, i_) do { const size_t r_ = (size_t)row0 + (t_); nx[i_] = bf2f(ACT[r_ * CONVCH + h * PS + p]); ndt[i_] = DT[r_ * 8 + h]; na[i_] = AA[r_ * 8 + h]; \
            { const unsigned ub_ = *(const unsigned*)(ACT + r_ * CONVCH + 512 + g * NST + 2 * lane), uc_ = *(const unsigned*)(ACT + r_ * CONVCH + 768 + g * NST + 2 * lane); \
              nb[i_] = (f32x2){__uint_as_float(ub_ << 16), __uint_as_float(ub_ & 0xffff0000u)}; nc[i_] = (f32x2){__uint_as_float(uc_ << 16), __uint_as_float(uc_ & 0xffff0000u)}; } } while (0)
#pragma unroll
        for (int i = 0; i < 4; ++i) SSD_LOAD(i, i);
        for (int t0 = 0; t0 < L; t0 += 4) {
            float cx[4], cdt[4], ca[4];
#pragma unroll
            for (int i = 0; i < 4; ++i) { cx[i] = nx[i]; cdt[i] = ndt[i]; ca[i] = na[i]; *(LAS f32x2*)(bc + i * 256 + 2 * lane) = nb[i]; *(LAS f32x2*)(bc + i * 256 + 128 + 2 * lane) = nc[i]; }
            if (t0 + 4 < L) {
#pragma unroll
                for (int i = 0; i < 4; ++i) SSD_LOAD(t0 + 4 + i, i);
            }
            asm volatile("s_waitcnt lgkmcnt(0)" ::: "memory");
#pragma unroll
            for (int i = 0; i < 4; ++i) {
                const float dA = __expf(ca[i]), xdt = cx[i] * cdt[i]; float y = 0.f;
#pragma unroll
                for (int n = 0; n < 32; n += 4) {
                    const f32x4 bn = *(const LAS f32x4*)(bc + i * 256 + n0 + n), cn = *(const LAS f32x4*)(bc + i * 256 + 128 + n0 + n);
                    hs[n] = dA * hs[n] + bn[0] * xdt; y += cn[0] * hs[n];
                    hs[n + 1] = dA * hs[n + 1] + bn[1] * xdt; y += cn[1] * hs[n + 1];
                    hs[n + 2] = dA * hs[n + 2] + bn[2] * xdt; y += cn[2] * hs[n + 2];
                    hs[n + 3] = dA * hs[n + 3] + bn[3] * xdt; y += cn[3] * hs[n + 3];
                }
                y += __shfl_xor(y, 16); y += __shfl_xor(y, 32);
                if (nq == 0) Y[((size_t)row0 + t0 + i) * DSSM + h * PS + p] = y + dsk * cx[i];
            }
            asm volatile("s_waitcnt lgkmcnt(0)" ::: "memory");
        }
#undef SSD_LOAD
#pragma unroll
        for (int n = 0; n < 32; n += 4) *(f32x4*)(sout + n) = (f32x4){hs[n], hs[n + 1], hs[n + 2], hs[n + 3]};
    }
}

__device__ __forceinline__ void p4_gate_norm(const Args& A, int lane, int wave, int wg, int nwg, int row_lo) {
    const float* Y = (const float*)(A.ws + WS_Y); const bf16* Zb = (const bf16*)(A.ws + WS_Z); bf16* MIX = (bf16*)(A.ws + WS_MIX); const float* g = (const float*)A.in[19];
    const int gw = wg * NWAVES + wave, NGW = nwg * NWAVES;
    for (int row = row_lo + gw; row < MT; row += NGW) {
        const f32x4 y0 = *(const f32x4*)(Y + (size_t)row * DSSM + 8 * lane), y1 = *(const f32x4*)(Y + (size_t)row * DSSM + 8 * lane + 4);
        const v4u zw = *(const v4u*)(Zb + (size_t)row * DSSM + 8 * lane);
        float z[8] = {bf2f((unsigned short)zw.x), bf2f((unsigned short)(zw.x >> 16)), bf2f((unsigned short)zw.y), bf2f((unsigned short)(zw.y >> 16)), bf2f((unsigned short)zw.z), bf2f((unsigned short)(zw.z >> 16)), bf2f((unsigned short)zw.w), bf2f((unsigned short)(zw.w >> 16))};
        float v[8]; float s = 0.f;
#pragma unroll
        for (int i = 0; i < 8; ++i) { v[i] = (i < 4 ? y0[i] : y1[i - 4]) * silu_f(z[i]); s += v[i] * v[i]; }
        const float rs = rstd_of(wave_sum(s), DSSM);
        const f32x4 g0 = *(const f32x4*)(g + 8 * lane), g1 = *(const f32x4*)(g + 8 * lane + 4);
        f32x4 a = {v[0] * rs * g0[0], v[1] * rs * g0[1], v[2] * rs * g0[2], v[3] * rs * g0[3]}, c = {v[4] * rs * g1[0], v[5] * rs * g1[1], v[6] * rs * g1[2], v[7] * rs * g1[3]};
        *(v4u*)(MIX + (size_t)row * DM + DATT + 8 * lane) = pack8(a, c);
    }
}

__device__ __forceinline__ void p11_final_norm(const Args& A, int lane, int wave, int wg, int nwg) {
    const bf16* XBf = (const bf16*)(A.ws + WS_XB); const float* g = (const float*)A.in[31];
    const int gw = wg * NWAVES + wave, NGW = nwg * NWAVES;
    for (int row = gw; row < MT; row += NGW) {
        float v[16]; float s = 0.f;
#pragma unroll
        for (int j = 0; j < 2; ++j) { const v4u w = *((const v4u*)(XBf + (size_t)row * DM) + lane + 64 * j);
            v[8 * j] = __uint_as_float(w.x << 16); v[8 * j + 1] = __uint_as_float(w.x & 0xffff0000u); v[8 * j + 2] = __uint_as_float(w.y << 16); v[8 * j + 3] = __uint_as_float(w.y & 0xffff0000u);
            v[8 * j + 4] = __uint_as_float(w.z << 16); v[8 * j + 5] = __uint_as_float(w.z & 0xffff0000u); v[8 * j + 6] = __uint_as_float(w.w << 16); v[8 * j + 7] = __uint_as_float(w.w & 0xffff0000u); }
#pragma unroll
        for (int i = 0; i < 16; ++i) s += v[i] * v[i];
        const float rs = rstd_of(wave_sum(s), DM);
        float* o = A.out + (row < MP ? OFF_YP + (size_t)row * DM : OFF_YS + (size_t)(row - MP) * DM);
#pragma unroll
        for (int j = 0; j < 2; ++j) { const int c = 8 * (lane + 64 * j); const f32x4 g0 = *(const f32x4*)(g + c), g1 = *(const f32x4*)(g + c + 4);
            *(f32x4*)(o + c) = (f32x4){v[8 * j] * rs * g0[0], v[8 * j + 1] * rs * g0[1], v[8 * j + 2] * rs * g0[2], v[8 * j + 3] * rs * g0[3]};
            *(f32x4*)(o + c + 4) = (f32x4){v[8 * j + 4] * rs * g1[0], v[8 * j + 5] * rs * g1[1], v[8 * j + 6] * rs * g1[2], v[8 * j + 7] * rs * g1[3]}; }
    }
}

constexpr size_t WS_KN = WS_CUM + 512 * 1024, WS_QN = WS_KN + 8192;
__device__ __forceinline__ void attn_norms(const Args& A, int lane, int wave, int wg, int nwg) {
    const int gw = wg * NWAVES + wave, NGW = nwg * NWAVES;
    for (int it = gw; it < 2 * NBATCH * HATT * (SEQ / 64); it += NGW) {
        const int which = it >> 11, bh = (it >> 7) & 15, tile = it & 127;
        const bf16* src = (const bf16*)(A.ws + (which ? WS_Q : WS_K)) + ((size_t)(bh >> 3) * SEQ + tile * 64 + lane) * DATT + (bh & 7) * HD;
        float s = 0.f;
#pragma unroll
        for (int i = 0; i < 8; ++i) { float x[8]; unpack8(*(const v4u*)(src + 8 * i), x);
#pragma unroll
            for (int k = 0; k < 8; ++k) s += x[k] * x[k]; }
        const float nmax = wave_max(sqrtf(s));
        if (lane == 0) ((float*)(A.ws + (which ? WS_QN : WS_KN)))[bh * (SEQ / 64) + tile] = nmax;
    }
}

constexpr size_t WS_SCH = 544 * MiB;
constexpr size_t WS_DEC = 580 * MiB;
constexpr size_t WS_HST = 582 * MiB;
constexpr size_t WS_END2 = 616 * MiB;
constexpr int SSD_Q = 128, NCH = SEQ / SSD_Q, LP = 136;
__device__ __forceinline__ f32x4 mfma16(bf16x8 a, bf16x8 b, f32x4 c) { return __builtin_amdgcn_mfma_f32_16x16x32_bf16(a, b, c, 0, 0, 0); }
__device__ __forceinline__ bf16x8 ldfrag(const LAS bf16* base, int pitch, int r0, int k0, int lane) { return *(const LAS bf16x8*)(base + (r0 + (lane & 15)) * pitch + k0 + 8 * (lane >> 4)); }
__device__ __forceinline__ void conv8x2(const bf16* __restrict__ XBC, int grow0, int seq0, int s0, int ch, const float* __restrict__ conv_w, const float* __restrict__ conv_b, float (&o0)[8], float (&o1)[8]) {
    float x0[11], x1[11];
#pragma unroll
    for (int k = 0; k < 11; ++k) { const int r = grow0 + s0 - 3 + k; unsigned u = 0u; if (r >= seq0) u = *(const unsigned*)(XBC + (size_t)r * CONVCH + ch); x0[k] = __uint_as_float(u << 16); x1[k] = __uint_as_float(u & 0xffff0000u); }
    float w0[4], w1[4];
#pragma unroll
    for (int j = 0; j < 4; ++j) { const f32x2 w = *(const f32x2*)(conv_w + j * CONVCH + ch); w0[j] = w[0]; w1[j] = w[1]; }
    const f32x2 bb = *(const f32x2*)(conv_b + ch);
#pragma unroll
    for (int i = 0; i < 8; ++i) { float a0 = bb[0], a1 = bb[1];
#pragma unroll
        for (int j = 0; j < 4; ++j) { a0 += w0[j] * x0[i + j]; a1 += w1[j] * x1[i + j]; }
        o0[i] = silu_f(a0); o1[i] = silu_f(a1); }
}
__device__ __forceinline__ void ssd_scalars(const float* __restrict__ AA, const float* __restrict__ DT, int grow0, int g, LAS float* acs, LAS float* dtl, LAS float* tmp, int tid, int lane, int wave) {
    const int hl = tid >> 7, s = tid & 127; const size_t idx = (size_t)(grow0 + s) * 8 + 4 * g + hl;
    float inc = AA[idx]; dtl[hl * 128 + s] = DT[idx];
#pragma unroll
    for (int o = 1; o < 64; o <<= 1) { const float t = __shfl_up(inc, o); if (lane >= o) inc += t; }
    if (lane == 63) tmp[wave] = inc;
    __syncthreads();
    if (wave & 1) inc += tmp[wave - 1];
    acs[hl * 128 + s] = inc;
    __syncthreads();
}
__device__ __forceinline__ unsigned short f2bf16(float f) { return (unsigned short)f2bf(f); }

__device__ __forceinline__ void ssd_phase_a(const Args& A, LAS unsigned char* lds, int tid, int lane, int wave, int wg, int nwg) {
    const bf16* XBC = (const bf16*)(A.ws + WS_XBC); const float* AA = (const float*)(A.ws + WS_AA); const float* DT = (const float*)(A.ws + WS_DT);
    float* SCH = (float*)(A.ws + WS_SCH); float* DEC = (float*)(A.ws + WS_DEC);
    const float* conv_w = (const float*)A.in[14]; const float* conv_b = (const float*)A.in[15];
    LAS bf16* XT = (LAS bf16*)lds;
    LAS bf16* BT = XT + 256 * LP;
    LAS float* acs = (LAS float*)(BT + 128 * LP); LAS float* dtl = acs + 512; LAS float* wl = dtl + 512; LAS float* tmp = wl + 512;
    for (int u = wg; u < NBATCH * NCH * 2; u += nwg) {
        const int g = u & 1, bc = u >> 1, b = bc / NCH, c = bc % NCH, grow0 = b * SEQ + c * SSD_Q, seq0 = b * SEQ;
        __syncthreads();
        ssd_scalars(AA, DT, grow0, g, acs, dtl, tmp, tid, lane, wave);
        { const int hl = tid >> 7, s = tid & 127; const float aend = acs[hl * 128 + 127]; wl[hl * 128 + s] = dtl[hl * 128 + s] * __expf(aend - acs[hl * 128 + s]);
          if (s == 127) DEC[(size_t)bc * 8 + 4 * g + hl] = __expf(aend); }
        __syncthreads();
        for (int it = tid; it < 192 * 16; it += NTHREADS) {
            const int cp = it % 192, s0 = (it / 192) * 8; float o0[8], o1[8];
            if (cp < 128) { const int j = 2 * cp; conv8x2(XBC, grow0, seq0, s0, 256 * g + j, conv_w, conv_b, o0, o1);
                const int hl = j >> 6; v4u w0, w1; float e[8];
#pragma unroll
                for (int i = 0; i < 8; ++i) e[i] = wl[hl * 128 + s0 + i];
                w0.x = pk2(o0[0] * e[0], o0[1] * e[1]); w0.y = pk2(o0[2] * e[2], o0[3] * e[3]); w0.z = pk2(o0[4] * e[4], o0[5] * e[5]); w0.w = pk2(o0[6] * e[6], o0[7] * e[7]);
                w1.x = pk2(o1[0] * e[0], o1[1] * e[1]); w1.y = pk2(o1[2] * e[2], o1[3] * e[3]); w1.z = pk2(o1[4] * e[4], o1[5] * e[5]); w1.w = pk2(o1[6] * e[6], o1[7] * e[7]);
                *(LAS v4u*)(XT + j * LP + s0) = w0; *(LAS v4u*)(XT + (j + 1) * LP + s0) = w1; }
            else { const int n = 2 * (cp - 128); conv8x2(XBC, grow0, seq0, s0, 512 + 128 * g + n, conv_w, conv_b, o0, o1);
                v4u w0, w1;
                w0.x = pk2(o0[0], o0[1]); w0.y = pk2(o0[2], o0[3]); w0.z = pk2(o0[4], o0[5]); w0.w = pk2(o0[6], o0[7]);
                w1.x = pk2(o1[0], o1[1]); w1.y = pk2(o1[2], o1[3]); w1.z = pk2(o1[4], o1[5]); w1.w = pk2(o1[6], o1[7]);
                *(LAS v4u*)(BT + n * LP + s0) = w0; *(LAS v4u*)(BT + (n + 1) * LP + s0) = w1; }
        }
        __syncthreads();
        const int hl = wave >> 1, nh = wave & 1;
        f32x4 acc[4][4];
#pragma unroll
        for (int mt = 0; mt < 4; ++mt)
#pragma unroll
            for (int nt = 0; nt < 4; ++nt) acc[mt][nt] = (f32x4){0.f, 0.f, 0.f, 0.f};
#pragma unroll
        for (int k = 0; k < 4; ++k) { bf16x8 af[4], bfr[4];
#pragma unroll
            for (int mt = 0; mt < 4; ++mt) af[mt] = ldfrag(XT, LP, 64 * hl + 16 * mt, 32 * k, lane);
#pragma unroll
            for (int nt = 0; nt < 4; ++nt) bfr[nt] = ldfrag(BT, LP, 64 * nh + 16 * nt, 32 * k, lane);
#pragma unroll
            for (int mt = 0; mt < 4; ++mt)
#pragma unroll
                for (int nt = 0; nt < 4; ++nt) acc[mt][nt] = mfma16(af[mt], bfr[nt], acc[mt][nt]); }
        float* dst = SCH + ((size_t)bc * 8 + 4 * g + hl) * (PS * NST);
        const int r = lane & 15, q = lane >> 4;
#pragma unroll
        for (int mt = 0; mt < 4; ++mt)
#pragma unroll
            for (int nt = 0; nt < 4; ++nt)
#pragma unroll
                for (int i = 0; i < 4; ++i) dst[(size_t)(16 * mt + 4 * q + i) * NST + 64 * nh + 16 * nt + r] = acc[mt][nt][i];
    }
    __syncthreads();
}

__device__ __forceinline__ void ssd_phase_b(const Args& A, int thr, int nthr) {
    const float* SCH = (const float*)(A.ws + WS_SCH); bf16* HSTo = (bf16*)(A.ws + WS_HST); const float* DEC = (const float*)(A.ws + WS_DEC);
    constexpr int PER = HSSM * PS * NST;
    for (int e0 = thr; e0 < NBATCH * PER; e0 += 2 * nthr) {
        const int e1 = e0 + nthr; const bool two = e1 < NBATCH * PER; const int e1c = two ? e1 : e0;
        const int b0 = e0 / PER, r0 = e0 % PER, b1 = e1c / PER, r1 = e1c % PER;
        const float* p0 = SCH + (size_t)b0 * NCH * PER + r0; const float* p1 = SCH + (size_t)b1 * NCH * PER + r1;
        bf16* o0 = HSTo + (size_t)b0 * NCH * PER + r0; bf16* o1 = HSTo + (size_t)b1 * NCH * PER + r1;
        const float* d0 = DEC + (size_t)b0 * NCH * 8 + r0 / (PS * NST); const float* d1 = DEC + (size_t)b1 * NCH * 8 + r1 / (PS * NST);
        float h0 = 0.f, h1 = 0.f;
        for (int c0 = 0; c0 < NCH; c0 += 16) { float s0[16], s1[16], q0[16], q1[16];
#pragma unroll
            for (int j = 0; j < 16; ++j) { s0[j] = p0[(size_t)(c0 + j) * PER]; s1[j] = p1[(size_t)(c0 + j) * PER]; q0[j] = d0[(c0 + j) * 8]; q1[j] = d1[(c0 + j) * 8]; }
#pragma unroll
            for (int j = 0; j < 16; ++j) { o0[(size_t)(c0 + j) * PER] = f2bf16(h0); h0 = q0[j] * h0 + s0[j]; if (two) o1[(size_t)(c0 + j) * PER] = f2bf16(h1); h1 = q1[j] * h1 + s1[j]; } }
        A.out[OFF_SP + e0] = h0; if (two) A.out[OFF_SP + e1] = h1;
    }
}

constexpr int YP = 520;
__device__ __forceinline__ void ssd_phase_c(const Args& A, LAS unsigned char* lds, int tid_in, int lane_in, int wave, int wg, int nwg) {
    const bf16* ACTB = (const bf16*)(A.ws + WS_ACTB); const float* AA = (const float*)(A.ws + WS_AA); const float* DT = (const float*)(A.ws + WS_DT);
    const bf16* HST = (const bf16*)(A.ws + WS_HST); const bf16* Zb = (const bf16*)(A.ws + WS_Z); bf16* MIX = (bf16*)(A.ws + WS_MIX);
    const float* d_skip = (const float*)A.in[18]; const float* gain = (const float*)A.in[19];
    LAS bf16* Bn = (LAS bf16*)lds;
    LAS bf16* Cn = Bn + 128 * LP;
    LAS bf16* XT = Cn + 64 * LP;
    LAS bf16* GL = XT + 64 * LP;
    LAS bf16* YL = GL + 64 * LP;
    LAS float* acs = (LAS float*)(YL + 64 * YP); LAS float* dtl = acs + 512; LAS float* tmp = dtl + 512;
    const int tt = wave >> 1, hf = wave & 1;
    for (int u = wg; u < NBATCH * NCH * 2; u += nwg) {
        int tid_o = tid_in; asm volatile("" : "+v"(tid_o));
        const int tid = tid_o, lane = tid & 63, r = lane & 15, q = lane >> 4;
        const int th = u & 1, bc = u >> 1, b = bc / NCH, c = bc % NCH, grow0 = b * SEQ + c * SSD_Q;
        v4u xa, xb, hfr[2][4];
#define SC_LOAD(h_) do { const bf16* xp_ = ACTB + (size_t)(grow0 + (tid & 127)) * CONVCH + 64 * (h_) + 16 * (tid >> 7); xa = *(const v4u*)xp_; xb = *(const v4u*)(xp_ + 8); \
            const bf16* hp_ = HST + ((size_t)bc * 8 + (h_)) * (PS * NST) + (size_t)(32 * hf + r) * NST + 8 * q; \
            _Pragma("unroll") for (int pt_ = 0; pt_ < 2; ++pt_) _Pragma("unroll") for (int k_ = 0; k_ < 4; ++k_) hfr[pt_][k_] = *(const v4u*)(hp_ + (size_t)(16 * pt_) * NST + 32 * k_); } while (0)
        SC_LOAD(0);
#pragma unroll 1
        for (int g = 0; g < 2; ++g) {
            __syncthreads();
            if (tid < 8) tmp[8 + tid] = d_skip[tid];
            ssd_scalars(AA, DT, grow0, g, acs, dtl, tmp, tid, lane, wave);
            { const int row = tid >> 2, part = tid & 3; const bf16* src = ACTB + (size_t)(grow0 + row) * CONVCH + 512 + 128 * g + 32 * part;
#pragma unroll
              for (int i = 0; i < 4; ++i) *(LAS v4u*)(Bn + row * LP + 32 * part + 8 * i) = *(const v4u*)(src + 8 * i); }
            { const int row = tid >> 3, part = tid & 7; const bf16* src = ACTB + (size_t)(grow0 + 64 * th + row) * CONVCH + 768 + 128 * g + 16 * part;
#pragma unroll
              for (int i = 0; i < 2; ++i) *(LAS v4u*)(Cn + row * LP + 16 * part + 8 * i) = *(const v4u*)(src + 8 * i); }
            __syncthreads();
            f32x4 G[4];
#pragma unroll
            for (int nt = 0; nt < 4; ++nt) G[nt] = (f32x4){0.f, 0.f, 0.f, 0.f};
#pragma unroll
            for (int k = 0; k < 4; ++k) { const bf16x8 af = ldfrag(Cn, LP, 16 * tt, 32 * k, lane);
#pragma unroll
                for (int nt = 0; nt < 4; ++nt) G[nt] = mfma16(af, ldfrag(Bn, LP, 64 * hf + 16 * nt, 32 * k, lane), G[nt]); }
#pragma unroll 1
            for (int hl = 0; hl < 4; ++hl) {
                const int h = 4 * g + hl;
                __syncthreads();
                const float dsk = tmp[8 + h];
                { const int s = tid & 127, p0 = 16 * (tid >> 7); const float dts = dtl[hl * 128 + s]; float xv[8];
                  unpack8(xa, xv);
#pragma unroll
                  for (int i = 0; i < 8; ++i) XT[(p0 + i) * LP + s] = f2bf16(xv[i] * dts);
                  unpack8(xb, xv);
#pragma unroll
                  for (int i = 0; i < 8; ++i) XT[(p0 + 8 + i) * LP + s] = f2bf16(xv[i] * dts); }
                bf16x8 hcur[2][4];
#pragma unroll
                for (int pt = 0; pt < 2; ++pt)
#pragma unroll
                    for (int k = 0; k < 4; ++k) hcur[pt][k] = __builtin_bit_cast(bf16x8, hfr[pt][k]);
                __builtin_amdgcn_sched_barrier(0);
                if (h < 7) SC_LOAD(h + 1);
                __builtin_amdgcn_sched_barrier(0);
#pragma unroll
                for (int i = 0; i < 4; ++i) { const int tl = 16 * tt + 4 * q + i, ta = 64 * th + tl; const float at = acs[hl * 128 + ta], dinv = dsk / dtl[hl * 128 + ta];
#pragma unroll
                    for (int nt = 0; nt < 4; ++nt) { const int s = 64 * hf + 16 * nt + r;
                        float e = __builtin_amdgcn_exp2f(fminf(at - acs[hl * 128 + s], 0.f) * LOG2E); asm volatile("" : "+v"(e));
                        float v = G[nt][i] * e * ((s <= ta) ? 1.f : 0.f); v += (s == ta) ? dinv : 0.f;
                        GL[tl * LP + s] = f2bf16(v); } }
                __syncthreads();
                f32x4 ya[2] = {(f32x4){0.f, 0.f, 0.f, 0.f}, (f32x4){0.f, 0.f, 0.f, 0.f}};
#pragma unroll
                for (int k = 0; k < 4; ++k) { const bf16x8 af = ldfrag(Cn, LP, 16 * tt, 32 * k, lane);
#pragma unroll
                    for (int pt = 0; pt < 2; ++pt) ya[pt] = mfma16(af, hcur[pt][k], ya[pt]); }
#pragma unroll
                for (int i = 0; i < 4; ++i) { const float ea = __expf(acs[hl * 128 + 64 * th + 16 * tt + 4 * q + i]); ya[0][i] *= ea; ya[1][i] *= ea; }
#pragma unroll
                for (int k = 0; k < 4; ++k) { const bf16x8 af = ldfrag(GL, LP, 16 * tt, 32 * k, lane);
#pragma unroll
                    for (int pt = 0; pt < 2; ++pt) ya[pt] = mfma16(af, ldfrag(XT, LP, 32 * hf + 16 * pt, 32 * k, lane), ya[pt]); }
#pragma unroll
                for (int pt = 0; pt < 2; ++pt)
#pragma unroll
                    for (int i = 0; i < 4; ++i) YL[(16 * tt + 4 * q + i) * YP + 64 * h + 32 * hf + 16 * pt + r] = f2bf16(ya[pt][i]);
            }
        }
#undef SC_LOAD
        __syncthreads();
        { const int tl = tid >> 3, c0 = (tid & 7) * 64; const size_t row = (size_t)grow0 + 64 * th + tl; float v[64]; float ss = 0.f;
#pragma unroll
          for (int k = 0; k < 8; ++k) { float yv[8], zv[8]; unpack8(*(const LAS v4u*)(YL + tl * YP + c0 + 8 * k), yv); unpack8(*(const v4u*)(Zb + row * DSSM + c0 + 8 * k), zv);
#pragma unroll
              for (int i = 0; i < 8; ++i) { const float gv = yv[i] * silu_f(zv[i]); v[8 * k + i] = gv; ss += gv * gv; } }
          ss += __shfl_xor(ss, 1); ss += __shfl_xor(ss, 2); ss += __shfl_xor(ss, 4);
          const float rs = rstd_of(ss, DSSM);
#pragma unroll
          for (int k = 0; k < 8; ++k) { const f32x4 g0 = *(const f32x4*)(gain + c0 + 8 * k), g1 = *(const f32x4*)(gain + c0 + 8 * k + 4);
              const f32x4 a = {v[8 * k] * rs * g0[0], v[8 * k + 1] * rs * g0[1], v[8 * k + 2] * rs * g0[2], v[8 * k + 3] * rs * g0[3]}, bq = {v[8 * k + 4] * rs * g1[0], v[8 * k + 5] * rs * g1[1], v[8 * k + 6] * rs * g1[2], v[8 * k + 7] * rs * g1[3]};
              *(v4u*)(MIX + row * DM + DATT + c0 + 8 * k) = pack8(a, bq); } }
    }
    __syncthreads();
}

#define ROR_ADD(v, n) ((v) + __builtin_bit_cast(float, __builtin_amdgcn_update_dpp(0, __builtin_bit_cast(int, (v)), 0x120 + (n), 0xf, 0xf, false)))
template <bool FOX> __device__ __forceinline__ float slice_sum(float v) {
    v = ROR_ADD(v, 8); v = ROR_ADD(v, 4); v = ROR_ADD(v, 2); v = ROR_ADD(v, 1);
    if (!FOX) { v += __shfl_xor(v, 16); v += __shfl_xor(v, 32); }
    return v;
}
constexpr size_t WS_RC = WS_Y + 8 * MiB;
constexpr size_t WS_PART = WS_Y;
template <bool FOX> __device__ __forceinline__ void decode_unit(const Args& A, LAS unsigned char* lds, int tid_in, int lane_in, int wave, int b, int sl, int part) {
    int tid_o = tid_in; asm volatile("" : "+v"(tid_o));
    const int tid = tid_o, lane = tid & 63;
    constexpr int KPW = FOX ? 64 : 32, NG = KPW / 4;
    const int hl = FOX ? (lane >> 4) : 0;
    LAS float* Rb = (LAS float*)lds;
    LAS float* om = (LAS float*)(lds + 32768);
    LAS float* mlb = (LAS float*)(lds + 65536);
    LAS float* tmp = (LAS float*)(lds + 65536 + 1024);
    const size_t qrow = (size_t)MP + b * DSQ;
    float q[4][4];
    { const bf16* qs = FOX ? (const bf16*)(A.ws + WS_Q) + qrow * DATT + sl * 256 + 4 * lane : (const bf16*)(A.ws + WS_QC) + qrow * DM + sl * 256 + 4 * lane;
#pragma unroll
      for (int t = 0; t < 4; ++t) { const unsigned long long w = *(const unsigned long long*)(qs + (size_t)t * (FOX ? DATT : DM));
          q[t][0] = bf2f((unsigned short)w); q[t][1] = bf2f((unsigned short)(w >> 16)); q[t][2] = bf2f((unsigned short)(w >> 32)); q[t][3] = bf2f((unsigned short)(w >> 48)); } }
    const int* page_table = (const int*)A.in[6];
    __syncthreads();
    if (FOX && part > 0) {
        const float* rc = (const float*)(A.ws + WS_RC) + (size_t)(b * 2 + sl) * (4 * PAST);
        { const int h4 = tid >> 7, k4 = (tid & 127) * 4; *(LAS f32x4*)(Rb + h4 * PAST + 512 * part + k4) = *(const f32x4*)(rc + h4 * PAST + 512 * part + k4); }
        __syncthreads();
    } else if (FOX) {
        const float* cache_logf = (const float*)A.in[5];
        const int h4 = tid >> 7, seg = tid & 127; const int phys = page_table[b * NPAGES + (seg >> 3)]; const size_t base = ((size_t)phys * PAGE + ((16 * seg) & (PAGE - 1))) * HATT + 4 * sl + h4;
        float lp[16]; float tot = 0.f;
#pragma unroll
        for (int i = 0; i < 16; ++i) { lp[i] = cache_logf[base + (size_t)i * HATT] * LOG2E; tot += lp[i]; }
        float inc = tot;
#pragma unroll
        for (int o = 1; o < 64; o <<= 1) { const float t = __shfl_down(inc, o); if (lane + o < 64) inc += t; }
        if (lane == 0) tmp[wave] = inc;
        __syncthreads();
        float after = inc - tot; if (!(wave & 1)) after += tmp[wave + 1];
        float run = after;
#pragma unroll
        for (int i = 15; i >= 0; --i) { Rb[h4 * PAST + 16 * seg + i] = run; run += lp[i]; }
        __syncthreads();
        { float* rc = (float*)(A.ws + WS_RC) + (size_t)(b * 2 + sl) * (4 * PAST);
#pragma unroll
          for (int j = 0; j < 4; ++j) { const int e4 = (tid + NTHREADS * j) * 4; *(f32x4*)(rc + e4) = *(const LAS f32x4*)(Rb + e4); } }
    }
    const float* ck = (const float*)A.in[FOX ? 3 : 7]; const float* cv = (const float*)A.in[FOX ? 4 : 8];
    size_t koff0;
    if (FOX) { const int p0 = page_table[b * NPAGES + 4 * part + (wave >> 1)]; koff0 = (((size_t)p0 * PAGE + 64 * (wave & 1)) * HATT + 4 * sl) * HD + 4 * lane; }
    else koff0 = (((size_t)b * NMEM + 32 * wave) * HX + sl) * HDX + 4 * lane;
    constexpr size_t KSTRIDE = FOX ? (size_t)HATT * HD : (size_t)HX * HDX;
    float m[4], l[4], o[4][4];
#pragma unroll
    for (int t = 0; t < 4; ++t) { m[t] = -1e30f; l[t] = 0.f; o[t][0] = 0.f; o[t][1] = 0.f; o[t][2] = 0.f; o[t][3] = 0.f; }
    f32x4 kf[4], vf[4], nk[4], nv[4];
#define DEC_LOAD(g_, K_, V_) do { const size_t off_ = koff0 + (size_t)(4 * (g_)) * KSTRIDE; \
        _Pragma("unroll") for (int k_ = 0; k_ < 4; ++k_) { K_[k_] = __builtin_nontemporal_load((const f32x4*)(ck + off_ + k_ * KSTRIDE)); V_[k_] = __builtin_nontemporal_load((const f32x4*)(cv + off_ + k_ * KSTRIDE)); } } while (0)
#define DEC_GROUP(K_, V_, B4_, MASKED_) do { float s_[4][4]; \
        _Pragma("unroll") for (int k_ = 0; k_ < 4; ++k_) _Pragma("unroll") for (int t_ = 0; t_ < 4; ++t_) \
            s_[k_][t_] = (q[t_][0] * K_[k_][0] + q[t_][1] * K_[k_][1]) + (q[t_][2] * K_[k_][2] + q[t_][3] * K_[k_][3]); \
          \
        _Pragma("unroll") for (int k_ = 0; k_ < 4; ++k_) _Pragma("unroll") for (int t_ = 0; t_ < 4; ++t_) s_[k_][t_] = ROR_ADD(s_[k_][t_], 8); \
        _Pragma("unroll") for (int k_ = 0; k_ < 4; ++k_) _Pragma("unroll") for (int t_ = 0; t_ < 4; ++t_) s_[k_][t_] = ROR_ADD(s_[k_][t_], 4); \
        _Pragma("unroll") for (int k_ = 0; k_ < 4; ++k_) _Pragma("unroll") for (int t_ = 0; t_ < 4; ++t_) s_[k_][t_] = ROR_ADD(s_[k_][t_], 2); \
        _Pragma("unroll") for (int k_ = 0; k_ < 4; ++k_) _Pragma("unroll") for (int t_ = 0; t_ < 4; ++t_) s_[k_][t_] = ROR_ADD(s_[k_][t_], 1); \
        if (!FOX) { _Pragma("unroll") for (int k_ = 0; k_ < 4; ++k_) _Pragma("unroll") for (int t_ = 0; t_ < 4; ++t_) { float d_ = s_[k_][t_]; d_ += __shfl_xor(d_, 16); d_ += __shfl_xor(d_, 32); s_[k_][t_] = d_; } } \
        _Pragma("unroll") for (int k_ = 0; k_ < 4; ++k_) _Pragma("unroll") for (int t_ = 0; t_ < 4; ++t_) { float d_ = s_[k_][t_] + B4_[k_]; if (MASKED_ && k_ > t_) d_ = -1e30f; s_[k_][t_] = d_; } \
        _Pragma("unroll") for (int t_ = 0; t_ < 4; ++t_) { const float mg_ = __builtin_fmaxf(__builtin_fmaxf(s_[0][t_], s_[1][t_]), __builtin_fmaxf(s_[2][t_], s_[3][t_])); const float mn_ = __builtin_fmaxf(m[t_], mg_); const float f_ = __builtin_amdgcn_exp2f(m[t_] - mn_); \
            const float p0_ = __builtin_amdgcn_exp2f(s_[0][t_] - mn_), p1_ = __builtin_amdgcn_exp2f(s_[1][t_] - mn_), p2_ = __builtin_amdgcn_exp2f(s_[2][t_] - mn_), p3_ = __builtin_amdgcn_exp2f(s_[3][t_] - mn_); \
            l[t_] = l[t_] * f_ + ((p0_ + p1_) + (p2_ + p3_)); m[t_] = mn_; \
            _Pragma("unroll") for (int d_ = 0; d_ < 4; ++d_) o[t_][d_] = o[t_][d_] * f_ + ((p0_ * V_[0][d_] + p1_ * V_[1][d_]) + (p2_ * V_[2][d_] + p3_ * V_[3][d_])); } } while (0)
    DEC_LOAD(0, kf, vf);
    for (int g = 0; g < NG; ++g) {
        if (g + 1 < NG) DEC_LOAD(g + 1, nk, nv);
        f32x4 b4 = {0.f, 0.f, 0.f, 0.f};
        if (FOX) b4 = *(const LAS f32x4*)(Rb + hl * PAST + 512 * part + KPW * wave + 4 * g);
        DEC_GROUP(kf, vf, b4, false);
#pragma unroll
        for (int k = 0; k < 4; ++k) { kf[k] = nk[k]; vf[k] = nv[k]; }
    }
    if (FOX && wave == 0 && part == 3) {
        const bf16* Kb = (const bf16*)(A.ws + WS_K) + qrow * DATT + sl * 256 + 4 * lane; const bf16* Vb = (const bf16*)(A.ws + WS_V) + qrow * DATT + sl * 256 + 4 * lane;
        const float* LOGF = (const float*)(A.ws + WS_LOGF) + qrow * 8 + 4 * sl + hl;
        f32x4 b4; float cn = 0.f;
#pragma unroll
        for (int k = 0; k < 4; ++k) { cn += LOGF[k * 8]; b4[k] = -cn * LOG2E;
            const unsigned long long kw = *(const unsigned long long*)(Kb + (size_t)k * DATT), vw = *(const unsigned long long*)(Vb + (size_t)k * DATT);
            kf[k] = (f32x4){bf2f((unsigned short)kw), bf2f((unsigned short)(kw >> 16)), bf2f((unsigned short)(kw >> 32)), bf2f((unsigned short)(kw >> 48))};
            vf[k] = (f32x4){bf2f((unsigned short)vw), bf2f((unsigned short)(vw >> 16)), bf2f((unsigned short)(vw >> 32)), bf2f((unsigned short)(vw >> 48))}; }
        DEC_GROUP(kf, vf, b4, true);
    }
#undef DEC_LOAD
#undef DEC_GROUP
#pragma unroll
    for (int t = 0; t < 4; ++t) { *(LAS f32x4*)(om + (wave * 4 + t) * 256 + 4 * lane) = (f32x4){o[t][0], o[t][1], o[t][2], o[t][3]};
        if ((lane & 15) == 0) { mlb[((wave * 4 + t) * 4 + (lane >> 4)) * 2] = m[t]; mlb[((wave * 4 + t) * 4 + (lane >> 4)) * 2 + 1] = l[t]; } }
    __syncthreads();
    { const int t = tid >> 7, idx = (tid & 127) * 2, h4 = idx >> 6;
      float M = -1e30f;
#pragma unroll
      for (int w = 0; w < 8; ++w) M = fmaxf(M, mlb[((w * 4 + t) * 4 + h4) * 2]);
      float L = 0.f, o0 = 0.f, o1 = 0.f;
#pragma unroll
      for (int w = 0; w < 8; ++w) { const float f = exp2f(mlb[((w * 4 + t) * 4 + h4) * 2] - M); L += f * mlb[((w * 4 + t) * 4 + h4) * 2 + 1]; const f32x2 ov = *(const LAS f32x2*)(om + (w * 4 + t) * 256 + idx); o0 += f * ov[0]; o1 += f * ov[1]; }
      if (FOX) { float* pb = (float*)(A.ws + WS_PART) + ((size_t)((b * 2 + sl) * 4) * 4 + t) * 272;
          if (part < 3) { *(f32x2*)(pb + (size_t)part * 4 * 272 + idx) = (f32x2){o0, o1}; if ((idx & 63) == 0) { pb[(size_t)part * 4 * 272 + 256 + h4] = M; pb[(size_t)part * 4 * 272 + 260 + h4] = L; } return; }
          float Mp[3], Lp[3]; f32x2 op[3]; float Mt = M;
#pragma unroll
          for (int pp = 0; pp < 3; ++pp) { Mp[pp] = pb[(size_t)pp * 4 * 272 + 256 + h4]; Lp[pp] = pb[(size_t)pp * 4 * 272 + 260 + h4]; op[pp] = *(const f32x2*)(pb + (size_t)pp * 4 * 272 + idx); Mt = fmaxf(Mt, Mp[pp]); }
          const float f3 = exp2f(M - Mt); L *= f3; o0 *= f3; o1 *= f3;
#pragma unroll
          for (int pp = 0; pp < 3; ++pp) { const float f = exp2f(Mp[pp] - Mt); L += f * Lp[pp]; o0 += f * op[pp][0]; o1 += f * op[pp][1]; } }
      const float il = 1.0f / L;
      bf16* dst = FOX ? (bf16*)(A.ws + WS_MIX) : (bf16*)(A.ws + WS_OC);
      *(unsigned*)(dst + (qrow + t) * DM + sl * 256 + idx) = pk2(o0 * il, o1 * il); }
}
template <bool FOX> __device__ __forceinline__ void decode_phase(const Args& A, LAS unsigned char* lds, int tid, int lane, int wave, int wg, int nwg, int part = 0) {
    constexpr int NU = FOX ? DB * 2 : DB * HX;
    for (int u = wg; u < NU; u += nwg) { if (FOX) decode_unit<true>(A, lds, tid, lane, wave, u >> 1, u & 1, part); else decode_unit<false>(A, lds, tid, lane, wave, u >> 2, u & 3, 0); }
    __syncthreads();
}

constexpr int XKP = 264, XVP = 136, XBUF = 69632;
__device__ __forceinline__ void cross_prompt_phase(const Args& A, LAS unsigned char* lds, int tid_in, int lane_in, int wave, int wg, int nwg) {
    const bf16* QC = (const bf16*)(A.ws + WS_QC); const bf16* MKb = (const bf16*)(A.ws + WS_MK); const bf16* MVT = (const bf16*)(A.ws + WS_MV); bf16* OC = (bf16*)(A.ws + WS_OC);
    for (int u = wg; u < NBATCH * HX * (SEQ / 256); u += nwg) {
        int tid_o = tid_in; asm volatile("" : "+v"(tid_o));
        const int tid = tid_o, lane = tid & 63, r = lane & 15, qd = lane >> 4;
        const int qt = u & 31, bh = u >> 5, b = bh >> 2, head = bh & 3; const size_t row0 = (size_t)b * SEQ + 256 * qt + 32 * wave + r;
        __syncthreads();
#pragma unroll
        for (int half = 0; half < 2; ++half) { const int key = tid >> 2, part = tid & 3; const bf16* src = MKb + ((size_t)b * NMEM + half * 128 + key) * DM + head * HDX + part * 64;
            LAS bf16* dst = (LAS bf16*)(lds + half * XBUF) + key * XKP + part * 64;
#pragma unroll
            for (int i = 0; i < 8; ++i) *(LAS v4u*)(dst + 8 * i) = *(const v4u*)(src + 8 * i); }
        __syncthreads();
        bf16x8 pb[2][8]; float il[2];
#pragma unroll
        for (int rt = 0; rt < 2; ++rt) {
            bf16x8 qf[8];
#pragma unroll
            for (int k = 0; k < 8; ++k) qf[k] = *(const bf16x8*)(QC + (row0 + 16 * rt) * DM + head * HDX + 32 * k + 8 * qd);
#pragma unroll
            for (int k = 0; k < 8; ++k) asm volatile("" : "+v"(qf[k]));
            f32x4 ST[16];
#pragma unroll
            for (int half = 0; half < 2; ++half)
#pragma unroll
                for (int kt = 0; kt < 8; ++kt) { f32x4 acc = {0.f, 0.f, 0.f, 0.f};
#pragma unroll
                    for (int k = 0; k < 8; ++k) acc = mfma16(ldfrag((const LAS bf16*)(lds + half * XBUF), XKP, 16 * kt, 32 * k, lane), qf[k], acc);
                    ST[half * 8 + kt] = acc; }
            float mx = -1e30f;
#pragma unroll
            for (int j = 0; j < 16; ++j) mx = fmaxf(mx, fmaxf(fmaxf(ST[j][0], ST[j][1]), fmaxf(ST[j][2], ST[j][3])));
            mx = fmaxf(mx, __shfl_xor(mx, 16)); mx = fmaxf(mx, __shfl_xor(mx, 32));
            float l = 0.f;
#pragma unroll
            for (int j = 0; j < 16; ++j)
#pragma unroll
                for (int i = 0; i < 4; ++i) { ST[j][i] = exp2f(ST[j][i] - mx); l += ST[j][i]; }
            l += __shfl_xor(l, 16); l += __shfl_xor(l, 32); il[rt] = 1.0f / l;
#pragma unroll
            for (int uu = 0; uu < 8; ++uu) { pb[rt][uu] = __builtin_bit_cast(bf16x8, pack8(ST[2 * uu], ST[2 * uu + 1])); asm volatile("" : "+v"(pb[rt][uu])); }
            __builtin_amdgcn_sched_barrier(0);
        }
        __syncthreads();
#pragma unroll
        for (int half = 0; half < 2; ++half) { const bf16* src = MVT + ((size_t)bh * HDX) * NMEM + half * 128; LAS bf16* dst = (LAS bf16*)(lds + half * XBUF);
#pragma unroll
            for (int j = 0; j < 8; ++j) { const int id = tid + NTHREADS * j, d = id >> 4, c = id & 15; *(LAS v4u*)(dst + d * XVP + 8 * c) = *(const v4u*)(src + (size_t)d * NMEM + 8 * c); } }
        __syncthreads();
#pragma unroll
        for (int rt = 0; rt < 2; ++rt) {
            f32x4 OT[16];
#pragma unroll
            for (int dt = 0; dt < 16; ++dt) OT[dt] = (f32x4){0.f, 0.f, 0.f, 0.f};
#pragma unroll
            for (int half = 0; half < 2; ++half)
#pragma unroll
                for (int u4 = 0; u4 < 4; ++u4)
#pragma unroll
                    for (int dt = 0; dt < 16; ++dt) { const LAS bf16* vp = (const LAS bf16*)(lds + half * XBUF) + (16 * dt + r) * XVP + 32 * u4 + 4 * qd;
                        const unsigned long long lo = *(const LAS unsigned long long*)vp, hi = *(const LAS unsigned long long*)(vp + 16);
                        v4u w; w.x = (unsigned)lo; w.y = (unsigned)(lo >> 32); w.z = (unsigned)hi; w.w = (unsigned)(hi >> 32);
                        OT[dt] = mfma16(__builtin_bit_cast(bf16x8, w), pb[rt][half * 4 + u4], OT[dt]); }
            const float ilv = il[rt];
#pragma unroll
            for (int dt = 0; dt < 16; ++dt) *(unsigned long long*)(OC + (row0 + 16 * rt) * DM + head * HDX + 16 * dt + 4 * qd) = (unsigned long long)pk2(OT[dt][0] * ilv, OT[dt][1] * ilv) | ((unsigned long long)pk2(OT[dt][2] * ilv, OT[dt][3] * ilv) << 32);
            __builtin_amdgcn_sched_barrier(0);
        }
    }
    __syncthreads();
}

template <class F> __device__ __forceinline__ void small_gemm(LAS unsigned char* lds, const bf16* __restrict__ Am, int row_base, int M, const bf16* __restrict__ Bt, int N, int K, const F& f, int tid_in, int wave, int wg, int nwg) {
    const int tiles_m = M / 32, ntiles = tiles_m * (N / 128), kw = K / 8;
    LAS float* part = (LAS float*)lds;
    for (int tile = wg; tile < ntiles; tile += nwg) {
        int tid_o = tid_in; asm volatile("" : "+v"(tid_o));
        const int lane = tid_o & 63, r = lane & 15, qd = lane >> 4;
        const int tm = tile % tiles_m, tn = tile / tiles_m;
        const bf16* ap = Am + (size_t)(32 * tm + r) * K + wave * kw + 8 * qd; const bf16* bp = Bt + (size_t)(128 * tn + r) * K + wave * kw + 8 * qd;
        f32x4 acc[2][8];
#pragma unroll
        for (int mt = 0; mt < 2; ++mt)
#pragma unroll
            for (int nt = 0; nt < 8; ++nt) acc[mt][nt] = (f32x4){0.f, 0.f, 0.f, 0.f};
#pragma unroll 2
        for (int ks = 0; ks < kw / 32; ++ks) { bf16x8 af[2], bfr[8];
#pragma unroll
            for (int mt = 0; mt < 2; ++mt) af[mt] = *(const bf16x8*)(ap + (size_t)(16 * mt) * K + 32 * ks);
#pragma unroll
            for (int nt = 0; nt < 8; ++nt) bfr[nt] = *(const bf16x8*)(bp + (size_t)(16 * nt) * K + 32 * ks);
#pragma unroll
            for (int mt = 0; mt < 2; ++mt)
#pragma unroll
                for (int nt = 0; nt < 8; ++nt) acc[mt][nt] = mfma16(af[mt], bfr[nt], acc[mt][nt]); }
#pragma unroll
        for (int mt = 0; mt < 2; ++mt)
#pragma unroll
            for (int nt = 0; nt < 8; ++nt)
#pragma unroll
                for (int i = 0; i < 4; ++i) part[(wave * 32 + 16 * mt + 4 * qd + i) * 128 + 16 * nt + r] = acc[mt][nt][i];
        __syncthreads();
        { const int row = (wave & 1) * 16 + r, col0 = ((wave >> 1) * 4 + qd) * 8; f32x4 v0 = {0.f, 0.f, 0.f, 0.f}, v1 = {0.f, 0.f, 0.f, 0.f};
#pragma unroll
          for (int w = 0; w < 8; ++w) { v0 = v0 + *(const LAS f32x4*)(part + (w * 32 + row) * 128 + col0); v1 = v1 + *(const LAS f32x4*)(part + (w * 32 + row) * 128 + col0 + 4); }
          f(row_base + 32 * tm + row, 128 * tn + col0, v0, v1); }
        __syncthreads();
    }
}

template <class Epi> __device__ __forceinline__ void run_gemm(LAS unsigned char* lds, const bf16* Am, const bf16* Bt, int M, int N, int K, int nwg, int wg, const Epi& E) {
    pg8::Gemm g{Am, Bt, M, N, K}; pg8::StaticOrder S; S.init(M, N, nwg, wg);
    pg8::gemm_phase<Epi, pg8::StaticOrder, true, true>((PG8_LAS unsigned char*)lds, g, S, E);
}

__global__ void __launch_bounds__(NTHREADS, 2) mk_fwd(Args A) {
    extern __shared__ __attribute__((aligned(16))) unsigned char lds_raw[];
    LAS unsigned char* lds = (LAS unsigned char*)lds_raw;
    const int tid = threadIdx.x, lane = tid & 63, wave = __builtin_amdgcn_readfirstlane(tid >> 6);
#define LANE() lane
#define TID() tid
    const int wg = blockIdx.x, nwg = gridDim.x;
    unsigned char* ws = A.ws;
    for (int u = TID(); u < (LDS_BYTES - LDSCTL_OFF) / 4; u += NTHREADS) ((LAS unsigned*)(lds + LDSCTL_OFF))[u] = 0u;
    __syncthreads();
    volatile LAS unsigned* MISC = (volatile LAS unsigned*)(lds + MISC_OFF);
    XcdBarrier bar; bar.bar = (unsigned*)(ws + WS_CTL) + CW_BAR; bar.x = 0; bar.st = nullptr;
    if (MK_ONE_LAUNCH) bar = xcd_barrier_post((unsigned*)(ws + WS_CTL) + CW_BAR, MISC + 8);
    const int lo = A.ph_lo, hi = A.ph_hi;
#define IN(k) (lo <= (k) && (k) < hi)
#define SEAM(k) do { if (MK_ONE_LAUNCH && IN(k) && IN((k) + 1)) xcd_barrier(bar); } while (0)
#ifndef REP_PHASE
#define REP_PHASE -1
#endif
#define REP(k, body) do { body; if (REP_PHASE == (k)) { body; } } while (0)
    bf16* XB = (bf16*)(ws + WS_XB);

    if (IN(0)) { REP(0, p0_prologue(A, lds, TID(), LANE(), wave, wg, nwg)); } SEAM(0);
    if (IN(1)) {
        if (wg < NBATCH * HATT) p1_cumsum(A, lds, TID(), LANE(), wave, wg);
        { const FMemKV Fm{(const float*)(ws + WS_SSM), (bf16*)(ws + WS_MK), (bf16*)(ws + WS_MV), A.out};
          small_gemm(lds, (const bf16*)(ws + WS_MB), 0, MMEM, (const bf16*)(ws + WS_WCKV), 2048, DM, Fm, TID(), wave, wg, nwg); }
        { const FInproj Fi{(const float*)(ws + WS_SS0), (bf16*)(ws + WS_Q), (bf16*)(ws + WS_K), (bf16*)(ws + WS_V), (bf16*)(ws + WS_Z), (bf16*)(ws + WS_XBC), A.out};
          small_gemm(lds, XB + (size_t)MP * DM, MP, MS, (const bf16*)(ws + WS_WIN), 3072, DM, Fi, TID(), wave, wg, nwg);
          pg8::Epi8<FInproj> E{Fi}; REP(1, run_gemm(lds, XB, (const bf16*)(ws + WS_WIN), MP, 3072, DM, nwg, wg, E)); }
    } SEAM(1);
    if (IN(2)) { if (wg & 1) decode_phase<true>(A, lds, TID(), LANE(), wave, wg, nwg, 0);
        if (nwg == 256) wconv(A, (LAS float*)(lds + wave * 8448), 1, wg * NWAVES + wave, nwg * NWAVES, LANE()); __syncthreads(); attn_norms(A, LANE(), wave, wg, nwg); REP(21, conv_pass(A, TID(), wg, nwg)); REP(2, ssd_phase_a(A, lds, TID(), LANE(), wave, wg, nwg));
        if (!(wg & 1)) decode_phase<true>(A, lds, TID(), LANE(), wave, wg, nwg, 0); } SEAM(2);
    if (IN(3)) { for (int rep3 = 0; rep3 < (REP_PHASE == 3 ? 2 : 1); ++rep3) {
        if (wave < 4) { ssd_phase_b(A, wg * 256 + TID(), nwg * 256); } else { p3_ssd_naive(A, lds, LANE(), wave, wg, nwg, NBATCH * HSSM * 4, wave - 4, 4); } __syncthreads();
        { const attn_body::AttnTensors AT{(const attn_body::bf16*)(ws + WS_Q), (const attn_body::bf16*)(ws + WS_K), (const attn_body::bf16*)(ws + WS_V), (attn_body::bf16*)(ws + WS_MIX), (const float*)(ws + WS_CUM), (const float*)(ws + WS_KN), (const float*)(ws + WS_QN)};
          const int grp = wg & 1; int dp = 0;
          gu32* aq = (gu32*)(ws + WS_CTL) + CW_AQ;
          for (;;) {
              int zo_; asm volatile("s_mov_b32 %0, 0" : "=s"(zo_));
              if (grp == 0 && dp < 2) { decode_phase<true>(A, lds + zo_, TID(), LANE(), wave, wg, nwg, 1 + dp); ++dp; }
              if (TID() == 0) MISC[0] = __hip_atomic_fetch_add(aq, 1u, __ATOMIC_RELAXED, __HIP_MEMORY_SCOPE_AGENT);
              __syncthreads();
              const int uq = (int)MISC[0];
              __syncthreads();
              if (uq < NBATCH * HATT * (SEQ / 256)) attn_body::attn_unit<64>((uq & 15) >> 3, uq & 7, (SEQ / 256 - 1) - (uq >> 4), AT.Q, AT.K, AT.V, AT.O, AT.CUM, AT.KN, AT.QN, (char*)lds_raw);
              if (grp == 1 && dp < 2) { decode_phase<true>(A, lds + zo_, TID(), LANE(), wave, wg, nwg, 1 + dp); ++dp; }
              if (uq >= NBATCH * HATT * (SEQ / 256) && dp == 2) break;
          } } } } SEAM(3);
    if (IN(4)) { p4_gate_norm(A, LANE(), wave, wg, nwg, MP); for (int slot = 0; slot < 2; ++slot) { int zo_; asm volatile("s_mov_b32 %0, 0" : "=s"(zo_)); if ((slot ^ (wg & 1)) == 0) decode_phase<true>(A, lds + zo_, TID(), LANE(), wave, wg, nwg, 3); else { REP(4, ssd_phase_c(A, lds + zo_, TID(), LANE(), wave, wg, nwg)); } } } SEAM(4);
    if (IN(5)) { const FRes Fr{(const float*)A.in[0], (const float*)A.in[1], XB, (float*)(ws + WS_SS1)};
        small_gemm(lds, (const bf16*)(ws + WS_MIX) + (size_t)MP * DM, MP, MS, (const bf16*)(ws + WS_WOUT), DM, DM, Fr, TID(), wave, wg, nwg);
        if (nwg == 256 && wg >= 128) { wconv(A, (LAS float*)(lds + wave * 8448), 2, (wg - 128) * NWAVES + wave, (nwg - 128) * NWAVES, LANE()); __syncthreads(); }
        pg8::Epi8<FRes> E{Fr}; run_gemm(lds, (const bf16*)(ws + WS_MIX), (const bf16*)(ws + WS_WOUT), MP, DM, DM, nwg, wg, E); } SEAM(5);
    if (IN(6)) { const FScaleBf16 Fs{(const float*)(ws + WS_SS1), (bf16*)(ws + WS_QC), XC2};
        small_gemm(lds, XB + (size_t)MP * DM, MP, MS, (const bf16*)(ws + WS_WCQ), DM, DM, Fs, TID(), wave, wg, nwg);
        if (nwg == 256 && wg >= 128) { wconv(A, (LAS float*)(lds + wave * 8448), 3, (wg - 128) * NWAVES + wave, (nwg - 128) * NWAVES, LANE()); __syncthreads(); }
        pg8::Epi8<FScaleBf16> E{Fs}; REP(6, run_gemm(lds, XB, (const bf16*)(ws + WS_WCQ), MP, DM, DM, nwg, wg, E)); } SEAM(6);
    if (IN(7)) {
        if (wg & 1) { REP(71, decode_phase<false>(A, lds, TID(), LANE(), wave, wg, nwg)); REP(72, cross_prompt_phase(A, lds, TID(), LANE(), wave, wg, nwg)); }
        else { REP(72, cross_prompt_phase(A, lds, TID(), LANE(), wave, wg, nwg)); REP(71, decode_phase<false>(A, lds, TID(), LANE(), wave, wg, nwg)); } } SEAM(7);
    if (IN(8)) { const FRes Fr{nullptr, nullptr, XB, (float*)(ws + WS_SS2)};
        small_gemm(lds, (const bf16*)(ws + WS_OC) + (size_t)MP * DM, MP, MS, (const bf16*)(ws + WS_WCO), DM, DM, Fr, TID(), wave, wg, nwg);
        if (nwg == 256 && wg >= 128) { wconv(A, (LAS float*)(lds + wave * 8448), 5, (wg - 128) * NWAVES + wave, (nwg - 128) * NWAVES, LANE()); __syncthreads(); }
        pg8::Epi8<FRes> E{Fr}; run_gemm(lds, (const bf16*)(ws + WS_OC), (const bf16*)(ws + WS_WCO), MP, DM, DM, nwg, wg, E); } SEAM(8);
    if (IN(9)) { pg8::EpiGU<FGateUp> E{{(const float*)(ws + WS_SS2), (bf16*)(ws + WS_U)}};
        REP(9, run_gemm(lds, XB, (const bf16*)(ws + WS_WGU), MT, 2 * DFF, DM, nwg, wg, E));
        if (nwg == 256 && wg >= 172) { wconv(A, (LAS float*)(lds + wave * 8448), 6, (wg - 172) * NWAVES + wave, (nwg - 172) * NWAVES, LANE()); } } SEAM(9);
    if (IN(10)) { const FRes Fr{nullptr, nullptr, XB, (float*)(ws + WS_SS3)};
        small_gemm(lds, (const bf16*)(ws + WS_U) + (size_t)MP * DFF, MP, MS, (const bf16*)(ws + WS_WD), DM, DFF, Fr, TID(), wave, wg, nwg);
        pg8::Epi8<FRes> E{Fr}; run_gemm(lds, (const bf16*)(ws + WS_U), (const bf16*)(ws + WS_WD), MP, DM, DFF, nwg, wg, E); } SEAM(10);
    if (IN(11)) { REP(11, p11_final_norm(A, LANE(), wave, wg, nwg)); }
#undef IN
#undef SEAM
#undef LANE
#undef TID
}

extern "C" void kernel_launch(void* const* d_in, const int* in_sizes, int n_in, void* d_out, int out_size, void* d_ws, size_t ws_size, hipStream_t stream) {
    static int grid = 0;
    if (grid == 0) {
        if (n_in != 32 || out_size != (int)OUT_TOTAL || ws_size < WS_END2) { fprintf(stderr, "kernel_launch: unexpected shapes (n_in %d out %d ws %zu)\n", n_in, out_size, ws_size); grid = -1; return; }
        int dev = 0, cus = 0, per_cu = 0;
        if (hipGetDevice(&dev) != hipSuccess || hipDeviceGetAttribute(&cus, hipDeviceAttributeMultiprocessorCount, dev) != hipSuccess) { grid = -1; return; }
        if (hipFuncSetAttribute((const void*)mk_fwd, hipFuncAttributeMaxDynamicSharedMemorySize, LDS_BYTES) != hipSuccess) { fprintf(stderr, "kernel_launch: hipFuncSetAttribute failed\n"); grid = -1; return; }
        if (hipOccupancyMaxActiveBlocksPerMultiprocessor(&per_cu, (const void*)mk_fwd, NTHREADS, LDS_BYTES) != hipSuccess || per_cu < 1) fprintf(stderr, "kernel_launch: occupancy query reports %d\n", per_cu);
        (void)hipGetLastError();
        grid = cus;
    }
    if (grid < 0) return;
    (void)hipMemsetAsync((char*)d_ws + WS_CTL, 0, CTL_ZERO_BYTES, stream);
    Args a{};
    for (int i = 0; i < 32; ++i) a.in[i] = d_in[i];
    a.out = (float*)d_out; a.ws = (unsigned char*)d_ws;
    if (MK_ONE_LAUNCH) { a.ph_lo = 0; a.ph_hi = NPH; hipLaunchKernelGGL(mk_fwd, dim3(grid), dim3(NTHREADS), LDS_BYTES, stream, a); }
    else for (int p = 0; p < NPH; ++p) { a.ph_lo = p; a.ph_hi = p + 1; hipLaunchKernelGGL(mk_fwd, dim3(grid), dim3(NTHREADS), LDS_BYTES, stream, a); }
}
```

```cpp
#include <hip/hip_runtime.h>
#include <cstdio>
#include <cstdint>
#include <cmath>
#define GAS __attribute__((address_space(1)))
#define LAS __attribute__((address_space(3)))
typedef unsigned short bf16;
typedef unsigned v4u __attribute__((ext_vector_type(4)));
typedef float f32x4 __attribute__((ext_vector_type(4)));
typedef short bf16x8 __attribute__((ext_vector_type(8)));
typedef GAS unsigned gu32;
typedef GAS unsigned long long gu64;
#define RLX_AGENT __ATOMIC_RELAXED, __HIP_MEMORY_SCOPE_AGENT
#define LDS_WAIT() asm volatile("s_waitcnt lgkmcnt(0)" ::: "memory")
#define VM_WAIT() asm volatile("s_waitcnt vmcnt(0)" ::: "memory")
__device__ __forceinline__ unsigned long long rt() { return __builtin_amdgcn_s_memrealtime(); }
__device__ __forceinline__ unsigned f2bf(float f) { unsigned u = __builtin_bit_cast(unsigned, f); return (u + 0x7fffu + ((u >> 16) & 1u)) >> 16; }
__device__ __forceinline__ unsigned pk2(float lo, float hi) { return f2bf(lo) | (f2bf(hi) << 16); }
typedef float f32x2 __attribute__((ext_vector_type(2)));
namespace pg8 {
#define PG8_LAS __attribute__((address_space(3)))
typedef unsigned short bf16_t;
typedef short bf16x8 __attribute__((ext_vector_type(8)));
typedef float f32x4 __attribute__((ext_vector_type(4)));
typedef unsigned u32x4 __attribute__((ext_vector_type(4)));
constexpr int BM = 256, BK = 64, HALF = 128, HTB = HALF * BK * 2  , STAGE_BYTES = 8 * HTB, NXCD = 8, WGM = 8;

__host__ __device__ __forceinline__ int lds_byte(int r, int c) { const int st = (r >> 4) * 2 + (c >> 5), rr = r & 15, cc = c & 31, ob = rr * 64 + cc * 2; return st * 1024 + (ob ^ (((ob >> 9) & 1) << 5)); }
__host__ __device__ __forceinline__ void stage_rc(int b, int& R, int& C) { const int st = b / 1024, sb = b % 1024, swz = sb ^ (((sb >> 9) & 1) << 5); R = (st >> 1) * 16 + swz / 64; C = (st & 1) * 32 + (swz % 64) / 2; }
__host__ __device__ __forceinline__ int perm32(int rho) { const int n = rho >> 4, i = rho & 15; return 8 * (i >> 2) + 4 * n + (i & 3); }

struct Unit { int pm, pn; };
struct Gemm { const bf16_t* A; const bf16_t* Bt; int M, N, K; };

struct StaticOrder {
    int nM, nN, nwg, G, c;
    __host__ __device__ void init(int M, int N, int G_, int c_) { nM = M / BM; nN = N / BM; nwg = nM * nN; G = G_; c = c_; }
    __host__ __device__ bool next(int i, Unit& u) const {
        const long L = (long)i * G + c; if (L >= nwg) return false;
        int wgid = (int)L; { const int q = nwg / NXCD, r = nwg % NXCD, xcd = wgid % NXCD, off = wgid / NXCD; wgid = (xcd < r ? xcd * (q + 1) : r * (q + 1) + (xcd - r) * q) + off; }
        const int nig = WGM * nN, gid = wgid / nig, fm = gid * WGM, gsz = (nM - fm) < WGM ? (nM - fm) : WGM;
        u.pm = fm + ((wgid % nig) % gsz); u.pn = (wgid % nig) / gsz; return true;
    }
    __device__ __forceinline__ void a_ready(const Unit&) const {}
    __device__ __forceinline__ void done(const Unit&) const {}
};

__device__ __forceinline__ unsigned cvt_pk_bf16(float lo, float hi) { unsigned r; asm volatile("v_cvt_pk_bf16_f32 %0, %1, %2" : "=v"(r) : "v"(lo), "v"(hi)); return r; }
typedef float f32x2 __attribute__((ext_vector_type(2)));
template <class F> struct Epi8 {
    static constexpr bool PERM = true, AFTER_DRAIN = false;
    F f;
    __device__ __forceinline__ void operator()(const f32x4 (&acc)[2][2][4][2], const Unit& u, int wr, int wc, int fr, int fq) const {
        const int row0 = u.pm * BM + wr * 64 + fr, col0 = u.pn * BM + wc * 32 + 8 * fq;
#pragma unroll
        for (int ai = 0; ai < 2; ++ai) { typename F::Pre pre[4][2];
#pragma unroll
            for (int m = 0; m < 4; ++m)
#pragma unroll
                for (int bj = 0; bj < 2; ++bj) f.prefetch(row0 + ai * HALF + m * 16, col0 + bj * HALF, pre[m][bj]);
#pragma unroll
            for (int m = 0; m < 4; ++m)
#pragma unroll
                for (int bj = 0; bj < 2; ++bj) f.apply(row0 + ai * HALF + m * 16, col0 + bj * HALF, acc[ai][bj][m][0], acc[ai][bj][m][1], pre[m][bj]); }
    }
};
template <class F> struct EpiGU {
    static constexpr bool PERM = true, AFTER_DRAIN = false;
    F f;
    __device__ __forceinline__ void operator()(const f32x4 (&acc)[2][2][4][2], const Unit& u, int wr, int wc, int fr, int fq) const {
        const int row0 = u.pm * BM + wr * 64 + fr, col0 = u.pn * HALF + wc * 32 + 8 * fq;
        typename F::Pre pre[2][4];
#pragma unroll
        for (int ai = 0; ai < 2; ++ai)
#pragma unroll
            for (int m = 0; m < 4; ++m) f.prefetch(row0 + ai * HALF + m * 16, col0, pre[ai][m]);
#pragma unroll
        for (int ai = 0; ai < 2; ++ai)
#pragma unroll
            for (int m = 0; m < 4; ++m) f.apply(row0 + ai * HALF + m * 16, col0, acc[ai][0][m][0], acc[ai][0][m][1], acc[ai][1][m][0], acc[ai][1][m][1], pre[ai][m]);
    }
};
template <class Epi, class Sched, bool ALIGN_EPI = false, bool SP2 = false>
__device__ __forceinline__ void gemm_phase(PG8_LAS unsigned char* lds, const Gemm g, const Sched& S, const Epi& E) {
    const int tid = threadIdx.x, wid = __builtin_amdgcn_readfirstlane(tid >> 6), lane = tid & 63, wr = wid >> 2, wc = wid & 3, fr = lane & 15, fq = lane >> 4;
    const int K = g.K, nt = K / BK;
    unsigned voffA[2], voffB[2];
#pragma unroll
    for (int i = 0; i < 2; ++i) { int R, C; stage_rc(tid * 16 + i * 8192, R, C); const int Rb = Epi::PERM ? ((R & ~31) + perm32(R & 31)) : R;
        voffA[i] = (unsigned)(R * K + C) * 2u; voffB[i] = (unsigned)(Rb * K + C) * 2u; }
    const size_t kstep = (size_t)(BK * 2);
    const size_t hstep = (size_t)HALF * K * 2;
    const size_t tstep = 2 * hstep;
    const unsigned ldsw = (unsigned)wid * 1024u;
    const int aoff = lds_byte(wr * 64 + fr, fq * 8), boff = lds_byte(wc * 32 + fr, fq * 8);
#define PG8_SA(b, h) (((b) * 2 + (h)) * HTB)
#define PG8_SB(b, h) ((4 + (b) * 2 + (h)) * HTB)
#define PG8_STAGE(bufoff, gbase, voff) do { _Pragma("unroll") for (int _i = 0; _i < 2; ++_i) \
        __builtin_amdgcn_global_load_lds((const unsigned*)((const char*)(gbase) + (voff)[_i]), (PG8_LAS unsigned*)(lds + (bufoff) + ldsw + _i * 8192), 16, 0, 0); } while (0)
#define PG8_LDA(dst, b, h) do { _Pragma("unroll") for (int m = 0; m < 4; ++m) _Pragma("unroll") for (int k = 0; k < 2; ++k) dst[m][k] = *(const PG8_LAS bf16x8*)(lds + PG8_SA(b, h) + aoff + m * 2048 + k * 1024); } while (0)
#define PG8_LDB(dst, b, h) do { _Pragma("unroll") for (int n = 0; n < 2; ++n) _Pragma("unroll") for (int k = 0; k < 2; ++k) dst[n][k] = *(const PG8_LAS bf16x8*)(lds + PG8_SB(b, h) + boff + n * 2048 + k * 1024); } while (0)
#define PG8_MMA(ai, bj, At, Bt) do { __builtin_amdgcn_s_setprio(1); _Pragma("unroll") for (int m = 0; m < 4; ++m) _Pragma("unroll") for (int n = 0; n < 2; ++n) _Pragma("unroll") for (int k = 0; k < 2; ++k) \
        acc[ai][bj][m][n] = __builtin_amdgcn_mfma_f32_16x16x32_bf16(Bt[n][k], At[m][k], acc[ai][bj][m][n], 0, 0, 0); __builtin_amdgcn_s_setprio(0); } while (0)
#define PG8_WAIT_V(n) asm volatile("s_waitcnt vmcnt(" #n ")" ::: "memory")
#define PG8_WAIT_L(n) asm volatile("s_waitcnt lgkmcnt(" #n ")" ::: "memory")
#define PG8_BAR __builtin_amdgcn_s_barrier()
#define PG8_SCHED __builtin_amdgcn_sched_barrier(0)
    Unit cur, nxt; int ui = 0;
    if (!S.next(0, cur)) return;
    f32x4 acc[2][2][4][2];
#pragma unroll
    for (int a = 0; a < 2; ++a)
#pragma unroll
        for (int b = 0; b < 2; ++b)
#pragma unroll
            for (int m = 0; m < 4; ++m)
#pragma unroll
                for (int n = 0; n < 2; ++n) acc[a][b][m][n] = (f32x4){0.f, 0.f, 0.f, 0.f};
    bf16x8 At[4][2], B0[2][2], B1[2][2];
    const char* cA = (const char*)g.A + (size_t)cur.pm * tstep; const char* cB = (const char*)g.Bt + (size_t)cur.pn * tstep;
    S.a_ready(cur);
    if constexpr (SP2) {
        PG8_STAGE(PG8_SB(0, 0), cB, voffB); PG8_STAGE(PG8_SB(0, 1), cB + hstep, voffB); PG8_STAGE(PG8_SA(0, 0), cA, voffA); PG8_STAGE(PG8_SA(0, 1), cA + hstep, voffA);
        if (wr == 1) PG8_BAR;
        PG8_WAIT_V(2); PG8_BAR;
        PG8_STAGE(PG8_SB(1, 0), cB + kstep, voffB); PG8_STAGE(PG8_SA(1, 0), cA + kstep, voffA); PG8_STAGE(PG8_SB(1, 1), cB + hstep + kstep, voffB);
        PG8_WAIT_V(6); PG8_BAR;
    } else {
        PG8_STAGE(PG8_SB(0, 0), cB, voffB); PG8_STAGE(PG8_SA(0, 0), cA, voffA); PG8_STAGE(PG8_SB(0, 1), cB + hstep, voffB); PG8_STAGE(PG8_SA(0, 1), cA + hstep, voffA);
        if (wr == 1) PG8_BAR;
        PG8_WAIT_V(4); PG8_BAR;
        PG8_STAGE(PG8_SB(1, 0), cB + kstep, voffB); PG8_STAGE(PG8_SA(1, 0), cA + kstep, voffA); PG8_STAGE(PG8_SB(1, 1), cB + hstep + kstep, voffB);
        PG8_WAIT_V(6); PG8_BAR;
    }
    for (;;) {
        const bool has_next = S.next(ui + 1, nxt);
        const char* nA = has_next ? (const char*)g.A + (size_t)nxt.pm * tstep : cA; const char* nB = has_next ? (const char*)g.Bt + (size_t)nxt.pn * tstep : cB;
        for (int t = 0; t < nt; t += 2) {
            const bool last = (t == nt - 2);
            const char* a1 = cA + (size_t)(t + 1) * kstep;
            const char* a2 = last ? nA : cA + (size_t)(t + 2) * kstep; const char* b2 = last ? nB : cB + (size_t)(t + 2) * kstep;
            const char* a3 = a2 + kstep; const char* b3 = b2 + kstep;
            if (last && has_next) S.a_ready(nxt);
            if constexpr (SP2) {
            PG8_LDB(B0, 0, 0); PG8_LDB(B1, 0, 1); PG8_SCHED; PG8_LDA(At, 0, 0); PG8_STAGE(PG8_SA(1, 1), a1 + hstep, voffA);
            PG8_WAIT_V(8); PG8_WAIT_L(0); PG8_BAR; PG8_MMA(0, 0, At, B0); PG8_MMA(0, 1, At, B1); PG8_BAR; PG8_SCHED;
            PG8_LDA(At, 0, 1); PG8_STAGE(PG8_SB(0, 0), b2, voffB); PG8_STAGE(PG8_SB(0, 1), b2 + hstep, voffB); PG8_STAGE(PG8_SA(0, 0), a2, voffA);
            PG8_WAIT_V(8); PG8_WAIT_L(0); PG8_BAR; PG8_MMA(1, 0, At, B0); PG8_MMA(1, 1, At, B1); PG8_BAR; PG8_SCHED;
            PG8_LDB(B0, 1, 0); PG8_LDB(B1, 1, 1); PG8_SCHED; PG8_LDA(At, 1, 0); PG8_STAGE(PG8_SA(0, 1), a2 + hstep, voffA);
            PG8_WAIT_V(8); PG8_WAIT_L(0); PG8_BAR; PG8_MMA(0, 0, At, B0); PG8_MMA(0, 1, At, B1); PG8_BAR; PG8_SCHED;
            PG8_LDA(At, 1, 1); PG8_STAGE(PG8_SB(1, 0), b3, voffB); PG8_STAGE(PG8_SB(1, 1), b3 + hstep, voffB); PG8_STAGE(PG8_SA(1, 0), a3, voffA);
            PG8_WAIT_V(8); PG8_WAIT_L(0); PG8_BAR; PG8_MMA(1, 0, At, B0); PG8_MMA(1, 1, At, B1); PG8_BAR; PG8_SCHED;
            } else {
            PG8_LDB(B0, 0, 0); PG8_SCHED; PG8_LDA(At, 0, 0); PG8_STAGE(PG8_SA(1, 1), a1 + hstep, voffA);
            PG8_WAIT_L(8); PG8_BAR; PG8_WAIT_L(0); PG8_MMA(0, 0, At, B0); PG8_BAR; PG8_SCHED;
            PG8_LDB(B1, 0, 1); PG8_STAGE(PG8_SB(0, 0), b2, voffB);
            PG8_BAR; PG8_WAIT_L(0); PG8_MMA(0, 1, At, B1); PG8_BAR;
            PG8_LDA(At, 0, 1); PG8_STAGE(PG8_SA(0, 0), a2, voffA);
            PG8_BAR; PG8_WAIT_L(0); PG8_MMA(1, 0, At, B0); PG8_BAR; PG8_SCHED;
            PG8_STAGE(PG8_SB(0, 1), b2 + hstep, voffB);
            PG8_WAIT_V(6); PG8_BAR; PG8_MMA(1, 1, At, B1); PG8_BAR;
            PG8_LDB(B0, 1, 0); PG8_SCHED; PG8_LDA(At, 1, 0); PG8_STAGE(PG8_SA(0, 1), a2 + hstep, voffA);
            PG8_WAIT_L(8); PG8_BAR; PG8_WAIT_L(0); PG8_MMA(0, 0, At, B0); PG8_BAR; PG8_SCHED;
            PG8_LDB(B1, 1, 1); PG8_STAGE(PG8_SB(1, 0), b3, voffB);
            PG8_BAR; PG8_WAIT_L(0); PG8_MMA(0, 1, At, B1); PG8_BAR;
            PG8_LDA(At, 1, 1); PG8_STAGE(PG8_SA(1, 0), a3, voffA);
            PG8_BAR; PG8_WAIT_L(0); PG8_MMA(1, 0, At, B0); PG8_BAR; PG8_SCHED;
            PG8_STAGE(PG8_SB(1, 1), b3 + hstep, voffB);
            PG8_WAIT_V(6); PG8_BAR; PG8_MMA(1, 1, At, B1); PG8_BAR;
            }
        }
        if constexpr (ALIGN_EPI) { if (wr == 0) PG8_BAR; }
        if constexpr (!Epi::AFTER_DRAIN) { E(acc, cur, wr, wc, fr, fq); S.done(cur); }
        if (!has_next) break;
#pragma unroll
        for (int a = 0; a < 2; ++a)
#pragma unroll
            for (int b = 0; b < 2; ++b)
#pragma unroll
                for (int m = 0; m < 4; ++m)
#pragma unroll
                    for (int n = 0; n < 2; ++n) acc[a][b][m][n] = (f32x4){0.f, 0.f, 0.f, 0.f};
        cur = nxt; cA = nA; cB = nB; ++ui;
        if constexpr (ALIGN_EPI) { if (wr == 1) PG8_BAR; }
    }
    PG8_WAIT_V(0);
    if constexpr (!ALIGN_EPI) { if (wr == 0) PG8_BAR; }
    PG8_BAR;
    if constexpr (Epi::AFTER_DRAIN) { E.fused(acc, cur, wr, wc, fr, fq, lds, wid, lane); S.done(cur); }
#undef PG8_SA
#undef PG8_SB
#undef PG8_STAGE
#undef PG8_LDA
#undef PG8_LDB
#undef PG8_MMA
#undef PG8_WAIT_V
#undef PG8_WAIT_L
#undef PG8_BAR
#undef PG8_SCHED
}
}
#define XB_TMO      128
#define XB_XCNT(j)  (256  + 64 * (j))
#define XB_XSUB(j)  (1280 + 64 * (j))
#define XB_XGEN(j)  (2304 + 64 * (j))
#define XB_TOP      3328
#define XB_TOPGEN   3392
#define XCD_BAR_WORDS 3456
#define XB_SPIN_CAP (1u << 18)

__device__ __forceinline__ unsigned xb_ld(unsigned* p)              { return __hip_atomic_load(p, __ATOMIC_RELAXED, __HIP_MEMORY_SCOPE_AGENT); }
__device__ __forceinline__ unsigned xb_add(unsigned* p, unsigned v) { return __hip_atomic_fetch_add(p, v, __ATOMIC_RELAXED, __HIP_MEMORY_SCOPE_AGENT); }
__device__ __forceinline__ unsigned xb_xcc_id() { return (unsigned)__builtin_amdgcn_s_getreg((3 << 11) | 20) & 0xFu; }
#define XB_SPIN(cond, bar) do { unsigned _sp = 0; while (cond) { __builtin_amdgcn_s_sleep(1); \
    if ((++_sp & 255u) == 0u) { if (xb_ld(&(bar)[XB_TMO])) break; if (_sp > XB_SPIN_CAP) { atomicAdd(&(bar)[XB_TMO], 1u); break; } } } } while (0)

struct XcdBarrier {
    unsigned* bar; unsigned x;
    volatile LAS unsigned* st;
};

__device__ __forceinline__ XcdBarrier xcd_barrier_post(unsigned* bar, volatile LAS unsigned* st) {
    XcdBarrier b; b.bar = bar; b.x = xb_xcc_id(); b.st = st;
    if (threadIdx.x == 0) (void)xb_add(&bar[XB_XCNT(b.x)], 1u);
    return b;
}
__device__ __forceinline__ void xcd_barrier_complete(unsigned* bar, unsigned x, unsigned& nloc, unsigned& nx) {
    const unsigned G = gridDim.x * gridDim.y * gridDim.z;
    unsigned sum, cnt, mine, sp = 0u;
    for (;;) {
        sum = 0u; cnt = 0u; mine = 0u;
#pragma unroll
        for (unsigned j = 0; j < 16; ++j) { const unsigned c = xb_ld(&bar[XB_XCNT(j)]); sum += c; cnt += (c > 0u) ? 1u : 0u; mine = (j == x) ? c : mine; }
        if (sum == G) break;
        __builtin_amdgcn_s_sleep(1);
        if ((++sp & 255u) == 0u) { if (xb_ld(&bar[XB_TMO])) break; if (sp > XB_SPIN_CAP) { atomicAdd(&bar[XB_TMO], 1u); break; } }
    }
    nloc = mine > 0u ? mine : 1u; nx = cnt > 0u ? cnt : 1u;
}

__device__ __forceinline__ void xcd_barrier(const XcdBarrier& b) {
    asm volatile("s_waitcnt vmcnt(0)" ::: "memory");
    __syncthreads();
    if (threadIdx.x == 0) {
        unsigned* bar = b.bar;
        __builtin_amdgcn_s_waitcnt(0);
        unsigned nloc = b.st[0], nx = b.st[1];
        if (nloc == 0u) { xcd_barrier_complete(bar, b.x, nloc, nx); b.st[0] = nloc; b.st[1] = nx; }
        const unsigned old = xb_add(&bar[XB_XSUB(b.x)], 1u);
        const unsigned gen = old / nloc;
        if (old + 1u == (gen + 1u) * nloc) {
            __builtin_amdgcn_fence(__ATOMIC_RELEASE, "agent");
            asm volatile("s_waitcnt vmcnt(0)" ::: "memory");
            const unsigned og = xb_add(&bar[XB_TOP], 1u);
            const unsigned tg = og / nx;
            if (og + 1u == (tg + 1u) * nx) xb_add(&bar[XB_TOPGEN], 1u);
            else XB_SPIN(xb_ld(&bar[XB_TOPGEN]) == tg, bar);
            __builtin_amdgcn_fence(__ATOMIC_ACQUIRE, "agent");
            xb_add(&bar[XB_XGEN(b.x)], 1u);
            asm volatile("s_waitcnt vmcnt(0)" ::: "memory");
        } else {
            XB_SPIN(xb_ld(&bar[XB_XGEN(b.x)]) == gen, bar);
            __builtin_amdgcn_fence(__ATOMIC_ACQUIRE, "agent");
            asm volatile("s_waitcnt vmcnt(0)" ::: "memory");
        }
    }
    __syncthreads();
}
#include <hip/hip_bf16.h>
#include <cmath>
namespace attn_body {
using bf16=__hip_bfloat16;
using bf16x8=__attribute__((ext_vector_type(8)))short;
using s16x4=__attribute__((ext_vector_type(4)))short;
using f32x16=__attribute__((ext_vector_type(16)))float;
using u32x4=__attribute__((ext_vector_type(4)))unsigned;
constexpr int BATCH=2,NHEAD=8,SEQ=8192,D=64,DM=NHEAD*D,ODM=1024;
constexpr int NW=8,QBLK=32,QB=QBLK*NW,KVBLK=64,NQB=SEQ/QB;
constexpr int ATTN_PITCH=DM, ATTN_UNIT_ROWS=QB;
__device__ __forceinline__ int crow(int r,int hi){return (r&3)+8*(r>>2)+4*hi;}
#define SBAR() __builtin_amdgcn_sched_barrier(0)
__device__ __forceinline__ void cmask(f32x16&p0,f32x16&p1,int jb,int qrel,int hi){
  const float NEG=-INFINITY; int kb=64*jb+4*hi;
  #pragma unroll
  for(int r=0;r<16;++r){int kv=kb+(r&3)+8*(r>>2); if(kv>qrel)p0[r]=NEG; if(kv+32>qrel)p1[r]=NEG;}
}

constexpr int NSLOT=3, SLOTB=8192;
constexpr int LDS_K=0, LDS_V=NSLOT*SLOTB, LDS_WS=2*NSLOT*SLOTB, LDS_OST=LDS_WS+NW*64*4, LDS_BYTES=LDS_OST+NW*4096; constexpr int LDS_KBIAS=LDS_BYTES, LDS_KZERO=LDS_KBIAS+SEQ*8;
constexpr float C2=0.125f*1.4426950408889634f;
__device__ __forceinline__ void glds16(const void*gsrc,unsigned lds_dst){unsigned keep;
  asm volatile("s_mov_b32 %0, m0\n\ts_mov_b32 m0, %2\n\ts_nop 0\n\tglobal_load_lds_dwordx4 %1, off\n\ts_mov_b32 m0, %0":"=&s"(keep):"v"(gsrc),"s"(lds_dst):"memory");}
__device__ __forceinline__ float max3f(float a,float b,float c){float r;asm("v_max3_f32 %0, %1, %2, %3":"=v"(r):"v"(a),"v"(b),"v"(c));return r;}
__device__ __forceinline__ float max2f(float a,float b){float r;asm("v_max_f32_e32 %0, %1, %2":"=v"(r):"v"(a),"v"(b));return r;}
__device__ __forceinline__ float fadd_s(float a,float b){float r;asm("v_add_f32_e32 %0, %1, %2":"=v"(r):"v"(a),"v"(b));return r;}
__device__ __forceinline__ float fsub_s(float a,float b){float r;asm("v_sub_f32_e32 %0, %1, %2":"=v"(r):"v"(a),"v"(b));return r;}
typedef float f32x2_t __attribute__((ext_vector_type(2))); typedef float f32x4_t __attribute__((ext_vector_type(4))); typedef __bf16 bf16x2_t __attribute__((ext_vector_type(2)));
__device__ __forceinline__ unsigned cvtpk_s(float lo,float hi){f32x2_t v={lo,hi};bf16x2_t b=__builtin_convertvector(v,bf16x2_t);return __builtin_bit_cast(unsigned,b);}
#define WAIT_BAR(N) asm volatile("s_waitcnt vmcnt(" #N ") lgkmcnt(0)\n\ts_barrier":::"memory")

__device__ __forceinline__ void qkt(f32x16&p0,f32x16&p1,const char*Kslot,const bf16x8*qr,const f32x16&negm,int r32,int hi){
  const char*kb=Kslot+hi*1024+r32*16;
  #pragma unroll
  for(int d0=0;d0<4;++d0){
    const bf16x8 b0=*reinterpret_cast<const bf16x8*>(kb+d0*2048);
    const bf16x8 b1=*reinterpret_cast<const bf16x8*>(kb+d0*2048+512);
    if(d0==0){p0=__builtin_amdgcn_mfma_f32_32x32x16_bf16(b0,qr[0],negm,0,0,0);p1=__builtin_amdgcn_mfma_f32_32x32x16_bf16(b1,qr[0],negm,0,0,0);}
    else{p0=__builtin_amdgcn_mfma_f32_32x32x16_bf16(b0,qr[d0],p0,0,0,0);p1=__builtin_amdgcn_mfma_f32_32x32x16_bf16(b1,qr[d0],p1,0,0,0);}}
}
typedef __attribute__((address_space(3))) const char* lds_cptr;
typedef short v4i16_t __attribute__((ext_vector_type(4)));
__device__ __forceinline__ void kload8(bf16x8*kf,lds_cptr kp){
  kf[0]=*(const __attribute__((address_space(3))) bf16x8*)(kp);      kf[1]=*(const __attribute__((address_space(3))) bf16x8*)(kp+512);
  kf[2]=*(const __attribute__((address_space(3))) bf16x8*)(kp+2048); kf[3]=*(const __attribute__((address_space(3))) bf16x8*)(kp+2560);
  kf[4]=*(const __attribute__((address_space(3))) bf16x8*)(kp+4096); kf[5]=*(const __attribute__((address_space(3))) bf16x8*)(kp+4608);
  kf[6]=*(const __attribute__((address_space(3))) bf16x8*)(kp+6144); kf[7]=*(const __attribute__((address_space(3))) bf16x8*)(kp+6656);
}
__device__ __forceinline__ void kload2(bf16x8*kf,lds_cptr kp,int j){ kf[2*j]=*(const __attribute__((address_space(3))) bf16x8*)(kp+j*2048); kf[2*j+1]=*(const __attribute__((address_space(3))) bf16x8*)(kp+j*2048+512); }
__device__ __forceinline__ s16x4 vtr(lds_cptr p){ return __builtin_bit_cast(s16x4,__builtin_amdgcn_ds_read_tr16_b64_v4i16((__attribute__((address_space(3))) v4i16_t*)p)); }
__device__ __forceinline__ float rowmax(const f32x16&p0,const f32x16&p1){
  float a=max3f(p0[0],p0[1],p1[0]),b=max3f(p0[2],p0[3],p1[1]);a=max3f(a,p1[2],p1[3]);
  #pragma unroll
  for(int r=4;r<16;r+=4){a=max3f(a,p0[r],p0[r+1]);b=max3f(b,p0[r+2],p0[r+3]);a=max3f(a,p1[r],p1[r+1]);b=max3f(b,p1[r+2],p1[r+3]);}
  const float m=max2f(a,b);
  auto rr=__builtin_amdgcn_permlane32_swap(__float_as_uint(m),__float_as_uint(m),false,false);
  return max2f(__uint_as_float(rr[0]),__uint_as_float(rr[1]));
}
__device__ __forceinline__ void pv(f32x16*o,int vb,bf16x8 pa0,bf16x8 pa1,bf16x8 pa2,bf16x8 pa3){
  #pragma unroll
  for(int d0=0;d0<2;++d0){s16x4 lo[4],hi[4];
    #pragma unroll
    for(int ks=0;ks<4;++ks){
      asm volatile("ds_read_b64_tr_b16 %0,%1 offset:%c2":"=&v"(lo[ks]):"v"(vb),"i"(d0*4096+ks*1024):"memory");
      asm volatile("ds_read_b64_tr_b16 %0,%1 offset:%c2":"=&v"(hi[ks]):"v"(vb),"i"(d0*4096+ks*1024+512):"memory");}
    asm volatile("s_waitcnt lgkmcnt(0)":::"memory");SBAR();
    #define PK(k) (bf16x8){lo[k][0],lo[k][1],lo[k][2],lo[k][3],hi[k][0],hi[k][1],hi[k][2],hi[k][3]}
    o[d0]=__builtin_amdgcn_mfma_f32_32x32x16_bf16(pa0,PK(0),o[d0],0,0,0);
    o[d0]=__builtin_amdgcn_mfma_f32_32x32x16_bf16(pa1,PK(1),o[d0],0,0,0);
    o[d0]=__builtin_amdgcn_mfma_f32_32x32x16_bf16(pa2,PK(2),o[d0],0,0,0);
    o[d0]=__builtin_amdgcn_mfma_f32_32x32x16_bf16(pa3,PK(3),o[d0],0,0,0);
    #undef PK
  }
}

#ifndef ATTN_STORE16
#define ATTN_STORE16(p,v) (*(u32x4*)(p)=(v))
#endif
template<int THRL> __device__ __forceinline__ void attn_unit(int b,int h,int qb,const bf16*Q,const bf16*__restrict__ K,const bf16*__restrict__ V,bf16*O,const float*__restrict__ CUM,const float*__restrict__ KN,const float*__restrict__ QN,char*shm){
  int tid_=threadIdx.x; asm volatile("":"+v"(tid_));
  const int tid=tid_,lane=tid&63,r32=lane&31,hi=lane>>5; const int wid=__builtin_amdgcn_readfirstlane(tid>>6);
  const long rowbase=(long)b*SEQ; const int q0=qb*QB;
  const bf16*Qw=Q+(rowbase+q0+wid*QBLK)*DM+h*D;
  const int NTF=(q0+QB)/KVBLK; int t0;
  { const float*cb=CUM+(long)(b*NHEAD+h)*SEQ; const float*kn=KN+(b*NHEAD+h)*(SEQ/KVBLK); const float*qn=QN+(b*NHEAD+h)*(SEQ/KVBLK); const float cref=cb[q0];
    const float kd=fmaxf(fmaxf(kn[NTF-4],kn[NTF-3]),fmaxf(kn[NTF-2],kn[NTF-1])), qm=1.01f*fmaxf(fmaxf(qn[NTF-4],qn[NTF-3]),fmaxf(qn[NTF-2],qn[NTF-1]));
    const int nb_=NTF-4, j0=lane, j1=lane+64; bool ok0=false, ok1=false;
    if(j0<nb_) ok0=((cref-cb[64*j0+63])*1.4426950408889634f+qm*(kn[j0]+kd)+1.0f<=-64.0f);
    if(j1<nb_) ok1=((cref-cb[64*j1+63])*1.4426950408889634f+qm*(kn[j1]+kd)+1.0f<=-64.0f);
    const unsigned long long m0=__ballot(!ok0), m1=__ballot(!ok1);
    const int f_=m0?__builtin_ctzll(m0):(m1?64+__builtin_ctzll(m1):128);
    t0=__builtin_amdgcn_readfirstlane((f_<nb_?f_:nb_)&~1); }
  const bf16*Kh=K+(rowbase+(long)t0*KVBLK)*DM+h*D,*Vh=V+(rowbase+(long)t0*KVBLK)*DM+h*D;
  const unsigned lds0=(unsigned)(uintptr_t)shm;
  float*wsf=(float*)(shm+LDS_WS)+wid*64;
  const bf16*ksrc=Kh+(long)lane*DM+wid*8;
  const bf16*vsrc=Vh+(long)(16*(wid&3)+(lane>>2))*DM+(wid>>2)*32+(lane&3)*8;
  const unsigned kdst=lds0+LDS_K+wid*1024, vdst=lds0+LDS_V+wid*1024;
  #define DMA_K(t,slot) glds16(ksrc+(long)(t)*KVBLK*DM,(unsigned)__builtin_amdgcn_readfirstlane(kdst+(slot)))
  #define DMA_V(t,slot) glds16(vsrc+(long)(t)*KVBLK*DM,(unsigned)__builtin_amdgcn_readfirstlane(vdst+(slot)))
  const int vb0=(int)(lds0+LDS_V)+((lane>>4)&1)*32+(lane&3)*8+(4*hi+((lane&15)>>2))*64;
  const char*Kbase=shm+LDS_K; bf16x8 kf[8];
  const lds_cptr shm3=(lds_cptr)shm; const lds_cptr kp0=shm3+LDS_K+hi*1024+r32*16; const lds_cptr vp0=shm3+LDS_V+((lane>>4)&1)*32+(lane&3)*8+(4*hi+((lane&15)>>2))*64;
  const int NT=NTF-t0;
  { const float*cb=CUM+(long)(b*NHEAD+h)*SEQ; const float cref=cb[q0];
    __attribute__((address_space(3))) unsigned long long*kbw=(__attribute__((address_space(3))) unsigned long long*)((__attribute__((address_space(3))) char*)shm+LDS_KBIAS);
    float cv_[16];
    _Pragma("unroll") for(int j=0;j<16;++j){ const int i=tid+NW*64*j; cv_[j]=(i<NT*KVBLK)?cb[i+t0*KVBLK]:cref; }
    _Pragma("unroll") for(int j=0;j<16;++j){ const int i=tid+NW*64*j; if(i<NT*KVBLK){ const float bv=(cref-cv_[j])*1.4426950408889634f;
      const unsigned hb=__float_as_uint(bv)&0xffff0000u; const float r1=bv-__uint_as_float(hb); const unsigned mb=__float_as_uint(r1)&0xffff0000u; const float r2=r1-__uint_as_float(mb);
      const unsigned lb=__float_as_uint(r2)>>16; kbw[i]=(unsigned long long)((hb>>16)|mb)|((unsigned long long)lb<<32); } }
    if(tid==0)kbw[SEQ]=0ull; }
  const __attribute__((address_space(3))) unsigned long long* kaug_p=(const __attribute__((address_space(3))) unsigned long long*)((lds_cptr)shm+(hi?LDS_KZERO:LDS_KBIAS+r32*8));
  const int kaug_s=hi?0:KVBLK, kaug_h=hi?0:32;
  bf16x8 qaug; { u32x4 qa_={0x3f803f80u,0x00003f80u,0u,0u}; asm volatile("":"+v"(qa_)); qaug=__builtin_bit_cast(bf16x8,qa_); }
  #define KAUG(t,half) __builtin_bit_cast(bf16x8,(u32x4){(unsigned)kaug_p[(t)*kaug_s+(half)*kaug_h],(unsigned)(kaug_p[(t)*kaug_s+(half)*kaug_h]>>32),0u,0u})
  DMA_K(0,0);DMA_V(0,0);DMA_K(1,SLOTB);
  bf16x8 qr[4];
  #pragma unroll
  for(int d0=0;d0<4;++d0)qr[d0]=*reinterpret_cast<const bf16x8*>(&Qw[(long)r32*DM+d0*16+hi*8]);
  float zz_; asm volatile("v_mov_b32 %0, 0":"=v"(zz_));
  float mhat=0.f,l_reg=0.f;f32x16 o[2],negm;
  _Pragma("unroll") for(int r=0;r<16;++r){o[0][r]=zz_;o[1][r]=zz_;negm[r]=zz_;} asm volatile("":"+v"(negm));
  const int qrel=wid*QBLK+r32;
  #define CMASK(P0,P1,t) do{int jb_=(t)-(NT-4); if(jb_>=0)cmask(P0,P1,jb_,qrel,hi);}while(0)
  bool resc=false;
  #define START(P0,P1) do{ const float rm=rowmax(P0,P1); resc=false; \
    { const float dl=rm; mhat=fadd_s(mhat,dl); \
      _Pragma("unroll") for(int r=0;r<16;++r){P0[r]=fsub_s(P0[r],dl);P1[r]=fsub_s(P1[r],dl);} \
      _Pragma("unroll") for(int r=0;r<16;++r)negm[r]=-mhat; asm volatile("":"+v"(negm)); } \
    _Pragma("unroll") for(int r=0;r<16;++r)P0[r]=__builtin_amdgcn_exp2f(P0[r]); }while(0)
  #define RESC() do{ if(resc){ asm volatile("s_waitcnt lgkmcnt(0)":::"memory"); \
      _Pragma("unroll") for(int d_=0;d_<2;++d_) _Pragma("unroll") for(int r=0;r<16;++r)o[d_][r]*=wsf[crow(r,hi)]; } }while(0)
  f32x16 pA0,pA1,pB0,pB1;
  int sl_prev=0,sl_cur=0,sl_next=SLOTB;
  #define ROT() do{sl_prev=sl_cur;sl_cur=sl_next;sl_next=(sl_next==(NSLOT-1)*SLOTB)?0:sl_next+SLOTB;}while(0)
  DMA_K(2,2*SLOTB);
  WAIT_BAR(3);
  qkt(pA0,pA1,Kbase,qr,negm,r32,hi);{const bf16x8 ka0_=KAUG(0,0),ka1_=KAUG(0,1);pA0=__builtin_amdgcn_mfma_f32_32x32x16_bf16(ka0_,qaug,pA0,0,0,0);pA1=__builtin_amdgcn_mfma_f32_32x32x16_bf16(ka1_,qaug,pA1,0,0,0);}asm volatile("s_nop 15\n\ts_nop 7":"+v"(pA0),"+v"(pA1));CMASK(pA0,pA1,0);
  START(pA0,pA1);
  _Pragma("unroll") for(int r=0;r<16;++r)pA1[r]=__builtin_amdgcn_exp2f(pA1[r]);
  WAIT_BAR(0);
  DMA_K(3,0);DMA_V(1,SLOTB);
  ROT();
  kload8(kf,kp0+sl_cur);
  WAIT_BAR(2);
  s16x4 vlo[8],vhi[8]; u32x4 pw0,pw1,pw2,pw3;
  #define PKW(P,B) cvtpk_s(P[B],P[B+1])
  #define PAF(k) __builtin_bit_cast(bf16x8,pw##k)
  #define VFR(i) (bf16x8){vlo[i][0],vlo[i][1],vlo[i][2],vlo[i][3],vhi[i][0],vhi[i][1],vhi[i][2],vhi[i][3]}
  #define PIN(x) asm volatile("":"+v"(x))
  #define MX3(a,b,c) __builtin_fmaxf(__builtin_fmaxf((a),(b)),(c))
  #define GAPA(MF,A0,A1,A2,A3,W0,W1,PW) do{ MF; sacc+=A0; sacc+=A1; sacc+=A2; sacc+=A3; PIN(sacc); W0; W1; PIN(PW); SBAR(); }while(0)
  #define EX(v) __builtin_amdgcn_exp2f(v)
  #define GAPB(MF,X,B) do{ MF; X[B]=EX(X[B]); X[B+1]=EX(X[B+1]); X[B+2]=EX(X[B+2]); X[B+3]=EX(X[B+3]); PIN(X); SBAR(); }while(0)
  #define VRD(i) do{ vlo[i]=vtr(vp_+(((i)>>2)*4096+((i)&3)*1024)); vhi[i]=vtr(vp_+(((i)>>2)*4096+((i)&3)*1024+512)); }while(0)
  #define KRD(G,j) do{ if(G){ kload2(kf,kp0+sl_next,j); SBAR(); } }while(0)
  #define STEP(C0,C1,P0,P1,t,GK,GV,GL) do{ SBAR(); \
    const lds_cptr vp_=vp0+sl_prev; \
    const bf16x8 ka0_=KAUG(t,0),ka1_=KAUG(t,1); VRD(0); SBAR(); float sacc=(P0[0]+P0[1]); \
    GAPA(C0=__builtin_amdgcn_mfma_f32_32x32x16_bf16(kf[0],qr[0],negm,0,0,0), P0[2],P0[3],P0[4],P0[5],     pw0[0]=PKW(P0,0), pw0[1]=PKW(P0,2), pw0); \
    VRD(4); SBAR(); GAPA(C1=__builtin_amdgcn_mfma_f32_32x32x16_bf16(kf[1],qr[0],negm,0,0,0), P0[6],P0[7],P0[8],P0[9],     pw0[2]=PKW(P0,4), pw0[3]=PKW(P0,6), pw0); \
    VRD(1); SBAR(); GAPA(C0=__builtin_amdgcn_mfma_f32_32x32x16_bf16(kf[2],qr[1],C0,0,0,0),   P0[10],P0[11],P0[12],P0[13], pw1[0]=PKW(P0,8), pw1[1]=PKW(P0,10), pw1); \
    VRD(5); SBAR(); GAPA(C1=__builtin_amdgcn_mfma_f32_32x32x16_bf16(kf[3],qr[1],C1,0,0,0),   P0[14],P0[15],P1[0],P1[1],   pw1[2]=PKW(P0,12),pw1[3]=PKW(P0,14), pw1); \
    VRD(2); SBAR(); GAPA(C0=__builtin_amdgcn_mfma_f32_32x32x16_bf16(kf[4],qr[2],C0,0,0,0),   P1[2],P1[3],P1[4],P1[5],     pw2[0]=PKW(P1,0), pw2[1]=PKW(P1,2), pw2); \
    VRD(6); SBAR(); GAPA(C1=__builtin_amdgcn_mfma_f32_32x32x16_bf16(kf[5],qr[2],C1,0,0,0),   P1[6],P1[7],P1[8],P1[9],     pw2[2]=PKW(P1,4), pw2[3]=PKW(P1,6), pw2); \
    VRD(3); SBAR(); GAPA(C0=__builtin_amdgcn_mfma_f32_32x32x16_bf16(kf[6],qr[3],C0,0,0,0),   P1[10],P1[11],P1[12],P1[13], pw3[0]=PKW(P1,8), pw3[1]=PKW(P1,10), pw3); \
    VRD(7); SBAR(); GAPA(C1=__builtin_amdgcn_mfma_f32_32x32x16_bf16(kf[7],qr[3],C1,0,0,0),   P1[14],P1[15],0.f,0.f,       pw3[2]=PKW(P1,12),pw3[3]=PKW(P1,14), pw3); \
    C0=__builtin_amdgcn_mfma_f32_32x32x16_bf16(ka0_,qaug,C0,0,0,0); C1=__builtin_amdgcn_mfma_f32_32x32x16_bf16(ka1_,qaug,C1,0,0,0); SBAR(); \
    l_reg+=sacc; \
    if(GK){DMA_K((t)+3,sl_cur);} if(GV){DMA_V((t)+1,sl_next);} \
    CMASK(C0,C1,t); \
    { float a=MX3(C0[0],C0[1],C1[0]),b=MX3(C0[2],C0[3],C1[1]); a=MX3(a,C1[2],C1[3]); \
      _Pragma("unroll") for(int r=4;r<16;r+=4){a=MX3(a,C0[r],C0[r+1]);b=MX3(b,C0[r+2],C0[r+3]);a=MX3(a,C1[r],C1[r+1]);b=MX3(b,C1[r+2],C1[r+3]);} \
      float rm=__builtin_fmaxf(a,b); { auto rr=__builtin_amdgcn_permlane32_swap(__float_as_uint(rm),__float_as_uint(rm),false,false); rm=__builtin_fmaxf(__uint_as_float(rr[0]),__uint_as_float(rr[1])); } \
      resc=false; \
      if(__builtin_expect(__any(rm>(float)THRL),0)){ const float dl=__builtin_fmaxf(rm,0.f); mhat+=dl; \
        _Pragma("unroll") for(int r=0;r<16;++r){C0[r]-=dl;C1[r]-=dl;} \
        _Pragma("unroll") for(int r=0;r<16;++r)negm[r]=-mhat; asm volatile("":"+v"(negm)); \
        const float f=__builtin_amdgcn_exp2f(-dl); l_reg*=f; if(hi==0)wsf[r32]=f; resc=true; } } \
    SBAR(); \
    GAPB(o[0]=__builtin_amdgcn_mfma_f32_32x32x16_bf16(PAF(0),VFR(0),o[0],0,0,0), C0,0); \
    GAPB(o[1]=__builtin_amdgcn_mfma_f32_32x32x16_bf16(PAF(0),VFR(4),o[1],0,0,0), C0,4); \
    KRD(GL,0); GAPB(o[0]=__builtin_amdgcn_mfma_f32_32x32x16_bf16(PAF(1),VFR(1),o[0],0,0,0), C0,8); \
    KRD(GL,1); GAPB(o[1]=__builtin_amdgcn_mfma_f32_32x32x16_bf16(PAF(1),VFR(5),o[1],0,0,0), C0,12); \
    KRD(GL,2); GAPB(o[0]=__builtin_amdgcn_mfma_f32_32x32x16_bf16(PAF(2),VFR(2),o[0],0,0,0), C1,0); \
    KRD(GL,3); GAPB(o[1]=__builtin_amdgcn_mfma_f32_32x32x16_bf16(PAF(2),VFR(6),o[1],0,0,0), C1,4); \
    GAPB(o[0]=__builtin_amdgcn_mfma_f32_32x32x16_bf16(PAF(3),VFR(3),o[0],0,0,0), C1,8); \
    GAPB(o[1]=__builtin_amdgcn_mfma_f32_32x32x16_bf16(PAF(3),VFR(7),o[1],0,0,0), C1,12); \
    }while(0)
  int t=1;
  #undef CMASK
  #define CMASK(P0,P1,t) do{}while(0)
  for(;t+5<NT;t+=2){
    STEP(pB0,pB1,pA0,pA1,t,true,true,true);     WAIT_BAR(2); RESC(); ROT();
    STEP(pA0,pA1,pB0,pB1,t+1,true,true,true);   WAIT_BAR(2); RESC(); ROT();
  }
  #undef CMASK
  #define CMASK(P0,P1,t) do{int jb_=(t)-(NT-4); if(jb_>=0)cmask(P0,P1,jb_,qrel,hi);}while(0)
  #define ENDW(tt) do{ if((tt)+3<NT){WAIT_BAR(2);} else if((tt)+2<NT){WAIT_BAR(1);} else {WAIT_BAR(0);} }while(0)
  for(;t+1<NT;t+=2){
    STEP(pB0,pB1,pA0,pA1,t,(t+3<NT),(t+1<NT),(t+1<NT));       ENDW(t);   RESC(); ROT();
    STEP(pA0,pA1,pB0,pB1,t+1,(t+4<NT),(t+2<NT),(t+2<NT));     ENDW(t+1); RESC(); ROT();
  }
  STEP(pB0,pB1,pA0,pA1,NT-1,false,false,false); RESC();
  { float sacc=pB0[0]+pB0[1]; _Pragma("unroll") for(int r=2;r<16;++r)sacc+=pB0[r]; _Pragma("unroll") for(int r=0;r<16;++r)sacc+=pB1[r]; l_reg+=sacc;
    pw0=(u32x4){PKW(pB0,0),PKW(pB0,2),PKW(pB0,4),PKW(pB0,6)};pw1=(u32x4){PKW(pB0,8),PKW(pB0,10),PKW(pB0,12),PKW(pB0,14)};pw2=(u32x4){PKW(pB1,0),PKW(pB1,2),PKW(pB1,4),PKW(pB1,6)};pw3=(u32x4){PKW(pB1,8),PKW(pB1,10),PKW(pB1,12),PKW(pB1,14)};
    SBAR(); pv(o,vb0+sl_cur,PAF(0),PAF(1),PAF(2),PAF(3)); }
  #undef PKW
  #undef PAF
  #undef VFR
  #undef PIN
  #undef MX3
  #undef GAPA
  #undef GAPB
  #undef EX
  #undef VRD
  #undef KRD
  #undef STEP
  #undef ENDW
  {auto rr=__builtin_amdgcn_permlane32_swap(__float_as_uint(l_reg),__float_as_uint(l_reg),false,false);l_reg=__uint_as_float(rr[0])+__uint_as_float(rr[1]);}
  if(hi==0)wsf[32+r32]=l_reg;asm volatile("s_waitcnt lgkmcnt(0)":::"memory");
  float rli[16];
  #pragma unroll
  for(int r=0;r<16;++r)rli[r]=__builtin_amdgcn_rcpf(wsf[32+crow(r,hi)]);
  bf16*Ow=O+(rowbase+q0+wid*QBLK)*ODM+h*D;
  { bf16*stg=(bf16*)(shm+LDS_OST)+wid*2048;
    #pragma unroll
    for(int r=0;r<16;++r){const int orow=crow(r,hi);
      #pragma unroll
      for(int d0=0;d0<2;++d0)stg[orow*64+d0*32+r32]=__float2bfloat16(o[d0][r]*rli[r]);}
    asm volatile("s_waitcnt lgkmcnt(0)":::"memory");
    #pragma unroll
    for(int i=0;i<4;++i){const int row=i*8+(lane>>3),ch=lane&7; const u32x4 v=*(const u32x4*)(stg+row*64+ch*8); ATTN_STORE16(Ow+(long)row*ODM+ch*8,v);} }
  asm volatile("s_waitcnt lgkmcnt(0)\n\ts_barrier":::"memory");
  #undef DMA_K
  #undef DMA_V
  #undef CMASK
  #undef KAUG
  #undef START
  #undef RESC
  #undef ROT
}
constexpr int ATTN_LDS_BYTES=LDS_BYTES+SEQ*8+16;
struct AttnTensors { const bf16* Q; const bf16* K; const bf16* V; bf16* O; const float* CUM; const float* KN; const float* QN; };
struct AttnUnit { int bh; int qb; };
struct StaticOrder {
  int vcu, G;
  __device__ __forceinline__ explicit StaticOrder(int grid,int block):vcu((grid%8==0)?(block%8)*(grid/8)+block/8:block),G(grid){}
  __device__ __forceinline__ bool next(int i,AttnUnit&u)const{ const int pair=vcu+(i>>1)*G; if(pair>=BATCH*NHEAD*(NQB/2))return false; const int s=pair&15; u.bh=pair>>4; u.qb=(i&1)?(NQB-1-s):s; return true; }
  __device__ __forceinline__ void a_ready(const AttnUnit&)const{}
  __device__ __forceinline__ void done(const AttnUnit&)const{}
};
template<class Sched,int THRL=8> __device__ __forceinline__ void attn_phase(char*lds,const AttnTensors&T,const Sched&S){
  AttnUnit u;
  for(int i=0;S.next(i,u);++i){ S.a_ready(u); attn_unit<THRL>(u.bh/NHEAD,u.bh%NHEAD,u.qb,T.Q,T.K,T.V,T.O,T.CUM,T.KN,T.QN,lds); S.done(u); }
}
#undef SBAR
#undef WAIT_BAR
}
constexpr int DM = 1024, SEQ = 8192, NBATCH = 2, MP = NBATCH * SEQ, DB = 128, DSQ = 4, MS = DB * DSQ, MT = MP + MS;
constexpr int NMEM = 256, MMEM = NBATCH * NMEM;
constexpr int HATT = 8, HD = 64, DATT = 512, HSSM = 8, PS = 64, NST = 128, DSSM = 512, CONVCH = 1024, DFF = 2816, INCOLS = 3088, HX = 4, HDX = 256;
constexpr int NPAGES = 16, PAGE = 128, PAST = 2048;
constexpr float EPS = 1e-6f, LOG2E = 1.4426950408889634f;
constexpr float C2 = 0.125f * LOG2E;
constexpr float XC2 = 0.0625f * LOG2E;
constexpr size_t OFF_YP = 0, OFF_YS = OFF_YP + (size_t)MP * DM, OFF_KP = OFF_YS + (size_t)MS * DM, OFF_VP = OFF_KP + (size_t)MP * DATT, OFF_FP = OFF_VP + (size_t)MP * DATT,
                 OFF_MKP = OFF_FP + (size_t)MP * HATT, OFF_MVP = OFF_MKP + (size_t)MMEM * DM, OFF_CP = OFF_MVP + (size_t)MMEM * DM, OFF_SP = OFF_CP + (size_t)NBATCH * 3 * CONVCH,
                 OFF_KS = OFF_SP + (size_t)NBATCH * HSSM * PS * NST, OFF_VS = OFF_KS + (size_t)MS * DATT, OFF_FS = OFF_VS + (size_t)MS * DATT, OFF_CS = OFF_FS + (size_t)MS * HATT,
                 OFF_SS = OFF_CS + (size_t)DB * 3 * CONVCH, OUT_TOTAL = OFF_SS + (size_t)DB * HSSM * PS * NST;
static_assert(OUT_TOTAL == 44705792, "output size");
constexpr size_t MiB = 1u << 20;
constexpr size_t WS_CTL = 0, CTL_ZERO_BYTES = 1 * MiB;
constexpr int CW_BAR = 4096;
constexpr int CW_AQ = 8192;
constexpr size_t WS_SS1 = 256 * 1024, WS_SS2 = 384 * 1024, WS_SS3 = 512 * 1024;
constexpr size_t WS_WIN = 2 * MiB, WS_WOUT = 8 * MiB, WS_WCQ = 10 * MiB, WS_WCO = 12 * MiB, WS_WCKV = 14 * MiB, WS_WGU = 18 * MiB, WS_WD = 29 * MiB;
constexpr size_t WS_SS0 = 35 * MiB, WS_SSM = 35 * MiB + 128 * 1024, WS_LOGF = 36 * MiB, WS_DT = 37 * MiB, WS_AA = 38 * MiB, WS_CUM = 39 * MiB;
constexpr size_t WS_XB = 40 * MiB, WS_MB = 74 * MiB, WS_Q = 76 * MiB, WS_K = 93 * MiB, WS_V = 110 * MiB, WS_Z = 127 * MiB, WS_XBC = 144 * MiB, WS_ACT = 178 * MiB, WS_Y = 244 * MiB;
constexpr size_t WS_MIX = 278 * MiB, WS_X = 312 * MiB, WS_QC = 378 * MiB, WS_OC = 412 * MiB, WS_U = 446 * MiB, WS_MK = 538 * MiB, WS_MV = 539 * MiB, WS_END = 540 * MiB;
static_assert(WS_SS3 + (size_t)MT * 4 <= CTL_ZERO_BYTES && (CW_BAR + 3456) * 4 <= (int)WS_SS1, "ctl map");
static_assert(WS_XB + (size_t)MT * DM * 2 <= WS_MB && WS_Q + (size_t)MT * DATT * 2 <= WS_K && WS_XBC + (size_t)MT * DM * 2 <= WS_ACT && WS_ACT + (size_t)MT * DM * 4 <= WS_Y && WS_Y + (size_t)MT * DSSM * 4 <= WS_MIX, "ws map 1");
static_assert(WS_MIX + (size_t)MT * DM * 2 <= WS_X && WS_X + (size_t)MT * DM * 4 <= WS_QC && WS_QC + (size_t)MT * DM * 2 <= WS_OC && WS_OC + (size_t)MT * DM * 2 <= WS_U && WS_U + (size_t)MT * DFF * 2 <= WS_MK, "ws map 2");
static_assert(WS_WGU + (size_t)2 * DFF * DM * 2 <= WS_WD && WS_WD + (size_t)DM * DFF * 2 <= WS_SS0 && WS_WIN + (size_t)3072 * DM * 2 <= WS_WOUT && WS_WCKV + (size_t)2048 * DM * 2 <= WS_WGU, "ws map 3");
constexpr int LDS_BYTES = 163840, LDSCTL_OFF = LDS_BYTES - 512, MISC_OFF = LDSCTL_OFF + 320;
constexpr int NWAVES = 8, NTHREADS = 512;
#ifndef MK_ONE_LAUNCH
#define MK_ONE_LAUNCH 1
#endif
constexpr int NPH = 12;

struct Args { const void* in[32]; float* out; unsigned char* ws; int ph_lo, ph_hi; };

__device__ __forceinline__ float bf2f(unsigned short h) { return __uint_as_float((unsigned)h << 16); }
__device__ __forceinline__ float wave_sum(float v) {
#pragma unroll
    for (int o = 1; o < 64; o <<= 1) v += __shfl_xor(v, o);
    return v;
}
__device__ __forceinline__ float wave_max(float v) {
#pragma unroll
    for (int o = 1; o < 64; o <<= 1) v = fmaxf(v, __shfl_xor(v, o));
    return v;
}
__device__ __forceinline__ v4u pack8(f32x4 a, f32x4 b) { v4u w; w.x = pk2(a[0], a[1]); w.y = pk2(a[2], a[3]); w.z = pk2(b[0], b[1]); w.w = pk2(b[2], b[3]); return w; }
__device__ __forceinline__ float rstd_of(float ss, int n) { return rsqrtf(ss * (1.0f / (float)n) + EPS); }

struct FInproj {
    const float* ss0; bf16 *Qb, *Kb, *Vb, *Zb, *XBCb; float* out;
    struct Pre { float s; };
    __device__ __forceinline__ void prefetch(int row, int, Pre& p) const { p.s = ss0[row]; }
    __device__ __forceinline__ void operator()(int row, int col0, f32x4 v0, f32x4 v1) const { Pre p; prefetch(row, col0, p); apply(row, col0, v0, v1, p); }
    __device__ __forceinline__ void apply(int row, int col0, f32x4 v0, f32x4 v1, const Pre& p) const {
        const float rs = rstd_of(p.s, DM); v0 = v0 * rs; v1 = v1 * rs;
        if (col0 < 512) { *(v4u*)(Qb + (size_t)row * DATT + col0) = pack8(v0 * C2, v1 * C2); }
        else if (col0 < 1536) {
            const bool isk = col0 < 1024; const int c = col0 - (isk ? 512 : 1024);
            *(v4u*)((isk ? Kb : Vb) + (size_t)row * DATT + c) = pack8(v0, v1);
            float* o = out + (row < MP ? (isk ? OFF_KP : OFF_VP) + (size_t)row * DATT : (isk ? OFF_KS : OFF_VS) + (size_t)(row - MP) * DATT) + c;
            *(f32x4*)o = v0; *(f32x4*)(o + 4) = v1;
        } else if (col0 < 2048) { *(v4u*)(Zb + (size_t)row * DSSM + (col0 - 1536)) = pack8(v0, v1); }
        else {
            const int c = col0 - 2048; *(v4u*)(XBCb + (size_t)row * CONVCH + c) = pack8(v0, v1);
            float* o = nullptr;
            if (row < MP) { const int t = row & (SEQ - 1); if (t >= SEQ - 3) o = out + OFF_CP + ((size_t)(row >> 13) * 3 + (t - (SEQ - 3))) * CONVCH + c; }
            else { const int s = row - MP, t = s & 3; if (t >= 1) o = out + OFF_CS + ((size_t)(s >> 2) * 3 + (t - 1)) * CONVCH + c; }
            if (o) { *(f32x4*)o = v0; *(f32x4*)(o + 4) = v1; }
        }
    }
};
struct FMemKV {
    const float* ssm; bf16 *MKb, *MVb; float* out;
    __device__ __forceinline__ void operator()(int row, int col0, f32x4 v0, f32x4 v1) const {
        const float rs = rstd_of(ssm[row], DM); v0 = v0 * rs; v1 = v1 * rs;
        const bool isk = col0 < 1024; const int c = isk ? col0 : col0 - 1024;
        if (isk) *(v4u*)(MKb + (size_t)row * DM + c) = pack8(v0, v1);
        else { bf16* vt = MVb + (((size_t)(row >> 8) * HX + (c >> 8)) * HDX + (c & 255)) * NMEM + (row & 255);
#pragma unroll
            for (int i = 0; i < 4; ++i) { vt[(size_t)i * NMEM] = (bf16)f2bf(v0[i]); vt[(size_t)(i + 4) * NMEM] = (bf16)f2bf(v1[i]); } }
        float* o = out + (isk ? OFF_MKP : OFF_MVP) + (size_t)row * DM + c; *(f32x4*)o = v0; *(f32x4*)(o + 4) = v1;
    }
};
struct FRes {
    const float* xin_p; const float* xin_s; bf16* XB; float* SS;
    struct Pre { f32x4 a, b; };
    __device__ __forceinline__ void prefetch(int row, int col0, Pre& p) const {
        if (xin_p) { const float* src = (row < MP ? xin_p + (size_t)row * DM : xin_s + (size_t)(row - MP) * DM) + col0; p.a = *(const f32x4*)src; p.b = *(const f32x4*)(src + 4); }
        else { const v4u w = *(const v4u*)(XB + (size_t)row * DM + col0);
            p.a = (f32x4){__uint_as_float(w.x << 16), __uint_as_float(w.x & 0xffff0000u), __uint_as_float(w.y << 16), __uint_as_float(w.y & 0xffff0000u)};
            p.b = (f32x4){__uint_as_float(w.z << 16), __uint_as_float(w.z & 0xffff0000u), __uint_as_float(w.w << 16), __uint_as_float(w.w & 0xffff0000u)}; } }
    __device__ __forceinline__ void operator()(int row, int col0, f32x4 v0, f32x4 v1) const { Pre p; prefetch(row, col0, p); apply(row, col0, v0, v1, p); }
    __device__ __forceinline__ void apply(int row, int col0, f32x4 v0, f32x4 v1, const Pre& p) const {
        const f32x4 x0 = p.a + v0, x1 = p.b + v1;
        *(v4u*)(XB + (size_t)row * DM + col0) = pack8(x0, x1);
        float q = (x0[0] * x0[0] + x0[1] * x0[1]) + (x0[2] * x0[2] + x0[3] * x0[3]) + (x1[0] * x1[0] + x1[1] * x1[1]) + (x1[2] * x1[2] + x1[3] * x1[3]);
        q += __shfl_xor(q, 16); q += __shfl_xor(q, 32);
        if (((threadIdx.x & 63) >> 4) == 0) __hip_atomic_fetch_add(SS + row, q, __ATOMIC_RELAXED, __HIP_MEMORY_SCOPE_AGENT);
    }
};
struct FScaleBf16 {
    const float* ss; bf16* dst; float scale;
    struct Pre { float s; };
    __device__ __forceinline__ void prefetch(int row, int, Pre& p) const { p.s = ss[row]; }
    __device__ __forceinline__ void operator()(int row, int col0, f32x4 v0, f32x4 v1) const { Pre p; prefetch(row, col0, p); apply(row, col0, v0, v1, p); }
    __device__ __forceinline__ void apply(int row, int col0, f32x4 v0, f32x4 v1, const Pre& p) const {
        const float rs = rstd_of(p.s, DM) * scale; *(v4u*)(dst + (size_t)row * DM + col0) = pack8(v0 * rs, v1 * rs);
    }
};
__device__ __forceinline__ float silu_f(float x) { return x / (1.0f + __expf(-x)); }
struct FGateUp {
    const float* ss; bf16* U;
    struct Pre { float s; };
    __device__ __forceinline__ void prefetch(int row, int, Pre& p) const { p.s = ss[row]; }
    __device__ __forceinline__ void apply(int row, int col0, f32x4 g0, f32x4 g1, f32x4 u0, f32x4 u1, const Pre& p) const {
        const float rs = rstd_of(p.s, DM); f32x4 a, b;
#pragma unroll
        for (int i = 0; i < 4; ++i) { a[i] = silu_f(g0[i] * rs) * (u0[i] * rs); b[i] = silu_f(g1[i] * rs) * (u1[i] * rs); }
        *(v4u*)(U + (size_t)row * DFF + col0) = pack8(a, b);
    }
};

__device__ __forceinline__ void transpose_item(const float* W, int ldw, int src_col0, int k0, bf16* WT, int K, int dst_row0, const float* gk, LAS float* scr, int lane) {
    float tv[32];
#pragma unroll
    for (int i = 0; i < 32; ++i) tv[i] = W[(size_t)(k0 + 2 * i + (lane >> 5)) * ldw + src_col0 + (lane & 31)];
    if (gk) {
#pragma unroll
        for (int i = 0; i < 32; ++i) tv[i] *= gk[k0 + 2 * i + (lane >> 5)];
    }
#pragma unroll
    for (int i = 0; i < 32; ++i) scr[(2 * i + (lane >> 5)) * 33 + (lane & 31)] = tv[i];
    LDS_WAIT(); asm volatile("" ::: "memory");
    const int c = lane & 7;
#pragma unroll
    for (int j = 0; j < 4; ++j) { const int n = (lane >> 3) + 8 * j; const LAS float* s = scr + (8 * c) * 33 + n;
        v4u o; o.x = pk2(s[0 * 33], s[1 * 33]); o.y = pk2(s[2 * 33], s[3 * 33]); o.z = pk2(s[4 * 33], s[5 * 33]); o.w = pk2(s[6 * 33], s[7 * 33]);
        *(v4u*)(WT + (size_t)(dst_row0 + n) * K + k0 + 8 * c) = o; }
    LDS_WAIT(); asm volatile("" ::: "memory");
}
__device__ __forceinline__ float softplus_f(float x) { return fmaxf(x, 0.f) + log1pf(__expf(-fabsf(x))); }

__device__ __forceinline__ void wconv(const Args& A, LAS float* scr, int kind, int worker, int nworkers, int lane) {
    unsigned char* ws = A.ws;
    const int nblk = kind == 0 ? 96 : kind == 4 ? 64 : kind == 5 ? 176 : 32, nkb = kind == 6 ? 44 : 16;
    for (int r = worker; r < nblk * nkb; r += nworkers) {
        const int kb = r / nblk, n0 = 32 * (r % nblk);
        if (kind == 0) transpose_item((const float*)A.in[12], INCOLS, n0 < 1536 ? n0 : n0 + 8, 64 * kb, (bf16*)(ws + WS_WIN), DM, n0, (const float*)A.in[11], scr, lane);
        else if (kind == 1) transpose_item((const float*)A.in[20], DM, n0, 64 * kb, (bf16*)(ws + WS_WOUT), DM, n0, nullptr, scr, lane);
        else if (kind == 2) transpose_item((const float*)A.in[23], DM, n0, 64 * kb, (bf16*)(ws + WS_WCQ), DM, n0, (const float*)A.in[21], scr, lane);
        else if (kind == 3) transpose_item((const float*)A.in[26], DM, n0, 64 * kb, (bf16*)(ws + WS_WCO), DM, n0, nullptr, scr, lane);
        else if (kind == 4) transpose_item((const float*)A.in[n0 < 1024 ? 24 : 25], DM, n0 & 1023, 64 * kb, (bf16*)(ws + WS_WCKV), DM, n0, (const float*)A.in[22], scr, lane);
        else if (kind == 5) { const int pn = n0 >> 8, half = (n0 >> 7) & 1, j0 = n0 & 127; transpose_item((const float*)A.in[half ? 29 : 28], DFF, pn * 128 + j0, 64 * kb, (bf16*)(ws + WS_WGU), DM, n0, (const float*)A.in[27], scr, lane); }
        else transpose_item((const float*)A.in[30], DM, n0, 64 * kb, (bf16*)(ws + WS_WD), DFF, n0, nullptr, scr, lane);
    }
}

__device__ __forceinline__ void p0_prologue(const Args& A, LAS unsigned char* lds, int tid, int lane, int wave, int wg, int nwg) {
    unsigned char* ws = A.ws;
    const float* w_in = (const float*)A.in[12];
    LAS float* scr = (LAS float*)(lds + wave * 8448);
    const int gw = wg * NWAVES + wave, NGW = nwg * NWAVES;
    wconv(A, scr, 0, gw, NGW, lane); wconv(A, scr, 4, gw, NGW, lane);
    if (nwg != 256) { wconv(A, scr, 1, gw, NGW, lane); wconv(A, scr, 2, gw, NGW, lane); wconv(A, scr, 3, gw, NGW, lane); wconv(A, scr, 5, gw, NGW, lane); wconv(A, scr, 6, gw, NGW, lane); }
    __syncthreads();
    LAS float* wfd = (LAS float*)lds;
    { const float* g = (const float*)A.in[11];
#pragma unroll
      for (int j = 0; j < 2; ++j) { const int k = tid + NTHREADS * j; const float* wr = w_in + (size_t)k * INCOLS; const float gk = g[k];
          const f32x4 a0 = *(const f32x4*)(wr + 1536), a1 = *(const f32x4*)(wr + 1540), b0 = *(const f32x4*)(wr + 3080), b1 = *(const f32x4*)(wr + 3084);
#pragma unroll
          for (int c = 0; c < 4; ++c) { wfd[c * DM + k] = a0[c] * gk; wfd[(4 + c) * DM + k] = a1[c] * gk; wfd[(8 + c) * DM + k] = b0[c] * gk; wfd[(12 + c) * DM + k] = b1[c] * gk; } } }
    __syncthreads();
    bf16* XB = (bf16*)(ws + WS_XB); bf16* MB = (bf16*)(ws + WS_MB);
    float* SS0 = (float*)(ws + WS_SS0); float* SSM = (float*)(ws + WS_SSM); float* LOGF = (float*)(ws + WS_LOGF); float* DT = (float*)(ws + WS_DT); float* AA = (float*)(ws + WS_AA);
    const float* b_forget = (const float*)A.in[13]; const float* dt_bias = (const float*)A.in[16]; const float* a_log = (const float*)A.in[17];
    f32x4 nxt[4];
    if (gw < MT + MMEM) { const float* s0 = gw < MP ? (const float*)A.in[0] + (size_t)gw * DM : gw < MT ? (const float*)A.in[1] + (size_t)(gw - MP) * DM : (const float*)A.in[2] + (size_t)(gw - MT) * DM;
#pragma unroll
        for (int j = 0; j < 4; ++j) nxt[j] = *((const f32x4*)s0 + lane + 64 * j); }
    for (int m = gw; m < MT + MMEM; m += NGW) {
        const float* src; bf16* dst;
        if (m < MP) { src = (const float*)A.in[0] + (size_t)m * DM; dst = XB + (size_t)m * DM; }
        else if (m < MT) { src = (const float*)A.in[1] + (size_t)(m - MP) * DM; dst = XB + (size_t)m * DM; }
        else { src = (const float*)A.in[2] + (size_t)(m - MT) * DM; dst = MB + (size_t)(m - MT) * DM; }
        f32x4 v[4]; float s = 0.f;
#pragma unroll
        for (int j = 0; j < 4; ++j) { v[j] = nxt[j]; s += (v[j][0] * v[j][0] + v[j][1] * v[j][1]) + (v[j][2] * v[j][2] + v[j][3] * v[j][3]); }
        { const int mn = m + NGW; if (mn < MT + MMEM) { const float* sn = mn < MP ? (const float*)A.in[0] + (size_t)mn * DM : mn < MT ? (const float*)A.in[1] + (size_t)(mn - MP) * DM : (const float*)A.in[2] + (size_t)(mn - MT) * DM;
#pragma unroll
            for (int j = 0; j < 4; ++j) nxt[j] = *((const f32x4*)sn + lane + 64 * j); } }
        s = wave_sum(s);
#pragma unroll
        for (int j = 0; j < 4; ++j) { unsigned long long w = (unsigned long long)pk2(v[j][0], v[j][1]) | ((unsigned long long)pk2(v[j][2], v[j][3]) << 32); *((unsigned long long*)dst + lane + 64 * j) = w; }
        if (m >= MT) { if (lane == 0) SSM[m - MT] = s; continue; }
        if (lane == 0) SS0[m] = s;
        const float rs = rstd_of(s, DM);
        float mine = 0.f;
#pragma unroll
        for (int c = 0; c < 16; ++c) { float d = 0.f;
#pragma unroll
            for (int j = 0; j < 4; ++j) { const f32x4 w = *((const LAS f32x4*)(wfd + c * DM) + lane + 64 * j); d += (v[j][0] * w[0] + v[j][1] * w[1]) + (v[j][2] * w[2] + v[j][3] * w[3]); }
            d = wave_sum(d); if (lane == c) mine = d; }
        if (lane < 8) { const float x = mine * rs + b_forget[lane]; const float lf = fminf(x, 0.f) - log1pf(__expf(-fabsf(x)));
            LOGF[(size_t)m * 8 + lane] = lf; if (m < MP) A.out[OFF_FP + (size_t)m * 8 + lane] = lf; else A.out[OFF_FS + (size_t)(m - MP) * 8 + lane] = lf; }
        else if (lane < 16) { const int h = lane - 8; const float dt = softplus_f(mine * rs + dt_bias[h]); DT[(size_t)m * 8 + h] = dt; AA[(size_t)m * 8 + h] = -__expf(a_log[h]) * dt; }
    }
}

__device__ __forceinline__ float block_excl_scan(float v, LAS float* sh, int lane, int wave) {
    float inc = v;
#pragma unroll
    for (int o = 1; o < 64; o <<= 1) { const float t = __shfl_up(inc, o); if (lane >= o) inc += t; }
    __syncthreads();
    if (lane == 63) sh[wave] = inc;
    __syncthreads();
    float base = 0.f;
    for (int w = 0; w < wave; ++w) base += sh[w];
    return base + inc - v;
}
__device__ __forceinline__ void p1_cumsum(const Args& A, LAS unsigned char* lds, int tid, int lane, int wave, int bh) {
    const float* LOGF = (const float*)(A.ws + WS_LOGF); float* CUM = (float*)(A.ws + WS_CUM);
    const int b = bh >> 3, h = bh & 7, t0 = tid * 16;
    float v[16]; float run = 0.f;
#pragma unroll
    for (int j = 0; j < 16; ++j) { run += LOGF[((size_t)b * SEQ + t0 + j) * 8 + h]; v[j] = run; }
    const float ex = block_excl_scan(run, (LAS float*)lds, lane, wave);
#pragma unroll
    for (int j = 0; j < 16; ++j) CUM[(size_t)bh * SEQ + t0 + j] = ex + v[j];
    __syncthreads();
}

constexpr size_t WS_ACTB = WS_ACT;
__device__ __forceinline__ void unpack8(v4u w, float (&x)[8]) { x[0] = __uint_as_float(w.x << 16); x[1] = __uint_as_float(w.x & 0xffff0000u); x[2] = __uint_as_float(w.y << 16); x[3] = __uint_as_float(w.y & 0xffff0000u);
    x[4] = __uint_as_float(w.z << 16); x[5] = __uint_as_float(w.z & 0xffff0000u); x[6] = __uint_as_float(w.w << 16); x[7] = __uint_as_float(w.w & 0xffff0000u); }
__device__ __forceinline__ void conv_pass(const Args& A, int tid, int wg, int nwg) {
    const bf16* XBC = (const bf16*)(A.ws + WS_XBC); bf16* ACTB = (bf16*)(A.ws + WS_ACTB);
    const float* state_conv = (const float*)A.in[9]; const float* conv_w = (const float*)A.in[14]; const float* conv_b = (const float*)A.in[15];
    constexpr int NPI = (MP / 16) * 128, NSI = DB * 128;
    for (int idx = wg * NTHREADS + tid; idx < NPI + NSI; idx += nwg * NTHREADS) {
        const bool prm = idx < NPI; const int j = prm ? idx : idx - NPI; const int c8 = (j & 127) * 8, rg = j >> 7;
        float w[4][8], bs[8], xw[3][8];
#pragma unroll
        for (int t = 0; t < 4; ++t) { const f32x4 a = *(const f32x4*)(conv_w + t * CONVCH + c8), b = *(const f32x4*)(conv_w + t * CONVCH + c8 + 4);
#pragma unroll
            for (int i = 0; i < 4; ++i) { w[t][i] = a[i]; w[t][4 + i] = b[i]; } }
        { const f32x4 a = *(const f32x4*)(conv_b + c8), b = *(const f32x4*)(conv_b + c8 + 4);
#pragma unroll
          for (int i = 0; i < 4; ++i) { bs[i] = a[i]; bs[4 + i] = b[i]; } }
        const int r0 = prm ? rg * 16 : MP + rg * 4, nrows = prm ? 16 : 4;
        if (prm) {
            if ((r0 & (SEQ - 1)) == 0) {
#pragma unroll
                for (int t = 0; t < 3; ++t)
#pragma unroll
                    for (int i = 0; i < 8; ++i) xw[t][i] = 0.f;
            } else {
#pragma unroll
                for (int t = 0; t < 3; ++t) unpack8(*(const v4u*)(XBC + (size_t)(r0 - 3 + t) * CONVCH + c8), xw[t]);
            }
        } else {
#pragma unroll
            for (int t = 0; t < 3; ++t) { const float* sp = state_conv + ((size_t)rg * 3 + t) * CONVCH + c8; const f32x4 a = *(const f32x4*)sp, b = *(const f32x4*)(sp + 4);
#pragma unroll
                for (int i = 0; i < 4; ++i) { xw[t][i] = a[i]; xw[t][4 + i] = b[i]; } }
        }
#pragma unroll 4
        for (int i = 0; i < nrows; ++i) {
            float xi[8]; unpack8(*(const v4u*)(XBC + (size_t)(r0 + i) * CONVCH + c8), xi);
            f32x4 o0, o1;
#pragma unroll
            for (int k = 0; k < 8; ++k) { const float a = bs[k] + ((w[0][k] * xw[0][k] + w[1][k] * xw[1][k]) + (w[2][k] * xw[2][k] + w[3][k] * xi[k])); const float sv = silu_f(a); if (k < 4) o0[k] = sv; else o1[k - 4] = sv;
                xw[0][k] = xw[1][k]; xw[1][k] = xw[2][k]; xw[2][k] = xi[k]; }
            *(v4u*)(ACTB + (size_t)(r0 + i) * CONVCH + c8) = pack8(o0, o1);
        }
    }
}

__device__ __forceinline__ void p3_ssd_naive(const Args& A, LAS unsigned char* lds, int lane, int wave, int wg, int nwg, int it_lo, int wsub, int nws) {
    const bf16* ACT = (const bf16*)(A.ws + WS_ACTB); const float* DT = (const float*)(A.ws + WS_DT); const float* AA = (const float*)(A.ws + WS_AA); float* Y = (float*)(A.ws + WS_Y);
    const float* state_ssm = (const float*)A.in[10]; const float* d_skip = (const float*)A.in[18];
    LAS float* bc = (LAS float*)(lds + wave * 4096);
    const int gwt = wsub * nwg + wg, NGW = nwg * nws;
    const int pl = lane & 15, nq = lane >> 4, n0 = nq * 32;
    for (int it = it_lo + gwt; it < (NBATCH * HSSM + DB * HSSM) * 4; it += NGW) {
        const int sh = it >> 2, p = (it & 3) * 16 + pl;
        int L, row0, h; float* sout; float hs[32];
        if (sh < NBATCH * HSSM) { const int b = sh >> 3; h = sh & 7; L = SEQ; row0 = b * SEQ; sout = A.out + OFF_SP + ((size_t)sh * PS + p) * NST + n0;
#pragma unroll
            for (int n = 0; n < 32; ++n) hs[n] = 0.f; }
        else { const int s = sh - NBATCH * HSSM, b = s >> 3; h = s & 7; L = DSQ; row0 = MP + b * DSQ; sout = A.out + OFF_SS + ((size_t)s * PS + p) * NST + n0;
            const float* h0 = state_ssm + ((size_t)s * PS + p) * NST + n0;
#pragma unroll
            for (int n = 0; n < 32; n += 4) { const f32x4 t = *(const f32x4*)(h0 + n); hs[n] = t[0]; hs[n + 1] = t[1]; hs[n + 2] = t[2]; hs[n + 3] = t[3]; } }
        const int g = h >> 2; const float dsk = d_skip[h];
        float nx[4], ndt[4], na[4]; f32x2 nb[4], nc[4];
#define SSD_LOAD(t_, i_) do { const size_t r_ = (size_t)row0 + (t_); nx[i_] = bf2f(ACT[r_ * CONVCH + h * PS + p]); ndt[i_] = DT[r_ * 8 + h]; na[i_] = AA[r_ * 8 + h]; \
            { const unsigned ub_ = *(const unsigned*)(ACT + r_ * CONVCH + 512 + g * NST + 2 * lane), uc_ = *(const unsigned*)(ACT + r_ * CONVCH + 768 + g * NST + 2 * lane); \
              nb[i_] = (f32x2){__uint_as_float(ub_ << 16), __uint_as_float(ub_ & 0xffff0000u)}; nc[i_] = (f32x2){__uint_as_float(uc_ << 16), __uint_as_float(uc_ & 0xffff0000u)}; } } while (0)
#pragma unroll
        for (int i = 0; i < 4; ++i) SSD_LOAD(i, i);
        for (int t0 = 0; t0 < L; t0 += 4) {
            float cx[4], cdt[4], ca[4];
#pragma unroll
            for (int i = 0; i < 4; ++i) { cx[i] = nx[i]; cdt[i] = ndt[i]; ca[i] = na[i]; *(LAS f32x2*)(bc + i * 256 + 2 * lane) = nb[i]; *(LAS f32x2*)(bc + i * 256 + 128 + 2 * lane) = nc[i]; }
            if (t0 + 4 < L) {
#pragma unroll
                for (int i = 0; i < 4; ++i) SSD_LOAD(t0 + 4 + i, i);
            }
            asm volatile("s_waitcnt lgkmcnt(0)" ::: "memory");
#pragma unroll
            for (int i = 0; i < 4; ++i) {
                const float dA = __expf(ca[i]), xdt = cx[i] * cdt[i]; float y = 0.f;
#pragma unroll
                for (int n = 0; n < 32; n += 4) {
                    const f32x4 bn = *(const LAS f32x4*)(bc + i * 256 + n0 + n), cn = *(const LAS f32x4*)(bc + i * 256 + 128 + n0 + n);
                    hs[n] = dA * hs[n] + bn[0] * xdt; y += cn[0] * hs[n];
                    hs[n + 1] = dA * hs[n + 1] + bn[1] * xdt; y += cn[1] * hs[n + 1];
                    hs[n + 2] = dA * hs[n + 2] + bn[2] * xdt; y += cn[2] * hs[n + 2];
                    hs[n + 3] = dA * hs[n + 3] + bn[3] * xdt; y += cn[3] * hs[n + 3];
                }
                y += __shfl_xor(y, 16); y += __shfl_xor(y, 32);
                if (nq == 0) Y[((size_t)row0 + t0 + i) * DSSM + h * PS + p] = y + dsk * cx[i];
            }
            asm volatile("s_waitcnt lgkmcnt(0)" ::: "memory");
        }
#undef SSD_LOAD
#pragma unroll
        for (int n = 0; n < 32; n += 4) *(f32x4*)(sout + n) = (f32x4){hs[n], hs[n + 1], hs[n + 2], hs[n + 3]};
    }
}

__device__ __forceinline__ void p4_gate_norm(const Args& A, int lane, int wave, int wg, int nwg, int row_lo) {
    const float* Y = (const float*)(A.ws + WS_Y); const bf16* Zb = (const bf16*)(A.ws + WS_Z); bf16* MIX = (bf16*)(A.ws + WS_MIX); const float* g = (const float*)A.in[19];
    const int gw = wg * NWAVES + wave, NGW = nwg * NWAVES;
    for (int row = row_lo + gw; row < MT; row += NGW) {
        const f32x4 y0 = *(const f32x4*)(Y + (size_t)row * DSSM + 8 * lane), y1 = *(const f32x4*)(Y + (size_t)row * DSSM + 8 * lane + 4);
        const v4u zw = *(const v4u*)(Zb + (size_t)row * DSSM + 8 * lane);
        float z[8] = {bf2f((unsigned short)zw.x), bf2f((unsigned short)(zw.x >> 16)), bf2f((unsigned short)zw.y), bf2f((unsigned short)(zw.y >> 16)), bf2f((unsigned short)zw.z), bf2f((unsigned short)(zw.z >> 16)), bf2f((unsigned short)zw.w), bf2f((unsigned short)(zw.w >> 16))};
        float v[8]; float s = 0.f;
#pragma unroll
        for (int i = 0; i < 8; ++i) { v[i] = (i < 4 ? y0[i] : y1[i - 4]) * silu_f(z[i]); s += v[i] * v[i]; }
        const float rs = rstd_of(wave_sum(s), DSSM);
        const f32x4 g0 = *(const f32x4*)(g + 8 * lane), g1 = *(const f32x4*)(g + 8 * lane + 4);
        f32x4 a = {v[0] * rs * g0[0], v[1] * rs * g0[1], v[2] * rs * g0[2], v[3] * rs * g0[3]}, c = {v[4] * rs * g1[0], v[5] * rs * g1[1], v[6] * rs * g1[2], v[7] * rs * g1[3]};
        *(v4u*)(MIX + (size_t)row * DM + DATT + 8 * lane) = pack8(a, c);
    }
}

__device__ __forceinline__ void p11_final_norm(const Args& A, int lane, int wave, int wg, int nwg) {
    const bf16* XBf = (const bf16*)(A.ws + WS_XB); const float* g = (const float*)A.in[31];
    const int gw = wg * NWAVES + wave, NGW = nwg * NWAVES;
    for (int row = gw; row < MT; row += NGW) {
        float v[16]; float s = 0.f;
#pragma unroll
        for (int j = 0; j < 2; ++j) { const v4u w = *((const v4u*)(XBf + (size_t)row * DM) + lane + 64 * j);
            v[8 * j] = __uint_as_float(w.x << 16); v[8 * j + 1] = __uint_as_float(w.x & 0xffff0000u); v[8 * j + 2] = __uint_as_float(w.y << 16); v[8 * j + 3] = __uint_as_float(w.y & 0xffff0000u);
            v[8 * j + 4] = __uint_as_float(w.z << 16); v[8 * j + 5] = __uint_as_float(w.z & 0xffff0000u); v[8 * j + 6] = __uint_as_float(w.w << 16); v[8 * j + 7] = __uint_as_float(w.w & 0xffff0000u); }
#pragma unroll
        for (int i = 0; i < 16; ++i) s += v[i] * v[i];
        const float rs = rstd_of(wave_sum(s), DM);
        float* o = A.out + (row < MP ? OFF_YP + (size_t)row * DM : OFF_YS + (size_t)(row - MP) * DM);
#pragma unroll
        for (int j = 0; j < 2; ++j) { const int c = 8 * (lane + 64 * j); const f32x4 g0 = *(const f32x4*)(g + c), g1 = *(const f32x4*)(g + c + 4);
            *(f32x4*)(o + c) = (f32x4){v[8 * j] * rs * g0[0], v[8 * j + 1] * rs * g0[1], v[8 * j + 2] * rs * g0[2], v[8 * j + 3] * rs * g0[3]};
            *(f32x4*)(o + c + 4) = (f32x4){v[8 * j + 4] * rs * g1[0], v[8 * j + 5] * rs * g1[1], v[8 * j + 6] * rs * g1[2], v[8 * j + 7] * rs * g1[3]}; }
    }
}

constexpr size_t WS_KN = WS_CUM + 512 * 1024, WS_QN = WS_KN + 8192;
__device__ __forceinline__ void attn_norms(const Args& A, int lane, int wave, int wg, int nwg) {
    const int gw = wg * NWAVES + wave, NGW = nwg * NWAVES;
    for (int it = gw; it < 2 * NBATCH * HATT * (SEQ / 64); it += NGW) {
        const int which = it >> 11, bh = (it >> 7) & 15, tile = it & 127;
        const bf16* src = (const bf16*)(A.ws + (which ? WS_Q : WS_K)) + ((size_t)(bh >> 3) * SEQ + tile * 64 + lane) * DATT + (bh & 7) * HD;
        float s = 0.f;
#pragma unroll
        for (int i = 0; i < 8; ++i) { float x[8]; unpack8(*(const v4u*)(src + 8 * i), x);
#pragma unroll
            for (int k = 0; k < 8; ++k) s += x[k] * x[k]; }
        const float nmax = wave_max(sqrtf(s));
        if (lane == 0) ((float*)(A.ws + (which ? WS_QN : WS_KN)))[bh * (SEQ / 64) + tile] = nmax;
    }
}

constexpr size_t WS_SCH = 544 * MiB;
constexpr size_t WS_DEC = 580 * MiB;
constexpr size_t WS_HST = 582 * MiB;
constexpr size_t WS_END2 = 616 * MiB;
constexpr int SSD_Q = 128, NCH = SEQ / SSD_Q, LP = 136;
__device__ __forceinline__ f32x4 mfma16(bf16x8 a, bf16x8 b, f32x4 c) { return __builtin_amdgcn_mfma_f32_16x16x32_bf16(a, b, c, 0, 0, 0); }
__device__ __forceinline__ bf16x8 ldfrag(const LAS bf16* base, int pitch, int r0, int k0, int lane) { return *(const LAS bf16x8*)(base + (r0 + (lane & 15)) * pitch + k0 + 8 * (lane >> 4)); }
__device__ __forceinline__ void conv8x2(const bf16* __restrict__ XBC, int grow0, int seq0, int s0, int ch, const float* __restrict__ conv_w, const float* __restrict__ conv_b, float (&o0)[8], float (&o1)[8]) {
    float x0[11], x1[11];
#pragma unroll
    for (int k = 0; k < 11; ++k) { const int r = grow0 + s0 - 3 + k; unsigned u = 0u; if (r >= seq0) u = *(const unsigned*)(XBC + (size_t)r * CONVCH + ch); x0[k] = __uint_as_float(u << 16); x1[k] = __uint_as_float(u & 0xffff0000u); }
    float w0[4], w1[4];
#pragma unroll
    for (int j = 0; j < 4; ++j) { const f32x2 w = *(const f32x2*)(conv_w + j * CONVCH + ch); w0[j] = w[0]; w1[j] = w[1]; }
    const f32x2 bb = *(const f32x2*)(conv_b + ch);
#pragma unroll
    for (int i = 0; i < 8; ++i) { float a0 = bb[0], a1 = bb[1];
#pragma unroll
        for (int j = 0; j < 4; ++j) { a0 += w0[j] * x0[i + j]; a1 += w1[j] * x1[i + j]; }
        o0[i] = silu_f(a0); o1[i] = silu_f(a1); }
}
__device__ __forceinline__ void ssd_scalars(const float* __restrict__ AA, const float* __restrict__ DT, int grow0, int g, LAS float* acs, LAS float* dtl, LAS float* tmp, int tid, int lane, int wave) {
    const int hl = tid >> 7, s = tid & 127; const size_t idx = (size_t)(grow0 + s) * 8 + 4 * g + hl;
    float inc = AA[idx]; dtl[hl * 128 + s] = DT[idx];
#pragma unroll
    for (int o = 1; o < 64; o <<= 1) { const float t = __shfl_up(inc, o); if (lane >= o) inc += t; }
    if (lane == 63) tmp[wave] = inc;
    __syncthreads();
    if (wave & 1) inc += tmp[wave - 1];
    acs[hl * 128 + s] = inc;
    __syncthreads();
}
__device__ __forceinline__ unsigned short f2bf16(float f) { return (unsigned short)f2bf(f); }

__device__ __forceinline__ void ssd_phase_a(const Args& A, LAS unsigned char* lds, int tid, int lane, int wave, int wg, int nwg) {
    const bf16* XBC = (const bf16*)(A.ws + WS_XBC); const float* AA = (const float*)(A.ws + WS_AA); const float* DT = (const float*)(A.ws + WS_DT);
    float* SCH = (float*)(A.ws + WS_SCH); float* DEC = (float*)(A.ws + WS_DEC);
    const float* conv_w = (const float*)A.in[14]; const float* conv_b = (const float*)A.in[15];
    LAS bf16* XT = (LAS bf16*)lds;
    LAS bf16* BT = XT + 256 * LP;
    LAS float* acs = (LAS float*)(BT + 128 * LP); LAS float* dtl = acs + 512; LAS float* wl = dtl + 512; LAS float* tmp = wl + 512;
    for (int u = wg; u < NBATCH * NCH * 2; u += nwg) {
        const int g = u & 1, bc = u >> 1, b = bc / NCH, c = bc % NCH, grow0 = b * SEQ + c * SSD_Q, seq0 = b * SEQ;
        __syncthreads();
        ssd_scalars(AA, DT, grow0, g, acs, dtl, tmp, tid, lane, wave);
        { const int hl = tid >> 7, s = tid & 127; const float aend = acs[hl * 128 + 127]; wl[hl * 128 + s] = dtl[hl * 128 + s] * __expf(aend - acs[hl * 128 + s]);
          if (s == 127) DEC[(size_t)bc * 8 + 4 * g + hl] = __expf(aend); }
        __syncthreads();
        for (int it = tid; it < 192 * 16; it += NTHREADS) {
            const int cp = it % 192, s0 = (it / 192) * 8; float o0[8], o1[8];
            if (cp < 128) { const int j = 2 * cp; conv8x2(XBC, grow0, seq0, s0, 256 * g + j, conv_w, conv_b, o0, o1);
                const int hl = j >> 6; v4u w0, w1; float e[8];
#pragma unroll
                for (int i = 0; i < 8; ++i) e[i] = wl[hl * 128 + s0 + i];
                w0.x = pk2(o0[0] * e[0], o0[1] * e[1]); w0.y = pk2(o0[2] * e[2], o0[3] * e[3]); w0.z = pk2(o0[4] * e[4], o0[5] * e[5]); w0.w = pk2(o0[6] * e[6], o0[7] * e[7]);
                w1.x = pk2(o1[0] * e[0], o1[1] * e[1]); w1.y = pk2(o1[2] * e[2], o1[3] * e[3]); w1.z = pk2(o1[4] * e[4], o1[5] * e[5]); w1.w = pk2(o1[6] * e[6], o1[7] * e[7]);
                *(LAS v4u*)(XT + j * LP + s0) = w0; *(LAS v4u*)(XT + (j + 1) * LP + s0) = w1; }
            else { const int n = 2 * (cp - 128); conv8x2(XBC, grow0, seq0, s0, 512 + 128 * g + n, conv_w, conv_b, o0, o1);
                v4u w0, w1;
                w0.x = pk2(o0[0], o0[1]); w0.y = pk2(o0[2], o0[3]); w0.z = pk2(o0[4], o0[5]); w0.w = pk2(o0[6], o0[7]);
                w1.x = pk2(o1[0], o1[1]); w1.y = pk2(o1[2], o1[3]); w1.z = pk2(o1[4], o1[5]); w1.w = pk2(o1[6], o1[7]);
                *(LAS v4u*)(BT + n * LP + s0) = w0; *(LAS v4u*)(BT + (n + 1) * LP + s0) = w1; }
        }
        __syncthreads();
        const int hl = wave >> 1, nh = wave & 1;
        f32x4 acc[4][4];
#pragma unroll
        for (int mt = 0; mt < 4; ++mt)
#pragma unroll
            for (int nt = 0; nt < 4; ++nt) acc[mt][nt] = (f32x4){0.f, 0.f, 0.f, 0.f};
#pragma unroll
        for (int k = 0; k < 4; ++k) { bf16x8 af[4], bfr[4];
#pragma unroll
            for (int mt = 0; mt < 4; ++mt) af[mt] = ldfrag(XT, LP, 64 * hl + 16 * mt, 32 * k, lane);
#pragma unroll
            for (int nt = 0; nt < 4; ++nt) bfr[nt] = ldfrag(BT, LP, 64 * nh + 16 * nt, 32 * k, lane);
#pragma unroll
            for (int mt = 0; mt < 4; ++mt)
#pragma unroll
                for (int nt = 0; nt < 4; ++nt) acc[mt][nt] = mfma16(af[mt], bfr[nt], acc[mt][nt]); }
        float* dst = SCH + ((size_t)bc * 8 + 4 * g + hl) * (PS * NST);
        const int r = lane & 15, q = lane >> 4;
#pragma unroll
        for (int mt = 0; mt < 4; ++mt)
#pragma unroll
            for (int nt = 0; nt < 4; ++nt)
#pragma unroll
                for (int i = 0; i < 4; ++i) dst[(size_t)(16 * mt + 4 * q + i) * NST + 64 * nh + 16 * nt + r] = acc[mt][nt][i];
    }
    __syncthreads();
}

__device__ __forceinline__ void ssd_phase_b(const Args& A, int thr, int nthr) {
    const float* SCH = (const float*)(A.ws + WS_SCH); bf16* HSTo = (bf16*)(A.ws + WS_HST); const float* DEC = (const float*)(A.ws + WS_DEC);
    constexpr int PER = HSSM * PS * NST;
    for (int e0 = thr; e0 < NBATCH * PER; e0 += 2 * nthr) {
        const int e1 = e0 + nthr; const bool two = e1 < NBATCH * PER; const int e1c = two ? e1 : e0;
        const int b0 = e0 / PER, r0 = e0 % PER, b1 = e1c / PER, r1 = e1c % PER;
        const float* p0 = SCH + (size_t)b0 * NCH * PER + r0; const float* p1 = SCH + (size_t)b1 * NCH * PER + r1;
        bf16* o0 = HSTo + (size_t)b0 * NCH * PER + r0; bf16* o1 = HSTo + (size_t)b1 * NCH * PER + r1;
        const float* d0 = DEC + (size_t)b0 * NCH * 8 + r0 / (PS * NST); const float* d1 = DEC + (size_t)b1 * NCH * 8 + r1 / (PS * NST);
        float h0 = 0.f, h1 = 0.f;
        for (int c0 = 0; c0 < NCH; c0 += 16) { float s0[16], s1[16], q0[16], q1[16];
#pragma unroll
            for (int j = 0; j < 16; ++j) { s0[j] = p0[(size_t)(c0 + j) * PER]; s1[j] = p1[(size_t)(c0 + j) * PER]; q0[j] = d0[(c0 + j) * 8]; q1[j] = d1[(c0 + j) * 8]; }
#pragma unroll
            for (int j = 0; j < 16; ++j) { o0[(size_t)(c0 + j) * PER] = f2bf16(h0); h0 = q0[j] * h0 + s0[j]; if (two) o1[(size_t)(c0 + j) * PER] = f2bf16(h1); h1 = q1[j] * h1 + s1[j]; } }
        A.out[OFF_SP + e0] = h0; if (two) A.out[OFF_SP + e1] = h1;
    }
}

constexpr int YP = 520;
__device__ __forceinline__ void ssd_phase_c(const Args& A, LAS unsigned char* lds, int tid_in, int lane_in, int wave, int wg, int nwg) {
    const bf16* ACTB = (const bf16*)(A.ws + WS_ACTB); const float* AA = (const float*)(A.ws + WS_AA); const float* DT = (const float*)(A.ws + WS_DT);
    const bf16* HST = (const bf16*)(A.ws + WS_HST); const bf16* Zb = (const bf16*)(A.ws + WS_Z); bf16* MIX = (bf16*)(A.ws + WS_MIX);
    const float* d_skip = (const float*)A.in[18]; const float* gain = (const float*)A.in[19];
    LAS bf16* Bn = (LAS bf16*)lds;
    LAS bf16* Cn = Bn + 128 * LP;
    LAS bf16* XT = Cn + 64 * LP;
    LAS bf16* GL = XT + 64 * LP;
    LAS bf16* YL = GL + 64 * LP;
    LAS float* acs = (LAS float*)(YL + 64 * YP); LAS float* dtl = acs + 512; LAS float* tmp = dtl + 512;
    const int tt = wave >> 1, hf = wave & 1;
    for (int u = wg; u < NBATCH * NCH * 2; u += nwg) {
        int tid_o = tid_in; asm volatile("" : "+v"(tid_o));
        const int tid = tid_o, lane = tid & 63, r = lane & 15, q = lane >> 4;
        const int th = u & 1, bc = u >> 1, b = bc / NCH, c = bc % NCH, grow0 = b * SEQ + c * SSD_Q;
        v4u xa, xb, hfr[2][4];
#define SC_LOAD(h_) do { const bf16* xp_ = ACTB + (size_t)(grow0 + (tid & 127)) * CONVCH + 64 * (h_) + 16 * (tid >> 7); xa = *(const v4u*)xp_; xb = *(const v4u*)(xp_ + 8); \
            const bf16* hp_ = HST + ((size_t)bc * 8 + (h_)) * (PS * NST) + (size_t)(32 * hf + r) * NST + 8 * q; \
            _Pragma("unroll") for (int pt_ = 0; pt_ < 2; ++pt_) _Pragma("unroll") for (int k_ = 0; k_ < 4; ++k_) hfr[pt_][k_] = *(const v4u*)(hp_ + (size_t)(16 * pt_) * NST + 32 * k_); } while (0)
        SC_LOAD(0);
#pragma unroll 1
        for (int g = 0; g < 2; ++g) {
            __syncthreads();
            if (tid < 8) tmp[8 + tid] = d_skip[tid];
            ssd_scalars(AA, DT, grow0, g, acs, dtl, tmp, tid, lane, wave);
            { const int row = tid >> 2, part = tid & 3; const bf16* src = ACTB + (size_t)(grow0 + row) * CONVCH + 512 + 128 * g + 32 * part;
#pragma unroll
              for (int i = 0; i < 4; ++i) *(LAS v4u*)(Bn + row * LP + 32 * part + 8 * i) = *(const v4u*)(src + 8 * i); }
            { const int row = tid >> 3, part = tid & 7; const bf16* src = ACTB + (size_t)(grow0 + 64 * th + row) * CONVCH + 768 + 128 * g + 16 * part;
#pragma unroll
              for (int i = 0; i < 2; ++i) *(LAS v4u*)(Cn + row * LP + 16 * part + 8 * i) = *(const v4u*)(src + 8 * i); }
            __syncthreads();
            f32x4 G[4];
#pragma unroll
            for (int nt = 0; nt < 4; ++nt) G[nt] = (f32x4){0.f, 0.f, 0.f, 0.f};
#pragma unroll
            for (int k = 0; k < 4; ++k) { const bf16x8 af = ldfrag(Cn, LP, 16 * tt, 32 * k, lane);
#pragma unroll
                for (int nt = 0; nt < 4; ++nt) G[nt] = mfma16(af, ldfrag(Bn, LP, 64 * hf + 16 * nt, 32 * k, lane), G[nt]); }
#pragma unroll 1
            for (int hl = 0; hl < 4; ++hl) {
                const int h = 4 * g + hl;
                __syncthreads();
                const float dsk = tmp[8 + h];
                { const int s = tid & 127, p0 = 16 * (tid >> 7); const float dts = dtl[hl * 128 + s]; float xv[8];
                  unpack8(xa, xv);
#pragma unroll
                  for (int i = 0; i < 8; ++i) XT[(p0 + i) * LP + s] = f2bf16(xv[i] * dts);
                  unpack8(xb, xv);
#pragma unroll
                  for (int i = 0; i < 8; ++i) XT[(p0 + 8 + i) * LP + s] = f2bf16(xv[i] * dts); }
                bf16x8 hcur[2][4];
#pragma unroll
                for (int pt = 0; pt < 2; ++pt)
#pragma unroll
                    for (int k = 0; k < 4; ++k) hcur[pt][k] = __builtin_bit_cast(bf16x8, hfr[pt][k]);
                __builtin_amdgcn_sched_barrier(0);
                if (h < 7) SC_LOAD(h + 1);
                __builtin_amdgcn_sched_barrier(0);
#pragma unroll
                for (int i = 0; i < 4; ++i) { const int tl = 16 * tt + 4 * q + i, ta = 64 * th + tl; const float at = acs[hl * 128 + ta], dinv = dsk / dtl[hl * 128 + ta];
#pragma unroll
                    for (int nt = 0; nt < 4; ++nt) { const int s = 64 * hf + 16 * nt + r;
                        float e = __builtin_amdgcn_exp2f(fminf(at - acs[hl * 128 + s], 0.f) * LOG2E); asm volatile("" : "+v"(e));
                        float v = G[nt][i] * e * ((s <= ta) ? 1.f : 0.f); v += (s == ta) ? dinv : 0.f;
                        GL[tl * LP + s] = f2bf16(v); } }
                __syncthreads();
                f32x4 ya[2] = {(f32x4){0.f, 0.f, 0.f, 0.f}, (f32x4){0.f, 0.f, 0.f, 0.f}};
#pragma unroll
                for (int k = 0; k < 4; ++k) { const bf16x8 af = ldfrag(Cn, LP, 16 * tt, 32 * k, lane);
#pragma unroll
                    for (int pt = 0; pt < 2; ++pt) ya[pt] = mfma16(af, hcur[pt][k], ya[pt]); }
#pragma unroll
                for (int i = 0; i < 4; ++i) { const float ea = __expf(acs[hl * 128 + 64 * th + 16 * tt + 4 * q + i]); ya[0][i] *= ea; ya[1][i] *= ea; }
#pragma unroll
                for (int k = 0; k < 4; ++k) { const bf16x8 af = ldfrag(GL, LP, 16 * tt, 32 * k, lane);
#pragma unroll
                    for (int pt = 0; pt < 2; ++pt) ya[pt] = mfma16(af, ldfrag(XT, LP, 32 * hf + 16 * pt, 32 * k, lane), ya[pt]); }
#pragma unroll
                for (int pt = 0; pt < 2; ++pt)
#pragma unroll
                    for (int i = 0; i < 4; ++i) YL[(16 * tt + 4 * q + i) * YP + 64 * h + 32 * hf + 16 * pt + r] = f2bf16(ya[pt][i]);
            }
        }
#undef SC_LOAD
        __syncthreads();
        { const int tl = tid >> 3, c0 = (tid & 7) * 64; const size_t row = (size_t)grow0 + 64 * th + tl; float v[64]; float ss = 0.f;
#pragma unroll
          for (int k = 0; k < 8; ++k) { float yv[8], zv[8]; unpack8(*(const LAS v4u*)(YL + tl * YP + c0 + 8 * k), yv); unpack8(*(const v4u*)(Zb + row * DSSM + c0 + 8 * k), zv);
#pragma unroll
              for (int i = 0; i < 8; ++i) { const float gv = yv[i] * silu_f(zv[i]); v[8 * k + i] = gv; ss += gv * gv; } }
          ss += __shfl_xor(ss, 1); ss += __shfl_xor(ss, 2); ss += __shfl_xor(ss, 4);
          const float rs = rstd_of(ss, DSSM);
#pragma unroll
          for (int k = 0; k < 8; ++k) { const f32x4 g0 = *(const f32x4*)(gain + c0 + 8 * k), g1 = *(const f32x4*)(gain + c0 + 8 * k + 4);
              const f32x4 a = {v[8 * k] * rs * g0[0], v[8 * k + 1] * rs * g0[1], v[8 * k + 2] * rs * g0[2], v[8 * k + 3] * rs * g0[3]}, bq = {v[8 * k + 4] * rs * g1[0], v[8 * k + 5] * rs * g1[1], v[8 * k + 6] * rs * g1[2], v[8 * k + 7] * rs * g1[3]};
              *(v4u*)(MIX + row * DM + DATT + c0 + 8 * k) = pack8(a, bq); } }
    }
    __syncthreads();
}

#define ROR_ADD(v, n) ((v) + __builtin_bit_cast(float, __builtin_amdgcn_update_dpp(0, __builtin_bit_cast(int, (v)), 0x120 + (n), 0xf, 0xf, false)))
template <bool FOX> __device__ __forceinline__ float slice_sum(float v) {
    v = ROR_ADD(v, 8); v = ROR_ADD(v, 4); v = ROR_ADD(v, 2); v = ROR_ADD(v, 1);
    if (!FOX) { v += __shfl_xor(v, 16); v += __shfl_xor(v, 32); }
    return v;
}
constexpr size_t WS_RC = WS_Y + 8 * MiB;
constexpr size_t WS_PART = WS_Y;
template <bool FOX> __device__ __forceinline__ void decode_unit(const Args& A, LAS unsigned char* lds, int tid_in, int lane_in, int wave, int b, int sl, int part) {
    int tid_o = tid_in; asm volatile("" : "+v"(tid_o));
    const int tid = tid_o, lane = tid & 63;
    constexpr int KPW = FOX ? 64 : 32, NG = KPW / 4;
    const int hl = FOX ? (lane >> 4) : 0;
    LAS float* Rb = (LAS float*)lds;
    LAS float* om = (LAS float*)(lds + 32768);
    LAS float* mlb = (LAS float*)(lds + 65536);
    LAS float* tmp = (LAS float*)(lds + 65536 + 1024);
    const size_t qrow = (size_t)MP + b * DSQ;
    float q[4][4];
    { const bf16* qs = FOX ? (const bf16*)(A.ws + WS_Q) + qrow * DATT + sl * 256 + 4 * lane : (const bf16*)(A.ws + WS_QC) + qrow * DM + sl * 256 + 4 * lane;
#pragma unroll
      for (int t = 0; t < 4; ++t) { const unsigned long long w = *(const unsigned long long*)(qs + (size_t)t * (FOX ? DATT : DM));
          q[t][0] = bf2f((unsigned short)w); q[t][1] = bf2f((unsigned short)(w >> 16)); q[t][2] = bf2f((unsigned short)(w >> 32)); q[t][3] = bf2f((unsigned short)(w >> 48)); } }
    const int* page_table = (const int*)A.in[6];
    __syncthreads();
    if (FOX && part != 3) {
        const float* rc = (const float*)(A.ws + WS_RC) + (size_t)(b * 2 + sl) * (4 * PAST);
        { const int h4 = tid >> 7, k4 = (tid & 127) * 4; *(LAS f32x4*)(Rb + h4 * PAST + 512 * part + k4) = *(const f32x4*)(rc + h4 * PAST + 512 * part + k4); }
        __syncthreads();
    } else if (FOX) {
        const float* cache_logf = (const float*)A.in[5];
        const int h4 = tid >> 7, seg = tid & 127; const int phys = page_table[b * NPAGES + (seg >> 3)]; const size_t base = ((size_t)phys * PAGE + ((16 * seg) & (PAGE - 1))) * HATT + 4 * sl + h4;
        float lp[16]; float tot = 0.f;
#pragma unroll
        for (int i = 0; i < 16; ++i) { lp[i] = cache_logf[base + (size_t)i * HATT] * LOG2E; tot += lp[i]; }
        float inc = tot;
#pragma unroll
        for (int o = 1; o < 64; o <<= 1) { const float t = __shfl_down(inc, o); if (lane + o < 64) inc += t; }
        if (lane == 0) tmp[wave] = inc;
        __syncthreads();
        float after = inc - tot; if (!(wave & 1)) after += tmp[wave + 1];
        float run = after;
#pragma unroll
        for (int i = 15; i >= 0; --i) { Rb[h4 * PAST + 16 * seg + i] = run; run += lp[i]; }
        __syncthreads();
        { float* rc = (float*)(A.ws + WS_RC) + (size_t)(b * 2 + sl) * (4 * PAST);
#pragma unroll
          for (int j = 0; j < 4; ++j) { const int e4 = (tid + NTHREADS * j) * 4; *(f32x4*)(rc + e4) = *(const LAS f32x4*)(Rb + e4); } }
    }
    const float* ck = (const float*)A.in[FOX ? 3 : 7]; const float* cv = (const float*)A.in[FOX ? 4 : 8];
    size_t koff0;
    if (FOX) { const int p0 = page_table[b * NPAGES + 4 * part + (wave >> 1)]; koff0 = (((size_t)p0 * PAGE + 64 * (wave & 1)) * HATT + 4 * sl) * HD + 4 * lane; }
    else koff0 = (((size_t)b * NMEM + 32 * wave) * HX + sl) * HDX + 4 * lane;
    constexpr size_t KSTRIDE = FOX ? (size_t)HATT * HD : (size_t)HX * HDX;
    float mref[4] = {-1e30f, -1e30f, -1e30f, -1e30f};
    if (FOX && part != 3) { const float* p3 = (const float*)(A.ws + WS_PART) + ((size_t)((b * 2 + sl) * 4 + 3) * 4) * 272 + 256 + hl;
#pragma unroll
        for (int t = 0; t < 4; ++t) mref[t] = p3[(size_t)t * 272] - 64.0f; }
    float m[4], l[4], o[4][4];
#pragma unroll
    for (int t = 0; t < 4; ++t) { m[t] = -1e30f; l[t] = 0.f; o[t][0] = 0.f; o[t][1] = 0.f; o[t][2] = 0.f; o[t][3] = 0.f; }
    f32x4 kf[4], vf[4], nk[4], nv[4];
#pragma unroll
    for (int k = 0; k < 4; ++k) { vf[k] = (f32x4){0.f, 0.f, 0.f, 0.f}; nv[k] = (f32x4){0.f, 0.f, 0.f, 0.f}; }
    const bool vpre = !FOX || part == 3;
#define DEC_LOAD(g_, K_, V_) do { const size_t off_ = koff0 + (size_t)(4 * (g_)) * KSTRIDE; \
        _Pragma("unroll") for (int k_ = 0; k_ < 4; ++k_) K_[k_] = __builtin_nontemporal_load((const f32x4*)(ck + off_ + k_ * KSTRIDE)); \
        if (vpre) { _Pragma("unroll") for (int k_ = 0; k_ < 4; ++k_) V_[k_] = __builtin_nontemporal_load((const f32x4*)(cv + off_ + k_ * KSTRIDE)); } } while (0)
#define DEC_LOADV(g_, V_) do { const size_t off_ = koff0 + (size_t)(4 * (g_)) * KSTRIDE; \
        _Pragma("unroll") for (int k_ = 0; k_ < 4; ++k_) V_[k_] = __builtin_nontemporal_load((const f32x4*)(cv + off_ + k_ * KSTRIDE)); } while (0)
#define DEC_GROUP(K_, V_, B4_, MASKED_, G_) do { float s_[4][4]; \
        _Pragma("unroll") for (int k_ = 0; k_ < 4; ++k_) _Pragma("unroll") for (int t_ = 0; t_ < 4; ++t_) \
            s_[k_][t_] = (q[t_][0] * K_[k_][0] + q[t_][1] * K_[k_][1]) + (q[t_][2] * K_[k_][2] + q[t_][3] * K_[k_][3]); \
          \
        _Pragma("unroll") for (int k_ = 0; k_ < 4; ++k_) _Pragma("unroll") for (int t_ = 0; t_ < 4; ++t_) s_[k_][t_] = ROR_ADD(s_[k_][t_], 8); \
        _Pragma("unroll") for (int k_ = 0; k_ < 4; ++k_) _Pragma("unroll") for (int t_ = 0; t_ < 4; ++t_) s_[k_][t_] = ROR_ADD(s_[k_][t_], 4); \
        _Pragma("unroll") for (int k_ = 0; k_ < 4; ++k_) _Pragma("unroll") for (int t_ = 0; t_ < 4; ++t_) s_[k_][t_] = ROR_ADD(s_[k_][t_], 2); \
        _Pragma("unroll") for (int k_ = 0; k_ < 4; ++k_) _Pragma("unroll") for (int t_ = 0; t_ < 4; ++t_) s_[k_][t_] = ROR_ADD(s_[k_][t_], 1); \
        if (!FOX) { _Pragma("unroll") for (int k_ = 0; k_ < 4; ++k_) _Pragma("unroll") for (int t_ = 0; t_ < 4; ++t_) { float d_ = s_[k_][t_]; d_ += __shfl_xor(d_, 16); d_ += __shfl_xor(d_, 32); s_[k_][t_] = d_; } } \
        _Pragma("unroll") for (int k_ = 0; k_ < 4; ++k_) _Pragma("unroll") for (int t_ = 0; t_ < 4; ++t_) { float d_ = s_[k_][t_] + B4_[k_]; if (MASKED_ && k_ > t_) d_ = -1e30f; s_[k_][t_] = d_; } \
        bool need_ = false; \
        _Pragma("unroll") for (int t_ = 0; t_ < 4; ++t_) need_ |= __builtin_fmaxf(__builtin_fmaxf(s_[0][t_], s_[1][t_]), __builtin_fmaxf(s_[2][t_], s_[3][t_])) > mref[t_]; \
        if (__any(need_)) { if (!vpre && !(MASKED_)) DEC_LOADV(G_, V_); \
        _Pragma("unroll") for (int t_ = 0; t_ < 4; ++t_) { const float mg_ = __builtin_fmaxf(__builtin_fmaxf(s_[0][t_], s_[1][t_]), __builtin_fmaxf(s_[2][t_], s_[3][t_])); const float mn_ = __builtin_fmaxf(m[t_], mg_); const float f_ = __builtin_amdgcn_exp2f(m[t_] - mn_); \
            const float p0_ = __builtin_amdgcn_exp2f(s_[0][t_] - mn_), p1_ = __builtin_amdgcn_exp2f(s_[1][t_] - mn_), p2_ = __builtin_amdgcn_exp2f(s_[2][t_] - mn_), p3_ = __builtin_amdgcn_exp2f(s_[3][t_] - mn_); \
            l[t_] = l[t_] * f_ + ((p0_ + p1_) + (p2_ + p3_)); m[t_] = mn_; \
            _Pragma("unroll") for (int d_ = 0; d_ < 4; ++d_) o[t_][d_] = o[t_][d_] * f_ + ((p0_ * V_[0][d_] + p1_ * V_[1][d_]) + (p2_ * V_[2][d_] + p3_ * V_[3][d_])); } } } while (0)
    DEC_LOAD(0, kf, vf);
    for (int g = 0; g < NG; ++g) {
        if (g + 1 < NG) DEC_LOAD(g + 1, nk, nv);
        f32x4 b4 = {0.f, 0.f, 0.f, 0.f};
        if (FOX) b4 = *(const LAS f32x4*)(Rb + hl * PAST + 512 * part + KPW * wave + 4 * g);
        DEC_GROUP(kf, vf, b4, false, g);
#pragma unroll
        for (int k = 0; k < 4; ++k) { kf[k] = nk[k]; vf[k] = nv[k]; }
    }
    if (FOX && wave == 0 && part == 3) {
        const bf16* Kb = (const bf16*)(A.ws + WS_K) + qrow * DATT + sl * 256 + 4 * lane; const bf16* Vb = (const bf16*)(A.ws + WS_V) + qrow * DATT + sl * 256 + 4 * lane;
        const float* LOGF = (const float*)(A.ws + WS_LOGF) + qrow * 8 + 4 * sl + hl;
        f32x4 b4; float cn = 0.f;
#pragma unroll
        for (int k = 0; k < 4; ++k) { cn += LOGF[k * 8]; b4[k] = -cn * LOG2E;
            const unsigned long long kw = *(const unsigned long long*)(Kb + (size_t)k * DATT), vw = *(const unsigned long long*)(Vb + (size_t)k * DATT);
            kf[k] = (f32x4){bf2f((unsigned short)kw), bf2f((unsigned short)(kw >> 16)), bf2f((unsigned short)(kw >> 32)), bf2f((unsigned short)(kw >> 48))};
            vf[k] = (f32x4){bf2f((unsigned short)vw), bf2f((unsigned short)(vw >> 16)), bf2f((unsigned short)(vw >> 32)), bf2f((unsigned short)(vw >> 48))}; }
        DEC_GROUP(kf, vf, b4, true, 0);
    }
#undef DEC_LOAD
#undef DEC_LOADV
#undef DEC_GROUP
#pragma unroll
    for (int t = 0; t < 4; ++t) { *(LAS f32x4*)(om + (wave * 4 + t) * 256 + 4 * lane) = (f32x4){o[t][0], o[t][1], o[t][2], o[t][3]};
        if ((lane & 15) == 0) { mlb[((wave * 4 + t) * 4 + (lane >> 4)) * 2] = m[t]; mlb[((wave * 4 + t) * 4 + (lane >> 4)) * 2 + 1] = l[t]; } }
    __syncthreads();
    { const int t = tid >> 7, idx = (tid & 127) * 2, h4 = idx >> 6;
      float M = -1e30f;
#pragma unroll
      for (int w = 0; w < 8; ++w) M = fmaxf(M, mlb[((w * 4 + t) * 4 + h4) * 2]);
      float L = 0.f, o0 = 0.f, o1 = 0.f;
#pragma unroll
      for (int w = 0; w < 8; ++w) { const float f = exp2f(mlb[((w * 4 + t) * 4 + h4) * 2] - M); L += f * mlb[((w * 4 + t) * 4 + h4) * 2 + 1]; const f32x2 ov = *(const LAS f32x2*)(om + (w * 4 + t) * 256 + idx); o0 += f * ov[0]; o1 += f * ov[1]; }
      if (FOX) { float* pb = (float*)(A.ws + WS_PART) + ((size_t)((b * 2 + sl) * 4) * 4 + t) * 272;
          if (part != 0) { *(f32x2*)(pb + (size_t)part * 4 * 272 + idx) = (f32x2){o0, o1}; if ((idx & 63) == 0) { pb[(size_t)part * 4 * 272 + 256 + h4] = M; pb[(size_t)part * 4 * 272 + 260 + h4] = L; } return; }
          float Mp[3], Lp[3]; f32x2 op[3]; float Mt = M;
#pragma unroll
          for (int pp = 0; pp < 3; ++pp) { Mp[pp] = pb[(size_t)(pp + 1) * 4 * 272 + 256 + h4]; Lp[pp] = pb[(size_t)(pp + 1) * 4 * 272 + 260 + h4]; op[pp] = *(const f32x2*)(pb + (size_t)(pp + 1) * 4 * 272 + idx); Mt = fmaxf(Mt, Mp[pp]); }
          const float f3 = exp2f(M - Mt); L *= f3; o0 *= f3; o1 *= f3;
#pragma unroll
          for (int pp = 0; pp < 3; ++pp) { const float f = exp2f(Mp[pp] - Mt); L += f * Lp[pp]; o0 += f * op[pp][0]; o1 += f * op[pp][1]; } }
      const float il = 1.0f / L;
      bf16* dst = FOX ? (bf16*)(A.ws + WS_MIX) : (bf16*)(A.ws + WS_OC);
      *(unsigned*)(dst + (qrow + t) * DM + sl * 256 + idx) = pk2(o0 * il, o1 * il); }
}
template <bool FOX> __device__ __forceinline__ void decode_phase(const Args& A, LAS unsigned char* lds, int tid, int lane, int wave, int wg, int nwg, int part = 0) {
    constexpr int NU = FOX ? DB * 2 : DB * HX;
    for (int u = wg; u < NU; u += nwg) { if (FOX) decode_unit<true>(A, lds, tid, lane, wave, u >> 1, u & 1, part); else decode_unit<false>(A, lds, tid, lane, wave, u >> 2, u & 3, 0); }
    __syncthreads();
}

constexpr int XKP = 264, XVP = 136, XBUF = 69632;
__device__ __forceinline__ void cross_prompt_phase(const Args& A, LAS unsigned char* lds, int tid_in, int lane_in, int wave, int wg, int nwg) {
    const bf16* QC = (const bf16*)(A.ws + WS_QC); const bf16* MKb = (const bf16*)(A.ws + WS_MK); const bf16* MVT = (const bf16*)(A.ws + WS_MV); bf16* OC = (bf16*)(A.ws + WS_OC);
    for (int u = wg; u < NBATCH * HX * (SEQ / 256); u += nwg) {
        int tid_o = tid_in; asm volatile("" : "+v"(tid_o));
        const int tid = tid_o, lane = tid & 63, r = lane & 15, qd = lane >> 4;
        const int qt = u & 31, bh = u >> 5, b = bh >> 2, head = bh & 3; const size_t row0 = (size_t)b * SEQ + 256 * qt + 32 * wave + r;
        __syncthreads();
#pragma unroll
        for (int half = 0; half < 2; ++half) { const int key = tid >> 2, part = tid & 3; const bf16* src = MKb + ((size_t)b * NMEM + half * 128 + key) * DM + head * HDX + part * 64;
            LAS bf16* dst = (LAS bf16*)(lds + half * XBUF) + key * XKP + part * 64;
#pragma unroll
            for (int i = 0; i < 8; ++i) *(LAS v4u*)(dst + 8 * i) = *(const v4u*)(src + 8 * i); }
        __syncthreads();
        bf16x8 pb[2][8]; float il[2];
#pragma unroll
        for (int rt = 0; rt < 2; ++rt) {
            bf16x8 qf[8];
#pragma unroll
            for (int k = 0; k < 8; ++k) qf[k] = *(const bf16x8*)(QC + (row0 + 16 * rt) * DM + head * HDX + 32 * k + 8 * qd);
#pragma unroll
            for (int k = 0; k < 8; ++k) asm volatile("" : "+v"(qf[k]));
            f32x4 ST[16];
#pragma unroll
            for (int half = 0; half < 2; ++half)
#pragma unroll
                for (int kt = 0; kt < 8; ++kt) { f32x4 acc = {0.f, 0.f, 0.f, 0.f};
#pragma unroll
                    for (int k = 0; k < 8; ++k) acc = mfma16(ldfrag((const LAS bf16*)(lds + half * XBUF), XKP, 16 * kt, 32 * k, lane), qf[k], acc);
                    ST[half * 8 + kt] = acc; }
            float mx = -1e30f;
#pragma unroll
            for (int j = 0; j < 16; ++j) mx = fmaxf(mx, fmaxf(fmaxf(ST[j][0], ST[j][1]), fmaxf(ST[j][2], ST[j][3])));
            mx = fmaxf(mx, __shfl_xor(mx, 16)); mx = fmaxf(mx, __shfl_xor(mx, 32));
            float l = 0.f;
#pragma unroll
            for (int j = 0; j < 16; ++j)
#pragma unroll
                for (int i = 0; i < 4; ++i) { ST[j][i] = exp2f(ST[j][i] - mx); l += ST[j][i]; }
            l += __shfl_xor(l, 16); l += __shfl_xor(l, 32); il[rt] = 1.0f / l;
#pragma unroll
            for (int uu = 0; uu < 8; ++uu) { pb[rt][uu] = __builtin_bit_cast(bf16x8, pack8(ST[2 * uu], ST[2 * uu + 1])); asm volatile("" : "+v"(pb[rt][uu])); }
            __builtin_amdgcn_sched_barrier(0);
        }
        __syncthreads();
#pragma unroll
        for (int half = 0; half < 2; ++half) { const bf16* src = MVT + ((size_t)bh * HDX) * NMEM + half * 128; LAS bf16* dst = (LAS bf16*)(lds + half * XBUF);
#pragma unroll
            for (int j = 0; j < 8; ++j) { const int id = tid + NTHREADS * j, d = id >> 4, c = id & 15; *(LAS v4u*)(dst + d * XVP + 8 * c) = *(const v4u*)(src + (size_t)d * NMEM + 8 * c); } }
        __syncthreads();
#pragma unroll
        for (int rt = 0; rt < 2; ++rt) {
            f32x4 OT[16];
#pragma unroll
            for (int dt = 0; dt < 16; ++dt) OT[dt] = (f32x4){0.f, 0.f, 0.f, 0.f};
#pragma unroll
            for (int half = 0; half < 2; ++half)
#pragma unroll
                for (int u4 = 0; u4 < 4; ++u4)
#pragma unroll
                    for (int dt = 0; dt < 16; ++dt) { const LAS bf16* vp = (const LAS bf16*)(lds + half * XBUF) + (16 * dt + r) * XVP + 32 * u4 + 4 * qd;
                        const unsigned long long lo = *(const LAS unsigned long long*)vp, hi = *(const LAS unsigned long long*)(vp + 16);
                        v4u w; w.x = (unsigned)lo; w.y = (unsigned)(lo >> 32); w.z = (unsigned)hi; w.w = (unsigned)(hi >> 32);
                        OT[dt] = mfma16(__builtin_bit_cast(bf16x8, w), pb[rt][half * 4 + u4], OT[dt]); }
            const float ilv = il[rt];
#pragma unroll
            for (int dt = 0; dt < 16; ++dt) *(unsigned long long*)(OC + (row0 + 16 * rt) * DM + head * HDX + 16 * dt + 4 * qd) = (unsigned long long)pk2(OT[dt][0] * ilv, OT[dt][1] * ilv) | ((unsigned long long)pk2(OT[dt][2] * ilv, OT[dt][3] * ilv) << 32);
            __builtin_amdgcn_sched_barrier(0);
        }
    }
    __syncthreads();
}

template <class F> __device__ __forceinline__ void small_gemm(LAS unsigned char* lds, const bf16* __restrict__ Am, int row_base, int M, const bf16* __restrict__ Bt, int N, int K, const F& f, int tid_in, int wave, int wg, int nwg) {
    const int tiles_m = M / 32, ntiles = tiles_m * (N / 128), kw = K / 8;
    LAS float* part = (LAS float*)lds;
    for (int tile = wg; tile < ntiles; tile += nwg) {
        int tid_o = tid_in; asm volatile("" : "+v"(tid_o));
        const int lane = tid_o & 63, r = lane & 15, qd = lane >> 4;
        const int tm = tile % tiles_m, tn = tile / tiles_m;
        const bf16* ap = Am + (size_t)(32 * tm + r) * K + wave * kw + 8 * qd; const bf16* bp = Bt + (size_t)(128 * tn + r) * K + wave * kw + 8 * qd;
        f32x4 acc[2][8];
#pragma unroll
        for (int mt = 0; mt < 2; ++mt)
#pragma unroll
            for (int nt = 0; nt < 8; ++nt) acc[mt][nt] = (f32x4){0.f, 0.f, 0.f, 0.f};
#pragma unroll 2
        for (int ks = 0; ks < kw / 32; ++ks) { bf16x8 af[2], bfr[8];
#pragma unroll
            for (int mt = 0; mt < 2; ++mt) af[mt] = *(const bf16x8*)(ap + (size_t)(16 * mt) * K + 32 * ks);
#pragma unroll
            for (int nt = 0; nt < 8; ++nt) bfr[nt] = *(const bf16x8*)(bp + (size_t)(16 * nt) * K + 32 * ks);
#pragma unroll
            for (int mt = 0; mt < 2; ++mt)
#pragma unroll
                for (int nt = 0; nt < 8; ++nt) acc[mt][nt] = mfma16(af[mt], bfr[nt], acc[mt][nt]); }
#pragma unroll
        for (int mt = 0; mt < 2; ++mt)
#pragma unroll
            for (int nt = 0; nt < 8; ++nt)
#pragma unroll
                for (int i = 0; i < 4; ++i) part[(wave * 32 + 16 * mt + 4 * qd + i) * 128 + 16 * nt + r] = acc[mt][nt][i];
        __syncthreads();
        { const int row = (wave & 1) * 16 + r, col0 = ((wave >> 1) * 4 + qd) * 8; f32x4 v0 = {0.f, 0.f, 0.f, 0.f}, v1 = {0.f, 0.f, 0.f, 0.f};
#pragma unroll
          for (int w = 0; w < 8; ++w) { v0 = v0 + *(const LAS f32x4*)(part + (w * 32 + row) * 128 + col0); v1 = v1 + *(const LAS f32x4*)(part + (w * 32 + row) * 128 + col0 + 4); }
          f(row_base + 32 * tm + row, 128 * tn + col0, v0, v1); }
        __syncthreads();
    }
}

template <class Epi> __device__ __forceinline__ void run_gemm(LAS unsigned char* lds, const bf16* Am, const bf16* Bt, int M, int N, int K, int nwg, int wg, const Epi& E) {
    pg8::Gemm g{Am, Bt, M, N, K}; pg8::StaticOrder S; S.init(M, N, nwg, wg);
    pg8::gemm_phase<Epi, pg8::StaticOrder, true, true>((PG8_LAS unsigned char*)lds, g, S, E);
}

__global__ void __launch_bounds__(NTHREADS, 2) mk_fwd(Args A) {
    extern __shared__ __attribute__((aligned(16))) unsigned char lds_raw[];
    LAS unsigned char* lds = (LAS unsigned char*)lds_raw;
    const int tid = threadIdx.x, lane = tid & 63, wave = __builtin_amdgcn_readfirstlane(tid >> 6);
#define LANE() lane
#define TID() tid
    const int wg = blockIdx.x, nwg = gridDim.x;
    unsigned char* ws = A.ws;
    for (int u = TID(); u < (LDS_BYTES - LDSCTL_OFF) / 4; u += NTHREADS) ((LAS unsigned*)(lds + LDSCTL_OFF))[u] = 0u;
    __syncthreads();
    volatile LAS unsigned* MISC = (volatile LAS unsigned*)(lds + MISC_OFF);
    XcdBarrier bar; bar.bar = (unsigned*)(ws + WS_CTL) + CW_BAR; bar.x = 0; bar.st = nullptr;
    if (MK_ONE_LAUNCH) bar = xcd_barrier_post((unsigned*)(ws + WS_CTL) + CW_BAR, MISC + 8);
    const int lo = A.ph_lo, hi = A.ph_hi;
#define IN(k) (lo <= (k) && (k) < hi)
#define SEAM(k) do { if (MK_ONE_LAUNCH && IN(k) && IN((k) + 1)) xcd_barrier(bar); } while (0)
#ifndef REP_PHASE
#define REP_PHASE -1
#endif
#define REP(k, body) do { body; if (REP_PHASE == (k)) { body; } } while (0)
    bf16* XB = (bf16*)(ws + WS_XB);

    if (IN(0)) { REP(0, p0_prologue(A, lds, TID(), LANE(), wave, wg, nwg)); } SEAM(0);
    if (IN(1)) {
        if (wg < NBATCH * HATT) p1_cumsum(A, lds, TID(), LANE(), wave, wg);
        { const FMemKV Fm{(const float*)(ws + WS_SSM), (bf16*)(ws + WS_MK), (bf16*)(ws + WS_MV), A.out};
          small_gemm(lds, (const bf16*)(ws + WS_MB), 0, MMEM, (const bf16*)(ws + WS_WCKV), 2048, DM, Fm, TID(), wave, wg, nwg); }
        { const FInproj Fi{(const float*)(ws + WS_SS0), (bf16*)(ws + WS_Q), (bf16*)(ws + WS_K), (bf16*)(ws + WS_V), (bf16*)(ws + WS_Z), (bf16*)(ws + WS_XBC), A.out};
          small_gemm(lds, XB + (size_t)MP * DM, MP, MS, (const bf16*)(ws + WS_WIN), 3072, DM, Fi, TID(), wave, wg, nwg);
          pg8::Epi8<FInproj> E{Fi}; REP(1, run_gemm(lds, XB, (const bf16*)(ws + WS_WIN), MP, 3072, DM, nwg, wg, E)); }
    } SEAM(1);
    if (IN(2)) { if (wg & 1) decode_phase<true>(A, lds, TID(), LANE(), wave, wg, nwg, 3);
        if (nwg == 256) wconv(A, (LAS float*)(lds + wave * 8448), 1, wg * NWAVES + wave, nwg * NWAVES, LANE()); __syncthreads(); attn_norms(A, LANE(), wave, wg, nwg); REP(21, conv_pass(A, TID(), wg, nwg)); REP(2, ssd_phase_a(A, lds, TID(), LANE(), wave, wg, nwg));
        if (!(wg & 1)) decode_phase<true>(A, lds, TID(), LANE(), wave, wg, nwg, 3); } SEAM(2);
    if (IN(3)) { for (int rep3 = 0; rep3 < (REP_PHASE == 3 ? 2 : 1); ++rep3) {
        if (wave < 4) { ssd_phase_b(A, wg * 256 + TID(), nwg * 256); } else { p3_ssd_naive(A, lds, LANE(), wave, wg, nwg, NBATCH * HSSM * 4, wave - 4, 4); } __syncthreads();
        { const attn_body::AttnTensors AT{(const attn_body::bf16*)(ws + WS_Q), (const attn_body::bf16*)(ws + WS_K), (const attn_body::bf16*)(ws + WS_V), (attn_body::bf16*)(ws + WS_MIX), (const float*)(ws + WS_CUM), (const float*)(ws + WS_KN), (const float*)(ws + WS_QN)};
          const int grp = wg & 1; int dp = 0;
          gu32* aq = (gu32*)(ws + WS_CTL) + CW_AQ;
          for (;;) {
              int zo_; asm volatile("s_mov_b32 %0, 0" : "=s"(zo_));
              if (grp == 0 && dp < 2) { decode_phase<true>(A, lds + zo_, TID(), LANE(), wave, wg, nwg, 2 - dp); ++dp; }
              if (TID() == 0) MISC[0] = __hip_atomic_fetch_add(aq, 1u, __ATOMIC_RELAXED, __HIP_MEMORY_SCOPE_AGENT);
              __syncthreads();
              const int uq = (int)MISC[0];
              __syncthreads();
              if (uq < NBATCH * HATT * (SEQ / 256)) attn_body::attn_unit<64>((uq & 15) >> 3, uq & 7, (SEQ / 256 - 1) - (uq >> 4), AT.Q, AT.K, AT.V, AT.O, AT.CUM, AT.KN, AT.QN, (char*)lds_raw);
              if (grp == 1 && dp < 2) { decode_phase<true>(A, lds + zo_, TID(), LANE(), wave, wg, nwg, 2 - dp); ++dp; }
              if (uq >= NBATCH * HATT * (SEQ / 256) && dp == 2) break;
          } } } } SEAM(3);
    if (IN(4)) { p4_gate_norm(A, LANE(), wave, wg, nwg, MP); for (int slot = 0; slot < 2; ++slot) { int zo_; asm volatile("s_mov_b32 %0, 0" : "=s"(zo_)); if ((slot ^ (wg & 1)) == 0) decode_phase<true>(A, lds + zo_, TID(), LANE(), wave, wg, nwg, 0); else { REP(4, ssd_phase_c(A, lds + zo_, TID(), LANE(), wave, wg, nwg)); } } } SEAM(4);
    if (IN(5)) { const FRes Fr{(const float*)A.in[0], (const float*)A.in[1], XB, (float*)(ws + WS_SS1)};
        small_gemm(lds, (const bf16*)(ws + WS_MIX) + (size_t)MP * DM, MP, MS, (const bf16*)(ws + WS_WOUT), DM, DM, Fr, TID(), wave, wg, nwg);
        if (nwg == 256 && wg >= 128) { wconv(A, (LAS float*)(lds + wave * 8448), 2, (wg - 128) * NWAVES + wave, (nwg - 128) * NWAVES, LANE()); __syncthreads(); }
        pg8::Epi8<FRes> E{Fr}; run_gemm(lds, (const bf16*)(ws + WS_MIX), (const bf16*)(ws + WS_WOUT), MP, DM, DM, nwg, wg, E); } SEAM(5);
    if (IN(6)) { const FScaleBf16 Fs{(const float*)(ws + WS_SS1), (bf16*)(ws + WS_QC), XC2};
        small_gemm(lds, XB + (size_t)MP * DM, MP, MS, (const bf16*)(ws + WS_WCQ), DM, DM, Fs, TID(), wave, wg, nwg);
        if (nwg == 256 && wg >= 128) { wconv(A, (LAS float*)(lds + wave * 8448), 3, (wg - 128) * NWAVES + wave, (nwg - 128) * NWAVES, LANE()); __syncthreads(); }
        pg8::Epi8<FScaleBf16> E{Fs}; REP(6, run_gemm(lds, XB, (const bf16*)(ws + WS_WCQ), MP, DM, DM, nwg, wg, E)); } SEAM(6);
    if (IN(7)) {
        if (wg & 1) { REP(71, decode_phase<false>(A, lds, TID(), LANE(), wave, wg, nwg)); REP(72, cross_prompt_phase(A, lds, TID(), LANE(), wave, wg, nwg)); }
        else { REP(72, cross_prompt_phase(A, lds, TID(), LANE(), wave, wg, nwg)); REP(71, decode_phase<false>(A, lds, TID(), LANE(), wave, wg, nwg)); } } SEAM(7);
    if (IN(8)) { const FRes Fr{nullptr, nullptr, XB, (float*)(ws + WS_SS2)};
        small_gemm(lds, (const bf16*)(ws + WS_OC) + (size_t)MP * DM, MP, MS, (const bf16*)(ws + WS_WCO), DM, DM, Fr, TID(), wave, wg, nwg);
        if (nwg == 256 && wg >= 128) { wconv(A, (LAS float*)(lds + wave * 8448), 5, (wg - 128) * NWAVES + wave, (nwg - 128) * NWAVES, LANE()); __syncthreads(); }
        pg8::Epi8<FRes> E{Fr}; run_gemm(lds, (const bf16*)(ws + WS_OC), (const bf16*)(ws + WS_WCO), MP, DM, DM, nwg, wg, E); } SEAM(8);
    if (IN(9)) { pg8::EpiGU<FGateUp> E{{(const float*)(ws + WS_SS2), (bf16*)(ws + WS_U)}};
        REP(9, run_gemm(lds, XB, (const bf16*)(ws + WS_WGU), MT, 2 * DFF, DM, nwg, wg, E));
        if (nwg == 256 && wg >= 172) { wconv(A, (LAS float*)(lds + wave * 8448), 6, (wg - 172) * NWAVES + wave, (nwg - 172) * NWAVES, LANE()); } } SEAM(9);
    if (IN(10)) { const FRes Fr{nullptr, nullptr, XB, (float*)(ws + WS_SS3)};
        small_gemm(lds, (const bf16*)(ws + WS_U) + (size_t)MP * DFF, MP, MS, (const bf16*)(ws + WS_WD), DM, DFF, Fr, TID(), wave, wg, nwg);
        pg8::Epi8<FRes> E{Fr}; run_gemm(lds, (const bf16*)(ws + WS_U), (const bf16*)(ws + WS_WD), MP, DM, DFF, nwg, wg, E); } SEAM(10);
    if (IN(11)) { REP(11, p11_final_norm(A, LANE(), wave, wg, nwg)); }
#undef IN
#undef SEAM
#undef LANE
#undef TID
}

extern "C" void kernel_launch(void* const* d_in, const int* in_sizes, int n_in, void* d_out, int out_size, void* d_ws, size_t ws_size, hipStream_t stream) {
    static int grid = 0;
    if (grid == 0) {
        if (n_in != 32 || out_size != (int)OUT_TOTAL || ws_size < WS_END2) { fprintf(stderr, "kernel_launch: unexpected shapes (n_in %d out %d ws %zu)\n", n_in, out_size, ws_size); grid = -1; return; }
        int dev = 0, cus = 0, per_cu = 0;
        if (hipGetDevice(&dev) != hipSuccess || hipDeviceGetAttribute(&cus, hipDeviceAttributeMultiprocessorCount, dev) != hipSuccess) { grid = -1; return; }
        if (hipFuncSetAttribute((const void*)mk_fwd, hipFuncAttributeMaxDynamicSharedMemorySize, LDS_BYTES) != hipSuccess) { fprintf(stderr, "kernel_launch: hipFuncSetAttribute failed\n"); grid = -1; return; }
        if (hipOccupancyMaxActiveBlocksPerMultiprocessor(&per_cu, (const void*)mk_fwd, NTHREADS, LDS_BYTES) != hipSuccess || per_cu < 1) fprintf(stderr, "kernel_launch: occupancy query reports %d\n", per_cu);
        (void)hipGetLastError();
        grid = cus;
    }
    if (grid < 0) return;
    (void)hipMemsetAsync((char*)d_ws + WS_CTL, 0, CTL_ZERO_BYTES, stream);
    Args a{};
    for (int i = 0; i < 32; ++i) a.in[i] = d_in[i];
    a.out = (float*)d_out; a.ws = (unsigned char*)d_ws;
    if (MK_ONE_LAUNCH) { a.ph_lo = 0; a.ph_hi = NPH; hipLaunchKernelGGL(mk_fwd, dim3(grid), dim3(NTHREADS), LDS_BYTES, stream, a); }
    else for (int p = 0; p < NPH; ++p) { a.ph_lo = p; a.ph_hi = p + 1; hipLaunchKernelGGL(mk_fwd, dim3(grid), dim3(NTHREADS), LDS_BYTES, stream, a); }
}
```
